# Optimizing an MI355X kernel written in HIP

```python
import jax, jax.numpy as jnp
from jax import lax
import numpy as np

D_MODEL = 2048
BATCH = 2
SEQ = 16384
DEPTH = 2

HG_HEADS = 8
HG_KDIM = 128
HG_VDIM = 128
HG_QF = HG_HEADS * HG_KDIM
HG_WIDTH = HG_HEADS * HG_VDIM
HG_CHUNK = 64
AT_HEADS = 16
AT_KV_HEADS = 2
AT_HEAD_DIM = 64
AT_GROUP = AT_HEADS // AT_KV_HEADS
AT_WIDTH = AT_HEADS * AT_HEAD_DIM
AT_KV_WIDTH = AT_KV_HEADS * AT_HEAD_DIM
WINDOW = 128
BLOCK = 128
D_FF = 4 * D_MODEL
EPS = 1e-6

SPLIT_SIZES = (HG_QF, HG_QF, HG_WIDTH, HG_WIDTH, AT_WIDTH, AT_KV_WIDTH, AT_KV_WIDTH, D_MODEL, D_MODEL)
D_IN = sum(SPLIT_SIZES)

kernel_name = "hybrid_hgrn2_swa_sink_gated"


def rmsnorm(x, g):
    xf = x.astype(jnp.float32)
    y = xf * lax.rsqrt(jnp.mean(xf * xf, axis=-1, keepdims=True) + EPS)
    return (y * g.astype(jnp.float32)).astype(x.dtype)


def alibi_slopes(n):
    return jnp.asarray(2.0 ** (-8.0 * (np.arange(n, dtype=np.float32) + 1.0) / n), dtype=jnp.float32)


def hgrn2(q, f_logit, i, lb):
    bsz, t_len, _ = q.shape
    n_chunks = t_len // HG_CHUNK
    c = HG_CHUNK
    lb = lb.astype(jnp.float32)
    qf = jax.nn.silu(q.astype(jnp.float32))
    fg = lb + (1.0 - lb) * jax.nn.sigmoid(f_logit.astype(jnp.float32))
    kf = 1.0 - fg
    logf = jnp.log(fg)

    def chunks(a, d):
        return a.reshape(bsz, n_chunks, c, HG_HEADS, d).transpose(0, 1, 3, 2, 4)

    q_c = chunks(qf, HG_KDIM)
    k_c = chunks(kf, HG_KDIM)
    g_c = chunks(logf, HG_KDIM)
    v_c = chunks(i.astype(jnp.float32), HG_VDIM)
    cum = jnp.cumsum(g_c, axis=3)
    ref = cum[:, :, :, c // 2 - 1:c // 2]
    a = jnp.einsum('bnhck,bnhsk->bnhcs', q_c * jnp.exp(cum - ref), k_c * jnp.exp(ref - cum))
    causal = jnp.tril(jnp.ones((c, c), dtype=bool))
    a = jnp.where(causal, a, 0.0)
    o_intra = jnp.einsum('bnhcs,bnhsv->bnhcv', a, v_c)
    last = cum[:, :, :, -1:]
    q_out = q_c * jnp.exp(cum)
    k_state = k_c * jnp.exp(last - cum)
    decay_last = jnp.exp(last[:, :, :, 0, :])

    def step(state, xs):
        qo, ks, vs, dl = xs
        o = jnp.einsum('bhck,bhkv->bhcv', qo, state)
        state = dl[..., None] * state + jnp.einsum('bhck,bhcv->bhkv', ks, vs)
        return state, o

    xs = (jnp.moveaxis(q_out, 1, 0), jnp.moveaxis(k_state, 1, 0),
          jnp.moveaxis(v_c, 1, 0), jnp.moveaxis(decay_last, 1, 0))
    s0 = jnp.zeros((bsz, HG_HEADS, HG_KDIM, HG_VDIM), jnp.float32)
    _, o_inter = lax.scan(step, s0, xs)
    o = o_intra + jnp.moveaxis(o_inter, 0, 1)
    return o.transpose(0, 1, 3, 2, 4).reshape(bsz, t_len, HG_HEADS, HG_VDIM)


def swa_sinks(q, k, v, sinks):
    bsz, t_len = q.shape[0], q.shape[1]
    nb = t_len // BLOCK
    qb = q.reshape(bsz, nb, BLOCK, AT_KV_HEADS, AT_GROUP, AT_HEAD_DIM)
    pad = jnp.zeros((bsz, BLOCK, AT_KV_HEADS, AT_HEAD_DIM), k.dtype)

    def band(a):
        ap = jnp.concatenate([pad, a], axis=1).reshape(bsz, nb + 1, BLOCK, AT_KV_HEADS, AT_HEAD_DIM)
        return jnp.concatenate([ap[:, :-1], ap[:, 1:]], axis=2)

    kb = band(k)
    vb = band(v)
    scale = AT_HEAD_DIM ** -0.5
    s = jnp.einsum('bnqhgd,bnkhd->bnhgqk', qb, kb).astype(jnp.float32) * scale
    qi = jnp.arange(BLOCK)[:, None]
    kj = jnp.arange(2 * BLOCK)[None, :]
    dist = qi + BLOCK - kj
    in_band = (dist >= 0) & (dist < WINDOW)
    blk = jnp.arange(nb)[:, None, None]
    valid = in_band[None] & ((blk > 0) | (kj[None] >= BLOCK))
    slopes = alibi_slopes(AT_HEADS)
    bias = -slopes[:, None, None] * dist.astype(jnp.float32)[None]
    s = s + bias.reshape(AT_KV_HEADS, AT_GROUP, BLOCK, 2 * BLOCK)[None, None]
    s = jnp.where(valid[None, :, None, None], s, -jnp.inf)
    sink = sinks.astype(jnp.float32).reshape(AT_KV_HEADS, AT_GROUP)[None, None, :, :, None, None]
    m = jnp.maximum(jnp.max(s, axis=-1, keepdims=True), sink)
    p = jnp.exp(s - m)
    p = p / (jnp.sum(p, axis=-1, keepdims=True) + jnp.exp(sink - m))
    o = jnp.einsum('bnhgqk,bnkhd->bnqhgd', p.astype(v.dtype), vb)
    return o.reshape(bsz, t_len, AT_WIDTH)


def setup_inputs(seed: int = 0) -> dict:
    key = jax.random.key(seed)
    ks = jax.random.split(key, 14)
    f32 = jnp.float32
    L = DEPTH
    return {
        "x": jax.random.normal(ks[0], (BATCH, SEQ, D_MODEL), f32),
        "norm_mix": 1.0 + 0.1 * jax.random.normal(ks[1], (L, D_MODEL), f32),
        "w_in": jax.random.normal(ks[2], (L, D_MODEL, D_IN), f32) * D_MODEL ** -0.5,
        "lb_logits": 0.5 * jax.random.normal(ks[3], (L, HG_QF), f32),
        "hg_norm": 1.0 + 0.1 * jax.random.normal(ks[4], (L, HG_VDIM), f32),
        "q_norm": 1.0 + 0.1 * jax.random.normal(ks[5], (L, AT_HEAD_DIM), f32),
        "k_norm": 1.0 + 0.1 * jax.random.normal(ks[6], (L, AT_HEAD_DIM), f32),
        "sinks": 0.5 * jax.random.normal(ks[7], (L, AT_HEADS), f32),
        "w_hg_out": jax.random.normal(ks[8], (L, HG_WIDTH, D_MODEL), f32) * HG_WIDTH ** -0.5,
        "w_at_out": jax.random.normal(ks[9], (L, AT_WIDTH, D_MODEL), f32) * AT_WIDTH ** -0.5,
        "w_out": jax.random.normal(ks[10], (L, D_MODEL, D_MODEL), f32) * D_MODEL ** -0.5,
        "norm_ffn": 1.0 + 0.1 * jax.random.normal(ks[11], (L, D_MODEL), f32),
        "w_up": jax.random.normal(ks[12], (L, D_MODEL, D_FF), f32) * D_MODEL ** -0.5,
        "w_down": jax.random.normal(ks[13], (L, D_FF, D_MODEL), f32) * (0.5 * D_FF ** -0.5),
    }


def reference(x, norm_mix, w_in, lb_logits, hg_norm, q_norm, k_norm, sinks,
              w_hg_out, w_at_out, w_out, norm_ffn, w_up, w_down):
    bsz, t_len, _ = x.shape
    lbp = jax.nn.softmax(lb_logits.astype(jnp.float32), axis=0)
    lower_bounds = jnp.cumsum(lbp, axis=0) - lbp[0:1]
    offsets = [int(v) for v in np.cumsum(SPLIT_SIZES)[:-1]]
    for l in range(DEPTH):
        h = rmsnorm(x, norm_mix[l])
        z = h @ w_in[l]
        hq, hf, hi, hgate, aq, ak, av, g_hg, g_at = jnp.split(z, offsets, axis=-1)
        o_hg = hgrn2(hq, hf, hi, lower_bounds[l]).astype(x.dtype)
        o_hg = rmsnorm(o_hg, hg_norm[l]) * jax.nn.silu(hgate.reshape(bsz, t_len, HG_HEADS, HG_VDIM))
        y_hg = o_hg.reshape(bsz, t_len, HG_WIDTH) @ w_hg_out[l]
        qa = rmsnorm(aq.reshape(bsz, t_len, AT_HEADS, AT_HEAD_DIM), q_norm[l])
        ka = rmsnorm(ak.reshape(bsz, t_len, AT_KV_HEADS, AT_HEAD_DIM), k_norm[l])
        va = av.reshape(bsz, t_len, AT_KV_HEADS, AT_HEAD_DIM)
        y_at = swa_sinks(qa, ka, va, sinks[l]) @ w_at_out[l]
        mixed = jax.nn.sigmoid(g_hg) * y_hg + jax.nn.sigmoid(g_at) * y_at
        x = x + mixed @ w_out[l]
        h2 = rmsnorm(x, norm_ffn[l])
        x = x + jnp.square(jax.nn.relu(h2 @ w_up[l])) @ w_down[l]
    return x
```

```cpp
#include <hip/hip_runtime.h>
#include <hip/hip_cooperative_groups.h>
#include <cstdio>
#include <cstdint>
namespace cg = cooperative_groups;
namespace pg8 {
#define PG8_LAS __attribute__((address_space(3)))
typedef unsigned short bf16_t;
typedef short bf16x8 __attribute__((ext_vector_type(8)));
typedef float f32x4 __attribute__((ext_vector_type(4)));
typedef unsigned u32x4 __attribute__((ext_vector_type(4)));
constexpr int BM = 256, BK = 64, HALF = 128, HTB = HALF * BK * 2  , STAGE_BYTES = 8 * HTB, NXCD = 8, WGM = 8;

__host__ __device__ __forceinline__ int lds_byte(int r, int c) { const int st = (r >> 4) * 2 + (c >> 5), rr = r & 15, cc = c & 31, ob = rr * 64 + cc * 2; return st * 1024 + (ob ^ (((ob >> 9) & 1) << 5)); }
__host__ __device__ __forceinline__ void stage_rc(int b, int& R, int& C) { const int st = b / 1024, sb = b % 1024, swz = sb ^ (((sb >> 9) & 1) << 5); R = (st >> 1) * 16 + swz / 64; C = (st & 1) * 32 + (swz % 64) / 2; }
__host__ __device__ __forceinline__ int perm32(int rho) { const int n = rho >> 4, i = rho & 15; return 8 * (i >> 2) + 4 * n + (i & 3); }

struct Unit { int pm, pn; };
struct Gemm { const bf16_t* A; const bf16_t* Bt; int M, N, K; };

struct StaticOrder {
    int nM, nN, nwg, G, c;
    __host__ __device__ void init(int M, int N, int G_, int c_) { nM = M / BM; nN = N / BM; nwg = nM * nN; G = G_; c = c_; }
    __host__ __device__ bool next(int i, Unit& u) const {
        const long L = (long)i * G + c; if (L >= nwg) return false;
        int wgid = (int)L; { const int q = nwg / NXCD, r = nwg % NXCD, xcd = wgid % NXCD, off = wgid / NXCD; wgid = (xcd < r ? xcd * (q + 1) : r * (q + 1) + (xcd - r) * q) + off; }
        const int nig = WGM * nN, gid = wgid / nig, fm = gid * WGM, gsz = (nM - fm) < WGM ? (nM - fm) : WGM;
        u.pm = fm + ((wgid % nig) % gsz); u.pn = (wgid % nig) / gsz; return true;
    }
    __device__ __forceinline__ void a_ready(const Unit&) const {}
    __device__ __forceinline__ void done(const Unit&) const {}
};
__device__ __forceinline__ unsigned cvt_pk_bf16(float lo, float hi) { unsigned r; asm volatile("v_cvt_pk_bf16_f32 %0, %1, %2" : "=v"(r) : "v"(lo), "v"(hi)); return r; }
typedef float f32x2 __attribute__((ext_vector_type(2)));
template <class Epi, class Sched, bool ALIGN_EPI = false, bool SP2 = false>
__device__ __forceinline__ void gemm_phase(PG8_LAS unsigned char* lds, const Gemm g, const Sched& S, const Epi& E) {
    int tid_ = threadIdx.x; asm volatile("" : "+v"(tid_));
    const int tid = tid_, wid = __builtin_amdgcn_readfirstlane(tid >> 6), lane = tid & 63, wr = wid >> 2, wc = wid & 3, fr = lane & 15, fq = lane >> 4;
    const int K = g.K, nt = K / BK;
    unsigned voffA[2], voffB[2];
#pragma unroll
    for (int i = 0; i < 2; ++i) { int R, C; stage_rc(tid * 16 + i * 8192, R, C); const int Rb = Epi::PERM ? ((R & ~31) + perm32(R & 31)) : R;
        voffA[i] = (unsigned)(R * K + C) * 2u; voffB[i] = (unsigned)(Rb * K + C) * 2u; }
    const size_t kstep = (size_t)(BK * 2);
    const size_t hstep = (size_t)HALF * K * 2;
    const size_t tstep = 2 * hstep;
    const unsigned ldsw = (unsigned)wid * 1024u;
    const int aoff = lds_byte(wr * 64 + fr, fq * 8), boff = lds_byte(wc * 32 + fr, fq * 8);
#define PG8_SA(b, h) (((b) * 2 + (h)) * HTB)
#define PG8_SB(b, h) ((4 + (b) * 2 + (h)) * HTB)
#define PG8_STAGE(bufoff, gbase, voff) do { _Pragma("unroll") for (int _i = 0; _i < 2; ++_i) \
        __builtin_amdgcn_global_load_lds((const unsigned*)((const char*)(gbase) + (voff)[_i]), (PG8_LAS unsigned*)(lds + (bufoff) + ldsw + _i * 8192), 16, 0, 0); } while (0)
#define PG8_LDA(dst, b, h) do { _Pragma("unroll") for (int m = 0; m < 4; ++m) _Pragma("unroll") for (int k = 0; k < 2; ++k) dst[m][k] = *(const PG8_LAS bf16x8*)(lds + PG8_SA(b, h) + aoff + m * 2048 + k * 1024); } while (0)
#define PG8_LDB(dst, b, h) do { _Pragma("unroll") for (int n = 0; n < 2; ++n) _Pragma("unroll") for (int k = 0; k < 2; ++k) dst[n][k] = *(const PG8_LAS bf16x8*)(lds + PG8_SB(b, h) + boff + n * 2048 + k * 1024); } while (0)
#define PG8_MMA(ai, bj, At, Bt) do { __builtin_amdgcn_s_setprio(1); _Pragma("unroll") for (int m = 0; m < 4; ++m) _Pragma("unroll") for (int n = 0; n < 2; ++n) _Pragma("unroll") for (int k = 0; k < 2; ++k) \
        acc[ai][bj][m][n] = __builtin_amdgcn_mfma_f32_16x16x32_bf16(Bt[n][k], At[m][k], acc[ai][bj][m][n], 0, 0, 0); __builtin_amdgcn_s_setprio(0); } while (0)
#define PG8_WAIT_V(n) asm volatile("s_waitcnt vmcnt(" #n ")" ::: "memory")
#define PG8_WAIT_L(n) asm volatile("s_waitcnt lgkmcnt(" #n ")" ::: "memory")
#define PG8_BAR __builtin_amdgcn_s_barrier()
#define PG8_SCHED __builtin_amdgcn_sched_barrier(0)
    Unit cur, nxt; int ui = 0;
    if (!S.next(0, cur)) return;
    f32x4 acc[2][2][4][2];
#pragma unroll
    for (int a = 0; a < 2; ++a)
#pragma unroll
        for (int b = 0; b < 2; ++b)
#pragma unroll
            for (int m = 0; m < 4; ++m)
#pragma unroll
                for (int n = 0; n < 2; ++n) acc[a][b][m][n] = (f32x4){0.f, 0.f, 0.f, 0.f};
    bf16x8 At[4][2], B0[2][2], B1[2][2];
    const char* cA = (const char*)g.A + (size_t)cur.pm * tstep; const char* cB = (const char*)g.Bt + (size_t)cur.pn * tstep;
    S.a_ready(cur);
    if constexpr (SP2) {
        PG8_STAGE(PG8_SB(0, 0), cB, voffB); PG8_STAGE(PG8_SB(0, 1), cB + hstep, voffB); PG8_STAGE(PG8_SA(0, 0), cA, voffA); PG8_STAGE(PG8_SA(0, 1), cA + hstep, voffA);
        if (wr == 1) PG8_BAR;
        PG8_WAIT_V(2); PG8_BAR;
        PG8_STAGE(PG8_SB(1, 0), cB + kstep, voffB); PG8_STAGE(PG8_SA(1, 0), cA + kstep, voffA); PG8_STAGE(PG8_SB(1, 1), cB + hstep + kstep, voffB);
        PG8_WAIT_V(6); PG8_BAR;
    } else {
        PG8_STAGE(PG8_SB(0, 0), cB, voffB); PG8_STAGE(PG8_SA(0, 0), cA, voffA); PG8_STAGE(PG8_SB(0, 1), cB + hstep, voffB); PG8_STAGE(PG8_SA(0, 1), cA + hstep, voffA);
        if (wr == 1) PG8_BAR;
        PG8_WAIT_V(4); PG8_BAR;
        PG8_STAGE(PG8_SB(1, 0), cB + kstep, voffB); PG8_STAGE(PG8_SA(1, 0), cA + kstep, voffA); PG8_STAGE(PG8_SB(1, 1), cB + hstep + kstep, voffB);
        PG8_WAIT_V(6); PG8_BAR;
    }
    for (;;) {
        const bool has_next = S.next(ui + 1, nxt);
        const char* nA = has_next ? (const char*)g.A + (size_t)nxt.pm * tstep : cA; const char* nB = has_next ? (const char*)g.Bt + (size_t)nxt.pn * tstep : cB;
        for (int t = 0; t < nt; t += 2) {
            const bool last = (t == nt - 2);
            const char* a1 = cA + (size_t)(t + 1) * kstep;
            const char* a2 = last ? nA : cA + (size_t)(t + 2) * kstep; const char* b2 = last ? nB : cB + (size_t)(t + 2) * kstep;
            const char* a3 = a2 + kstep; const char* b3 = b2 + kstep;
            if (last && has_next) S.a_ready(nxt);
            if constexpr (SP2) {
            PG8_LDB(B0, 0, 0); PG8_LDB(B1, 0, 1); PG8_SCHED; PG8_LDA(At, 0, 0); PG8_STAGE(PG8_SA(1, 1), a1 + hstep, voffA);
            PG8_WAIT_V(8); PG8_WAIT_L(0); PG8_BAR; PG8_MMA(0, 0, At, B0); PG8_MMA(0, 1, At, B1); PG8_BAR; PG8_SCHED;
            PG8_LDA(At, 0, 1); PG8_STAGE(PG8_SB(0, 0), b2, voffB); PG8_STAGE(PG8_SB(0, 1), b2 + hstep, voffB); PG8_STAGE(PG8_SA(0, 0), a2, voffA);
            PG8_WAIT_V(8); PG8_WAIT_L(0); PG8_BAR; PG8_MMA(1, 0, At, B0); PG8_MMA(1, 1, At, B1); PG8_BAR; PG8_SCHED;
            PG8_LDB(B0, 1, 0); PG8_LDB(B1, 1, 1); PG8_SCHED; PG8_LDA(At, 1, 0); PG8_STAGE(PG8_SA(0, 1), a2 + hstep, voffA);
            PG8_WAIT_V(8); PG8_WAIT_L(0); PG8_BAR; PG8_MMA(0, 0, At, B0); PG8_MMA(0, 1, At, B1); PG8_BAR; PG8_SCHED;
            PG8_LDA(At, 1, 1); PG8_STAGE(PG8_SB(1, 0), b3, voffB); PG8_STAGE(PG8_SB(1, 1), b3 + hstep, voffB); PG8_STAGE(PG8_SA(1, 0), a3, voffA);
            PG8_WAIT_V(8); PG8_WAIT_L(0); PG8_BAR; PG8_MMA(1, 0, At, B0); PG8_MMA(1, 1, At, B1); PG8_BAR; PG8_SCHED;
            } else {
            PG8_LDB(B0, 0, 0); PG8_SCHED; PG8_LDA(At, 0, 0); PG8_STAGE(PG8_SA(1, 1), a1 + hstep, voffA);
            PG8_WAIT_L(8); PG8_BAR; PG8_WAIT_L(0); PG8_MMA(0, 0, At, B0); PG8_BAR; PG8_SCHED;
            PG8_LDB(B1, 0, 1); PG8_STAGE(PG8_SB(0, 0), b2, voffB);
            PG8_BAR; PG8_WAIT_L(0); PG8_MMA(0, 1, At, B1); PG8_BAR;
            PG8_LDA(At, 0, 1); PG8_STAGE(PG8_SA(0, 0), a2, voffA);
            PG8_BAR; PG8_WAIT_L(0); PG8_MMA(1, 0, At, B0); PG8_BAR; PG8_SCHED;
            PG8_STAGE(PG8_SB(0, 1), b2 + hstep, voffB);
            PG8_WAIT_V(6); PG8_BAR; PG8_MMA(1, 1, At, B1); PG8_BAR;
            PG8_LDB(B0, 1, 0); PG8_SCHED; PG8_LDA(At, 1, 0); PG8_STAGE(PG8_SA(0, 1), a2 + hstep, voffA);
            PG8_WAIT_L(8); PG8_BAR; PG8_WAIT_L(0); PG8_MMA(0, 0, At, B0); PG8_BAR; PG8_SCHED;
            PG8_LDB(B1, 1, 1); PG8_STAGE(PG8_SB(1, 0), b3, voffB);
            PG8_BAR; PG8_WAIT_L(0); PG8_MMA(0, 1, At, B1); PG8_BAR;
            PG8_LDA(At, 1, 1); PG8_STAGE(PG8_SA(1, 0), a3, voffA);
            PG8_BAR; PG8_WAIT_L(0); PG8_MMA(1, 0, At, B0); PG8_BAR; PG8_SCHED;
            PG8_STAGE(PG8_SB(1, 1), b3 + hstep, voffB);
            PG8_WAIT_V(6); PG8_BAR; PG8_MMA(1, 1, At, B1); PG8_BAR;
            }
        }
        if constexpr (ALIGN_EPI) { if (wr == 0) PG8_BAR; }
        if constexpr (!Epi::AFTER_DRAIN) { E(acc, cur, wr, wc, fr, fq); S.done(cur); }
        if (!has_next) break;
#pragma unroll
        for (int a = 0; a < 2; ++a)
#pragma unroll
            for (int b = 0; b < 2; ++b)
#pragma unroll
                for (int m = 0; m < 4; ++m)
#pragma unroll
                    for (int n = 0; n < 2; ++n) acc[a][b][m][n] = (f32x4){0.f, 0.f, 0.f, 0.f};
        cur = nxt; cA = nA; cB = nB; ++ui;
        if constexpr (ALIGN_EPI) { if (wr == 1) PG8_BAR; }
    }
    PG8_WAIT_V(0);
    if constexpr (!ALIGN_EPI) { if (wr == 0) PG8_BAR; }
    PG8_BAR;
    if constexpr (Epi::AFTER_DRAIN) { E.fused(acc, cur, wr, wc, fr, fq, lds, wid, lane); S.done(cur); }
#undef PG8_SA
#undef PG8_SB
#undef PG8_STAGE
#undef PG8_LDA
#undef PG8_LDB
#undef PG8_MMA
#undef PG8_WAIT_V
#undef PG8_WAIT_L
#undef PG8_BAR
#undef PG8_SCHED
}
}

constexpr int BATCH = 2, SEQ = 16384, DM = 2048, MTOK = BATCH * SEQ;
constexpr int HGH = 8, HGD = 128, HGW = 1024;
constexpr int ATH = 16, ATD = 64, ATW = 1024, WIN = 128;
constexpr int DIN = 9472, DFF = 8192;
constexpr float EPSF = 1e-6f;

#define LAS __attribute__((address_space(3)))
typedef unsigned short bf16;
typedef float f32x4 __attribute__((ext_vector_type(4)));
typedef unsigned u32x4 __attribute__((ext_vector_type(4)));
typedef unsigned u32x2 __attribute__((ext_vector_type(2)));

__device__ __forceinline__ float sigm(float x) { return __builtin_amdgcn_rcpf(1.f + __expf(-x)); }
__device__ __forceinline__ float bflo(unsigned w) { return __uint_as_float(w << 16); }
__device__ __forceinline__ float bfhi(unsigned w) { return __uint_as_float(w & 0xffff0000u); }
__device__ __forceinline__ unsigned pk2(float lo, float hi) { return pg8::cvt_pk_bf16(lo, hi); }

constexpr size_t WS_RS = 0;
constexpr size_t WS_LB = 131072;
constexpr size_t WS_PART = 262144;
constexpr size_t WS_W = WS_PART + (size_t)MTOK * 32 * 4;
constexpr size_t W_IN = 0, W_HG = W_IN + (size_t)DIN * DM * 2, W_AT = W_HG + (size_t)DM * HGW * 2, W_OUT = W_AT + (size_t)DM * ATW * 2,
                 W_UP = W_OUT + (size_t)DM * DM * 2, W_DN = W_UP + (size_t)DFF * DM * 2, W_LAYER = W_DN + (size_t)DM * DFF * 2;
constexpr size_t WS_XB = WS_W + 2 * W_LAYER;
constexpr size_t WS_Z = WS_XB + (size_t)MTOK * DM * 2;
constexpr size_t Z_QF = 0, Z_LOGF = Z_QF + (size_t)MTOK * 1024 * 2, Z_VI = Z_LOGF + (size_t)MTOK * 1024 * 4, Z_HGATE = Z_VI + (size_t)MTOK * 1024 * 2,
                 Z_AQ = Z_HGATE + (size_t)MTOK * 1024 * 2, Z_AKV = Z_AQ + (size_t)MTOK * 1024 * 2, Z_GH = Z_AKV + (size_t)MTOK * 256 * 2,
                 Z_GA = Z_GH + (size_t)MTOK * 2048 * 2, Z_END = Z_GA + (size_t)MTOK * 2048 * 2;
constexpr size_t Z_T1 = 0, Z_MIX = (size_t)MTOK * 2048 * 2;
constexpr size_t Z_U = 0;
constexpr size_t WS_END = WS_Z + Z_END;
static_assert(Z_MIX + (size_t)MTOK * 2048 * 2 <= Z_HGATE, "T1|MIX overlay");
static_assert((size_t)MTOK * DFF * 2 <= Z_END, "U overlay");
static_assert(WS_END <= 1073741824ull, "workspace");

constexpr int LDS_BYTES = 147456;
#ifndef PH
#define PH 0xFFFF
#endif
#define ON(k) ((PH >> (k)) & 1)

namespace pg8 {
struct EpiIn {
    static constexpr bool PERM = true, AFTER_DRAIN = false;
    const float* rs; const float* lb; unsigned char* Z;
    __device__ __forceinline__ void operator()(const f32x4 (&acc)[2][2][4][2], const Unit& u, int wr, int wc, int fr, int fq) const {
        const int pn = u.pn; int kind, ld, tb; size_t zo;
        if (pn < 4)       { kind = 0; zo = Z_QF;    ld = 1024; tb = pn * 256; }
        else if (pn < 8)  { kind = 1; zo = Z_LOGF;  ld = 1024; tb = (pn - 4) * 256; }
        else if (pn < 12) { kind = 2; zo = Z_VI;    ld = 1024; tb = (pn - 8) * 256; }
        else if (pn < 16) { kind = 0; zo = Z_HGATE; ld = 1024; tb = (pn - 12) * 256; }
        else if (pn < 20) { kind = 2; zo = Z_AQ;    ld = 1024; tb = (pn - 16) * 256; }
        else if (pn == 20){ kind = 2; zo = Z_AKV;   ld = 256;  tb = 0; }
        else if (pn < 29) { kind = 3; zo = Z_GH;    ld = 2048; tb = (pn - 21) * 256; }
        else              { kind = 3; zo = Z_GA;    ld = 2048; tb = (pn - 29) * 256; }
        const int row0 = u.pm * BM + wr * 64 + fr, col0 = tb + wc * 32 + 8 * fq;
        if (kind == 1) {
            float* LOGF = (float*)(Z + zo);
            f32x4 lbv[2][2];
#pragma unroll
            for (int bj = 0; bj < 2; ++bj)
#pragma unroll
                for (int n = 0; n < 2; ++n) lbv[bj][n] = *(const f32x4*)(lb + col0 + bj * HALF + 4 * n);
#pragma unroll
            for (int ai = 0; ai < 2; ++ai)
#pragma unroll
                for (int m = 0; m < 4; ++m) { const int row = row0 + ai * HALF + m * 16; const float s = rs[row]; float* rp = LOGF + (size_t)row * 1024 + col0;
#pragma unroll
                    for (int bj = 0; bj < 2; ++bj)
#pragma unroll
                        for (int n = 0; n < 2; ++n) { const f32x4 v = acc[ai][bj][m][n] * s; f32x4 o;
#pragma unroll
                            for (int e = 0; e < 4; ++e) { const float l = lbv[bj][n][e]; o[e] = __logf(l + (1.f - l) * sigm(v[e])); }
                            *(f32x4*)(rp + bj * HALF + 4 * n) = o; } }
        } else {
            bf16_t* dst = (bf16_t*)(Z + zo);
#pragma unroll
            for (int ai = 0; ai < 2; ++ai)
#pragma unroll
                for (int m = 0; m < 4; ++m) { const int row = row0 + ai * HALF + m * 16; const float s = rs[row]; bf16_t* rp = dst + (size_t)row * ld + col0;
#pragma unroll
                    for (int bj = 0; bj < 2; ++bj) { f32x4 v0 = acc[ai][bj][m][0] * s, v1 = acc[ai][bj][m][1] * s;
                        if (kind == 0) {
#pragma unroll
                            for (int e = 0; e < 4; ++e) { v0[e] = v0[e] * sigm(v0[e]); v1[e] = v1[e] * sigm(v1[e]); }
                        } else if (kind == 3) {
#pragma unroll
                            for (int e = 0; e < 4; ++e) { v0[e] = sigm(v0[e]); v1[e] = sigm(v1[e]); }
                        }
                        u32x4 w; w.x = cvt_pk_bf16(v0[0], v0[1]); w.y = cvt_pk_bf16(v0[2], v0[3]); w.z = cvt_pk_bf16(v1[0], v1[1]); w.w = cvt_pk_bf16(v1[2], v1[3]);
                        *(u32x4*)(rp + bj * HALF) = w; } }
        }
    }
};
template <int MODE> struct EpiGate {
    static constexpr bool PERM = true, AFTER_DRAIN = false;
    const bf16_t* gate; const bf16_t* t1; bf16_t* dst;
    __device__ __forceinline__ void operator()(const f32x4 (&acc)[2][2][4][2], const Unit& u, int wr, int wc, int fr, int fq) const {
        const int row0 = u.pm * BM + wr * 64 + fr, col0 = u.pn * BM + wc * 32 + 8 * fq;
#pragma unroll
        for (int ai = 0; ai < 2; ++ai)
#pragma unroll
            for (int m = 0; m < 4; ++m) { const size_t off = (size_t)(row0 + ai * HALF + m * 16) * 2048 + col0;
#pragma unroll
                for (int bj = 0; bj < 2; ++bj) { const u32x4 g = *(const u32x4*)(gate + off + bj * HALF);
                    f32x4 v0 = acc[ai][bj][m][0], v1 = acc[ai][bj][m][1];
                    v0[0] *= bflo(g.x); v0[1] *= bfhi(g.x); v0[2] *= bflo(g.y); v0[3] *= bfhi(g.y); v1[0] *= bflo(g.z); v1[1] *= bfhi(g.z); v1[2] *= bflo(g.w); v1[3] *= bfhi(g.w);
                    if (MODE == 1) { const u32x4 t = *(const u32x4*)(t1 + off + bj * HALF);
                        v0[0] += bflo(t.x); v0[1] += bfhi(t.x); v0[2] += bflo(t.y); v0[3] += bfhi(t.y); v1[0] += bflo(t.z); v1[1] += bfhi(t.z); v1[2] += bflo(t.w); v1[3] += bfhi(t.w); }
                    u32x4 w; w.x = cvt_pk_bf16(v0[0], v0[1]); w.y = cvt_pk_bf16(v0[2], v0[3]); w.z = cvt_pk_bf16(v1[0], v1[1]); w.w = cvt_pk_bf16(v1[2], v1[3]);
                    *(u32x4*)(dst + off + bj * HALF) = w; } }
    }
};
struct EpiRes {
    static constexpr bool PERM = true, AFTER_DRAIN = false;
    const float* resid; float* out; bf16_t* xb; float* part;
    __device__ __forceinline__ void operator()(const f32x4 (&acc)[2][2][4][2], const Unit& u, int wr, int wc, int fr, int fq) const {
        const int row0 = u.pm * BM + wr * 64 + fr, col0 = u.pn * BM + wc * 32 + 8 * fq;
#pragma unroll
        for (int ai = 0; ai < 2; ++ai)
#pragma unroll
            for (int m = 0; m < 4; ++m) { const int row = row0 + ai * HALF + m * 16; const size_t off = (size_t)row * 2048 + col0; float ss = 0.f;
#pragma unroll
                for (int bj = 0; bj < 2; ++bj) { const f32x4 r0 = *(const f32x4*)(resid + off + bj * HALF), r1 = *(const f32x4*)(resid + off + bj * HALF + 4);
                    const f32x4 o0 = r0 + acc[ai][bj][m][0], o1 = r1 + acc[ai][bj][m][1];
                    *(f32x4*)(out + off + bj * HALF) = o0; *(f32x4*)(out + off + bj * HALF + 4) = o1;
                    if (xb) { ss += (o0[0] * o0[0] + o0[1] * o0[1]) + (o0[2] * o0[2] + o0[3] * o0[3]) + (o1[0] * o1[0] + o1[1] * o1[1]) + (o1[2] * o1[2] + o1[3] * o1[3]);
                        u32x4 w; w.x = cvt_pk_bf16(o0[0], o0[1]); w.y = cvt_pk_bf16(o0[2], o0[3]); w.z = cvt_pk_bf16(o1[0], o1[1]); w.w = cvt_pk_bf16(o1[2], o1[3]);
                        *(u32x4*)(xb + off + bj * HALF) = w; } }
                if (xb) { ss += __shfl_xor(ss, 16); ss += __shfl_xor(ss, 32); if (fq == 0) part[(size_t)row * 32 + u.pn * 4 + wc] = ss; } }
    }
};
struct EpiUp {
    static constexpr bool PERM = true, AFTER_DRAIN = false;
    const float* rs; bf16_t* dst;
    __device__ __forceinline__ void operator()(const f32x4 (&acc)[2][2][4][2], const Unit& u, int wr, int wc, int fr, int fq) const {
        const int row0 = u.pm * BM + wr * 64 + fr, col0 = u.pn * BM + wc * 32 + 8 * fq;
#pragma unroll
        for (int ai = 0; ai < 2; ++ai)
#pragma unroll
            for (int m = 0; m < 4; ++m) { const int row = row0 + ai * HALF + m * 16; const float s = rs[row]; bf16_t* rp = dst + (size_t)row * DFF + col0;
#pragma unroll
                for (int bj = 0; bj < 2; ++bj) { f32x4 v0 = acc[ai][bj][m][0] * s, v1 = acc[ai][bj][m][1] * s;
#pragma unroll
                    for (int e = 0; e < 4; ++e) { const float a = fmaxf(v0[e], 0.f), b = fmaxf(v1[e], 0.f); v0[e] = a * a; v1[e] = b * b; }
                    u32x4 w; w.x = cvt_pk_bf16(v0[0], v0[1]); w.y = cvt_pk_bf16(v0[2], v0[3]); w.z = cvt_pk_bf16(v1[0], v1[1]); w.w = cvt_pk_bf16(v1[2], v1[3]);
                    *(u32x4*)(rp + bj * HALF) = w; } }
    }
};
}

__device__ __forceinline__ float wave_sum(float v) {
#pragma unroll
    for (int o = 1; o < 64; o <<= 1) v += __shfl_xor(v, o);
    return v;
}
__device__ __forceinline__ void transpose_item(const float* __restrict__ W, const float* __restrict__ gain, int K, int N, bf16* __restrict__ WT, LAS float* scr, int item, int lane) {
    const int nblk = N / 32, kb = item / nblk, nb = item % nblk, k0 = 64 * kb, n0 = 32 * nb;
#pragma unroll 8
    for (int i = 0; i < 32; ++i) { const int kk = 2 * i + (lane >> 5); const float g = gain ? gain[k0 + kk] : 1.f; scr[kk * 33 + (lane & 31)] = W[(size_t)(k0 + kk) * N + n0 + (lane & 31)] * g; }
    asm volatile("s_waitcnt lgkmcnt(0)" ::: "memory");
    const int c = lane & 7;
#pragma unroll
    for (int j = 0; j < 4; ++j) { const int n = (lane >> 3) + 8 * j; const LAS float* s = scr + (8 * c) * 33 + n;
        u32x4 o; o.x = pk2(s[0 * 33], s[1 * 33]); o.y = pk2(s[2 * 33], s[3 * 33]); o.z = pk2(s[4 * 33], s[5 * 33]); o.w = pk2(s[6 * 33], s[7 * 33]);
        *(u32x4*)(WT + (size_t)(n0 + n) * K + k0 + 8 * c) = o; }
    asm volatile("s_waitcnt lgkmcnt(0)" ::: "memory");
}

struct Args {
    const float *x, *norm_mix, *w_in, *lb_logits, *hg_norm, *q_norm, *k_norm, *sinks, *w_hg_out, *w_at_out, *w_out, *norm_ffn, *w_up, *w_down;
    float* out; unsigned char* ws;
};

__device__ __forceinline__ void hgrn2_seq(const bf16* __restrict__ QF, const float* __restrict__ LOGF, const bf16* __restrict__ VI, float* __restrict__ ORAW, int item, int tid) {
    const int bh = item >> 3, vs = item & 7, b = bh >> 3, h = bh & 7;
    const int lane = tid & 63, w = tid >> 6, kg = lane & 31, v = vs * 16 + w * 2 + (lane >> 5);
    const size_t rowbase = (size_t)b * SEQ;
    const int kc = h * 128 + kg * 4, vc = h * 128 + v;
    float S0 = 0.f, S1 = 0.f, S2 = 0.f, S3 = 0.f;
    f32x4 nlf[4]; u32x2 nq[4]; unsigned short nv[4];
#pragma unroll
    for (int j = 0; j < 4; ++j) { const size_t o = (rowbase + j) * 1024; nlf[j] = *(const f32x4*)(LOGF + o + kc); nq[j] = *(const u32x2*)(QF + o + kc); nv[j] = VI[o + vc]; }
    for (int t = 0; t < SEQ; t += 4) {
        f32x4 clf[4]; u32x2 cq[4]; unsigned short cv[4];
#pragma unroll
        for (int j = 0; j < 4; ++j) { clf[j] = nlf[j]; cq[j] = nq[j]; cv[j] = nv[j]; }
        if (t + 4 < SEQ) {
#pragma unroll
            for (int j = 0; j < 4; ++j) { const size_t o = (rowbase + t + 4 + j) * 1024; nlf[j] = *(const f32x4*)(LOGF + o + kc); nq[j] = *(const u32x2*)(QF + o + kc); nv[j] = VI[o + vc]; }
        }
#pragma unroll
        for (int j = 0; j < 4; ++j) {
            const float f0 = __expf(clf[j][0]), f1 = __expf(clf[j][1]), f2 = __expf(clf[j][2]), f3 = __expf(clf[j][3]);
            const float vv = __uint_as_float((unsigned)cv[j] << 16);
            S0 = f0 * S0 + (1.f - f0) * vv; S1 = f1 * S1 + (1.f - f1) * vv; S2 = f2 * S2 + (1.f - f2) * vv; S3 = f3 * S3 + (1.f - f3) * vv;
            float o = (bflo(cq[j].x) * S0 + bfhi(cq[j].x) * S1) + (bflo(cq[j].y) * S2 + bfhi(cq[j].y) * S3);
            o += __shfl_xor(o, 1); o += __shfl_xor(o, 2); o += __shfl_xor(o, 4); o += __shfl_xor(o, 8); o += __shfl_xor(o, 16);
            if (kg == 0) ORAW[(rowbase + t + j) * 1024 + vc] = o;
        }
    }
}

__device__ __forceinline__ void qk_norm_pass(bf16* AQ, bf16* AKV, const float* qn, const float* kn, int gtid, int NT) {
    const int sub = gtid & 7;
    f32x4 g0 = *(const f32x4*)(qn + sub * 8), g1 = *(const f32x4*)(qn + sub * 8 + 4);
    for (size_t c = gtid; c < (size_t)MTOK * 128; c += NT) {
        u32x4 w = *(u32x4*)(AQ + c * 8);
        float v[8] = {bflo(w.x), bfhi(w.x), bflo(w.y), bfhi(w.y), bflo(w.z), bfhi(w.z), bflo(w.w), bfhi(w.w)};
        float ss = 0.f;
#pragma unroll
        for (int e = 0; e < 8; ++e) ss += v[e] * v[e];
        ss += __shfl_xor(ss, 1); ss += __shfl_xor(ss, 2); ss += __shfl_xor(ss, 4);
        const float r = rsqrtf(ss * (1.f / 64.f) + EPSF) * 0.125f;
        u32x4 o; o.x = pk2(v[0] * r * g0[0], v[1] * r * g0[1]); o.y = pk2(v[2] * r * g0[2], v[3] * r * g0[3]); o.z = pk2(v[4] * r * g1[0], v[5] * r * g1[1]); o.w = pk2(v[6] * r * g1[2], v[7] * r * g1[3]);
        *(u32x4*)(AQ + c * 8) = o;
    }
    g0 = *(const f32x4*)(kn + sub * 8); g1 = *(const f32x4*)(kn + sub * 8 + 4);
    for (size_t c = gtid; c < (size_t)MTOK * 16; c += NT) {
        bf16* p = AKV + (c >> 4) * 256 + (c & 15) * 8;
        u32x4 w = *(u32x4*)p;
        float v[8] = {bflo(w.x), bfhi(w.x), bflo(w.y), bfhi(w.y), bflo(w.z), bfhi(w.z), bflo(w.w), bfhi(w.w)};
        float ss = 0.f;
#pragma unroll
        for (int e = 0; e < 8; ++e) ss += v[e] * v[e];
        ss += __shfl_xor(ss, 1); ss += __shfl_xor(ss, 2); ss += __shfl_xor(ss, 4);
        const float r = rsqrtf(ss * (1.f / 64.f) + EPSF);
        u32x4 o; o.x = pk2(v[0] * r * g0[0], v[1] * r * g0[1]); o.y = pk2(v[2] * r * g0[2], v[3] * r * g0[3]); o.z = pk2(v[4] * r * g1[0], v[5] * r * g1[1]); o.w = pk2(v[6] * r * g1[2], v[7] * r * g1[3]);
        *(u32x4*)p = o;
    }
}

__device__ __forceinline__ void hg_norm_pass(const float* __restrict__ ORAW, bf16* HGATE, const float* hn, int gtid, int NT) {
    const int sub = gtid & 15;
    const f32x4 g0 = *(const f32x4*)(hn + sub * 8), g1 = *(const f32x4*)(hn + sub * 8 + 4);
    for (size_t c = gtid; c < (size_t)MTOK * 128; c += NT) {
        const f32x4 a = *(const f32x4*)(ORAW + c * 8), b = *(const f32x4*)(ORAW + c * 8 + 4);
        float ss = (a[0] * a[0] + a[1] * a[1]) + (a[2] * a[2] + a[3] * a[3]) + (b[0] * b[0] + b[1] * b[1]) + (b[2] * b[2] + b[3] * b[3]);
        ss += __shfl_xor(ss, 1); ss += __shfl_xor(ss, 2); ss += __shfl_xor(ss, 4); ss += __shfl_xor(ss, 8);
        const float r = rsqrtf(ss * (1.f / 128.f) + EPSF);
        const u32x4 w = *(u32x4*)(HGATE + c * 8);
        u32x4 o; o.x = pk2(a[0] * r * g0[0] * bflo(w.x), a[1] * r * g0[1] * bfhi(w.x)); o.y = pk2(a[2] * r * g0[2] * bflo(w.y), a[3] * r * g0[3] * bfhi(w.y));
        o.z = pk2(b[0] * r * g1[0] * bflo(w.z), b[1] * r * g1[1] * bfhi(w.z)); o.w = pk2(b[2] * r * g1[2] * bflo(w.w), b[3] * r * g1[3] * bfhi(w.w));
        *(u32x4*)(HGATE + c * 8) = o;
    }
}

__device__ __forceinline__ void attn_simple(bf16* AQ, const bf16* __restrict__ AKV, const float* __restrict__ sinks, int gtid, int NT) {
    for (int i = gtid; i < MTOK * ATH; i += NT) {
        const int token = i >> 4, h = i & 15, t = token & (SEQ - 1), kvh = h >> 3;
        float q[64], o[64];
        bf16* qp = AQ + (size_t)token * 1024 + h * 64;
#pragma unroll
        for (int j = 0; j < 8; ++j) { const u32x4 w = *(const u32x4*)(qp + j * 8);
            q[j * 8 + 0] = bflo(w.x); q[j * 8 + 1] = bfhi(w.x); q[j * 8 + 2] = bflo(w.y); q[j * 8 + 3] = bfhi(w.y); q[j * 8 + 4] = bflo(w.z); q[j * 8 + 5] = bfhi(w.z); q[j * 8 + 6] = bflo(w.w); q[j * 8 + 7] = bfhi(w.w); }
#pragma unroll
        for (int d = 0; d < 64; ++d) o[d] = 0.f;
        const float slope = exp2f(-0.5f * (float)(h + 1));
        float mx = sinks[h], l = 1.f;
        const int nk = t < WIN - 1 ? t + 1 : WIN;
        const bf16* kp = AKV + (size_t)(token - nk + 1) * 256 + kvh * 64;
        for (int s = 0; s < nk; ++s, kp += 256) {
            float d0 = 0.f, d1 = 0.f;
#pragma unroll
            for (int j = 0; j < 8; ++j) { const u32x4 w = *(const u32x4*)(kp + j * 8);
                d0 += q[j * 8 + 0] * bflo(w.x) + q[j * 8 + 2] * bflo(w.y) + q[j * 8 + 4] * bflo(w.z) + q[j * 8 + 6] * bflo(w.w);
                d1 += q[j * 8 + 1] * bfhi(w.x) + q[j * 8 + 3] * bfhi(w.y) + q[j * 8 + 5] * bfhi(w.z) + q[j * 8 + 7] * bfhi(w.w); }
            const float sc = (d0 + d1) - slope * (float)(nk - 1 - s);
            if (sc > mx) { const float al = __expf(mx - sc); l *= al;
#pragma unroll
                for (int d = 0; d < 64; ++d) o[d] *= al;
                mx = sc; }
            const float p = __expf(sc - mx); l += p;
#pragma unroll
            for (int j = 0; j < 8; ++j) { const u32x4 w = *(const u32x4*)(kp + 128 + j * 8);
                o[j * 8 + 0] += p * bflo(w.x); o[j * 8 + 1] += p * bfhi(w.x); o[j * 8 + 2] += p * bflo(w.y); o[j * 8 + 3] += p * bfhi(w.y);
                o[j * 8 + 4] += p * bflo(w.z); o[j * 8 + 5] += p * bfhi(w.z); o[j * 8 + 6] += p * bflo(w.w); o[j * 8 + 7] += p * bfhi(w.w); }
        }
        const float inv = 1.f / l;
#pragma unroll
        for (int j = 0; j < 8; ++j) { u32x4 w; w.x = pk2(o[j * 8 + 0] * inv, o[j * 8 + 1] * inv); w.y = pk2(o[j * 8 + 2] * inv, o[j * 8 + 3] * inv); w.z = pk2(o[j * 8 + 4] * inv, o[j * 8 + 5] * inv); w.w = pk2(o[j * 8 + 6] * inv, o[j * 8 + 7] * inv);
            *(u32x4*)(qp + j * 8) = w; }
    }
}

__device__ __forceinline__ void rowstats_pass(const float* __restrict__ part, float* __restrict__ rs, int gtid, int NT) {
    for (int r = gtid; r < MTOK; r += NT) { const f32x4* p = (const f32x4*)(part + (size_t)r * 32); float s = 0.f;
#pragma unroll
        for (int j = 0; j < 8; ++j) { const f32x4 v = p[j]; s += (v[0] + v[1]) + (v[2] + v[3]); }
        rs[r] = rsqrtf(s * (1.f / DM) + EPSF); }
}

__device__ __forceinline__ const Args* kargs() { const Args* p = (const Args*)__builtin_amdgcn_kernarg_segment_ptr(); asm volatile("" : "+s"(p)); return p; }
#define ZP(off) (ka->ws + WS_Z + (off))
#define WL(off) ((const bf16*)(ka->ws + WS_W + (size_t)l * W_LAYER + (off)))
__global__ void __launch_bounds__(512, 2) fwd_mega(Args a_unused) {
    extern __shared__ __attribute__((aligned(16))) unsigned char lds_raw[];
    LAS unsigned char* lds = (LAS unsigned char*)lds_raw;
    cg::grid_group grid = cg::this_grid();
    const int G = gridDim.x, bx = blockIdx.x;
#define TIDS int tid_ = threadIdx.x; asm volatile("" : "+v"(tid_)); const int tid = tid_, lane = tid & 63, wave = __builtin_amdgcn_readfirstlane(tid >> 6), gw = bx * 8 + wave, NGW = G * 8, gtid = bx * 512 + tid, NT = G * 512; (void)lane; (void)gw; (void)NGW; (void)gtid; (void)NT;

    {
        const Args* ka = kargs(); TIDS
        unsigned char* ws = ka->ws; float* RS = (float*)(ws + WS_RS); float* LB = (float*)(ws + WS_LB); bf16* XB = (bf16*)(ws + WS_XB);
        LAS float* scr = (LAS float*)(lds + wave * 16384);
        constexpr int I_IN = (DM / 64) * (DIN / 32), I_HG = (HGW / 64) * (DM / 32), I_AT = (ATW / 64) * (DM / 32), I_OUT = (DM / 64) * (DM / 32), I_UP = (DM / 64) * (DFF / 32), I_DN = (DFF / 64) * (DM / 32);
        constexpr int I_LAYER = I_IN + I_HG + I_AT + I_OUT + I_UP + I_DN;
        for (int it = gw; it < 2 * I_LAYER; it += NGW) {
            const int l = it >= I_LAYER ? 1 : 0; int r = it - l * I_LAYER; unsigned char* wl = ws + WS_W + (size_t)l * W_LAYER;
            if (r < I_IN) { transpose_item(ka->w_in + (size_t)l * DM * DIN, ka->norm_mix + l * DM, DM, DIN, (bf16*)(wl + W_IN), scr, r, lane); continue; } r -= I_IN;
            if (r < I_HG) { transpose_item(ka->w_hg_out + (size_t)l * HGW * DM, nullptr, HGW, DM, (bf16*)(wl + W_HG), scr, r, lane); continue; } r -= I_HG;
            if (r < I_AT) { transpose_item(ka->w_at_out + (size_t)l * ATW * DM, nullptr, ATW, DM, (bf16*)(wl + W_AT), scr, r, lane); continue; } r -= I_AT;
            if (r < I_OUT) { transpose_item(ka->w_out + (size_t)l * DM * DM, nullptr, DM, DM, (bf16*)(wl + W_OUT), scr, r, lane); continue; } r -= I_OUT;
            if (r < I_UP) { transpose_item(ka->w_up + (size_t)l * DM * DFF, ka->norm_ffn + l * DM, DM, DFF, (bf16*)(wl + W_UP), scr, r, lane); continue; } r -= I_UP;
            transpose_item(ka->w_down + (size_t)l * DFF * DM, nullptr, DFF, DM, (bf16*)(wl + W_DN), scr, r, lane);
        }
        for (int c = gtid; c < 1024; c += NT) { LB[c] = 0.f; LB[1024 + c] = sigm(ka->lb_logits[1024 + c] - ka->lb_logits[c]); }
        const float* x = ka->x;
        for (int m = gw; m < MTOK; m += NGW) {
            const f32x4* xr = (const f32x4*)(x + (size_t)m * DM) + lane; f32x4 v[8]; float s = 0.f;
#pragma unroll
            for (int j = 0; j < 8; ++j) { v[j] = xr[64 * j]; s += (v[j][0] * v[j][0] + v[j][1] * v[j][1]) + (v[j][2] * v[j][2] + v[j][3] * v[j][3]); }
            s = wave_sum(s);
            if (lane == 0) RS[m] = rsqrtf(s * (1.f / DM) + EPSF);
            u32x2* o8 = (u32x2*)(XB + (size_t)m * DM) + lane;
#pragma unroll
            for (int j = 0; j < 8; ++j) { u32x2 w; w.x = pk2(v[j][0], v[j][1]); w.y = pk2(v[j][2], v[j][3]); o8[64 * j] = w; }
        }
    }
    grid.sync();

    for (int l = 0; l < 2; ++l) {
        if (ON(1)) {
            const Args* ka = kargs();
            pg8::Gemm g{(const bf16*)(ka->ws + WS_XB), WL(W_IN), MTOK, DIN, DM}; pg8::StaticOrder S; S.init(MTOK, DIN, G, bx);
            pg8::EpiIn E{(const float*)(ka->ws + WS_RS), (const float*)(ka->ws + WS_LB) + l * 1024, ka->ws + WS_Z};
            pg8::gemm_phase<pg8::EpiIn, pg8::StaticOrder, true, true>(lds, g, S, E);
        }
        grid.sync();
        {
            const Args* ka = kargs(); TIDS
            if (ON(2)) for (int item = bx; item < 128; item += G) hgrn2_seq((const bf16*)ZP(Z_QF), (const float*)ZP(Z_LOGF), (const bf16*)ZP(Z_VI), (float*)(ka->ws + WS_XB), item, tid);
            if (ON(3)) { if (G > 128) { if (bx >= 128) qk_norm_pass((bf16*)ZP(Z_AQ), (bf16*)ZP(Z_AKV), ka->q_norm + l * 64, ka->k_norm + l * 64, (bx - 128) * 512 + tid, (G - 128) * 512); }
                         else qk_norm_pass((bf16*)ZP(Z_AQ), (bf16*)ZP(Z_AKV), ka->q_norm + l * 64, ka->k_norm + l * 64, gtid, NT); }
        }
        grid.sync();
        {
            const Args* ka = kargs(); TIDS
            if (ON(4)) hg_norm_pass((const float*)(ka->ws + WS_XB), (bf16*)ZP(Z_HGATE), ka->hg_norm + l * 128, gtid, NT);
            if (ON(5)) attn_simple((bf16*)ZP(Z_AQ), (const bf16*)ZP(Z_AKV), ka->sinks + l * 16, gtid, NT);
        }
        grid.sync();
        if (ON(6)) {
            const Args* ka = kargs();
            pg8::Gemm g{(const bf16*)ZP(Z_HGATE), WL(W_HG), MTOK, DM, HGW}; pg8::StaticOrder S; S.init(MTOK, DM, G, bx);
            pg8::EpiGate<0> E{(const bf16*)ZP(Z_GH), nullptr, (bf16*)ZP(Z_T1)};
            pg8::gemm_phase<pg8::EpiGate<0>, pg8::StaticOrder, true, true>(lds, g, S, E);
        }
        if (ON(7)) {
            const Args* ka = kargs();
            pg8::Gemm g{(const bf16*)ZP(Z_AQ), WL(W_AT), MTOK, DM, ATW}; pg8::StaticOrder S; S.init(MTOK, DM, G, bx);
            pg8::EpiGate<1> E{(const bf16*)ZP(Z_GA), (const bf16*)ZP(Z_T1), (bf16*)ZP(Z_MIX)};
            pg8::gemm_phase<pg8::EpiGate<1>, pg8::StaticOrder, true, true>(lds, g, S, E);
        }
        grid.sync();
        if (ON(8)) {
            const Args* ka = kargs();
            pg8::Gemm g{(const bf16*)ZP(Z_MIX), WL(W_OUT), MTOK, DM, DM}; pg8::StaticOrder S; S.init(MTOK, DM, G, bx);
            pg8::EpiRes E{l == 0 ? ka->x : (const float*)ka->out, ka->out, (bf16*)(ka->ws + WS_XB), (float*)(ka->ws + WS_PART)};
            pg8::gemm_phase<pg8::EpiRes, pg8::StaticOrder, true, true>(lds, g, S, E);
        }
        grid.sync();
        { const Args* ka = kargs(); TIDS rowstats_pass((const float*)(ka->ws + WS_PART), (float*)(ka->ws + WS_RS), gtid, NT); }
        grid.sync();
        if (ON(9)) {
            const Args* ka = kargs();
            pg8::Gemm g{(const bf16*)(ka->ws + WS_XB), WL(W_UP), MTOK, DFF, DM}; pg8::StaticOrder S; S.init(MTOK, DFF, G, bx);
            pg8::EpiUp E{(const float*)(ka->ws + WS_RS), (bf16*)ZP(Z_U)};
            pg8::gemm_phase<pg8::EpiUp, pg8::StaticOrder, true, true>(lds, g, S, E);
        }
        grid.sync();
        if (ON(10)) {
            const Args* ka = kargs();
            pg8::Gemm g{(const bf16*)ZP(Z_U), WL(W_DN), MTOK, DM, DFF}; pg8::StaticOrder S; S.init(MTOK, DM, G, bx);
            pg8::EpiRes E{ka->out, ka->out, l == 0 ? (bf16*)(ka->ws + WS_XB) : nullptr, (float*)(ka->ws + WS_PART)};
            pg8::gemm_phase<pg8::EpiRes, pg8::StaticOrder, true, true>(lds, g, S, E);
        }
        if (l == 0) { grid.sync(); { const Args* ka = kargs(); TIDS rowstats_pass((const float*)(ka->ws + WS_PART), (float*)(ka->ws + WS_RS), gtid, NT); } grid.sync(); }
    }
}

extern "C" void kernel_launch(void* const* d_in, const int* in_sizes, int n_in, void* d_out, int out_size, void* d_ws, size_t ws_size, hipStream_t stream) {
    static int grid = 0;
    if (grid == 0) {
        if (n_in != 14 || out_size != MTOK * DM || ws_size < WS_END) { fprintf(stderr, "kernel_launch: unexpected shapes (n_in %d out %d ws %zu need %zu)\n", n_in, out_size, ws_size, (size_t)WS_END); grid = -1; return; }
        int dev = 0, cus = 0, per_cu = 0;
        (void)hipGetDevice(&dev); (void)hipDeviceGetAttribute(&cus, hipDeviceAttributeMultiprocessorCount, dev);
        if (hipFuncSetAttribute((const void*)fwd_mega, hipFuncAttributeMaxDynamicSharedMemorySize, LDS_BYTES) != hipSuccess) { fprintf(stderr, "hipFuncSetAttribute failed\n"); grid = -1; return; }
        if (hipOccupancyMaxActiveBlocksPerMultiprocessor(&per_cu, (const void*)fwd_mega, 512, LDS_BYTES) != hipSuccess || per_cu < 1) { fprintf(stderr, "occupancy query: %d\n", per_cu); per_cu = 1; }
        (void)hipGetLastError();
        grid = cus * 1;
    }
    if (grid < 0) return;
    Args a{};
    a.x = (const float*)d_in[0]; a.norm_mix = (const float*)d_in[1]; a.w_in = (const float*)d_in[2]; a.lb_logits = (const float*)d_in[3]; a.hg_norm = (const float*)d_in[4];
    a.q_norm = (const float*)d_in[5]; a.k_norm = (const float*)d_in[6]; a.sinks = (const float*)d_in[7]; a.w_hg_out = (const float*)d_in[8]; a.w_at_out = (const float*)d_in[9];
    a.w_out = (const float*)d_in[10]; a.norm_ffn = (const float*)d_in[11]; a.w_up = (const float*)d_in[12]; a.w_down = (const float*)d_in[13];
    a.out = (float*)d_out; a.ws = (unsigned char*)d_ws;
    void* args[] = {&a};
    hipError_t e = hipLaunchCooperativeKernel((const void*)fwd_mega, dim3(grid), dim3(512), args, LDS_BYTES, stream);
    if (e != hipSuccess) fprintf(stderr, "cooperative launch failed: %s (grid %d)\n", hipGetErrorString(e), grid);
}
```

```cpp
#include <hip/hip_runtime.h>
#include <hip/hip_cooperative_groups.h>
#include <cstdio>
#include <cstdint>
namespace cg = cooperative_groups;
namespace pg8 {
#define PG8_LAS __attribute__((address_space(3)))
typedef unsigned short bf16_t;
typedef short bf16x8 __attribute__((ext_vector_type(8)));
typedef float f32x4 __attribute__((ext_vector_type(4)));
typedef unsigned u32x4 __attribute__((ext_vector_type(4)));
constexpr int BM = 256, BK = 64, HALF = 128, HTB = HALF * BK * 2  , STAGE_BYTES = 8 * HTB, NXCD = 8, WGM = 8;

__host__ __device__ __forceinline__ int lds_byte(int r, int c) { const int st = (r >> 4) * 2 + (c >> 5), rr = r & 15, cc = c & 31, ob = rr * 64 + cc * 2; return st * 1024 + (ob ^ (((ob >> 9) & 1) << 5)); }
__host__ __device__ __forceinline__ void stage_rc(int b, int& R, int& C) { const int st = b / 1024, sb = b % 1024, swz = sb ^ (((sb >> 9) & 1) << 5); R = (st >> 1) * 16 + swz / 64; C = (st & 1) * 32 + (swz % 64) / 2; }
__host__ __device__ __forceinline__ int perm32(int rho) { const int n = rho >> 4, i = rho & 15; return 8 * (i >> 2) + 4 * n + (i & 3); }

struct Unit { int pm, pn; };
struct Gemm { const bf16_t* A; const bf16_t* Bt; int M, N, K; };

struct StaticOrder {
    int nM, nN, nwg, G, c;
    __host__ __device__ void init(int M, int N, int G_, int c_) { nM = M / BM; nN = N / BM; nwg = nM * nN; G = G_; c = c_; }
    __host__ __device__ bool next(int i, Unit& u) const {
        const long L = (long)i * G + c; if (L >= nwg) return false;
        int wgid = (int)L; { const int q = nwg / NXCD, r = nwg % NXCD, xcd = wgid % NXCD, off = wgid / NXCD; wgid = (xcd < r ? xcd * (q + 1) : r * (q + 1) + (xcd - r) * q) + off; }
        const int nig = WGM * nN, gid = wgid / nig, fm = gid * WGM, gsz = (nM - fm) < WGM ? (nM - fm) : WGM;
        u.pm = fm + ((wgid % nig) % gsz); u.pn = (wgid % nig) / gsz; return true;
    }
    __device__ __forceinline__ void a_ready(const Unit&) const {}
    __device__ __forceinline__ void done(const Unit&) const {}
};
__device__ __forceinline__ unsigned cvt_pk_bf16(float lo, float hi) { unsigned r; asm volatile("v_cvt_pk_bf16_f32 %0, %1, %2" : "=v"(r) : "v"(lo), "v"(hi)); return r; }
typedef float f32x2 __attribute__((ext_vector_type(2)));
template <class Epi, class Sched, bool ALIGN_EPI = false, bool SP2 = false>
__device__ __forceinline__ void gemm_phase(PG8_LAS unsigned char* lds, const Gemm g, const Sched& S, const Epi& E) {
    int tid_ = threadIdx.x; asm volatile("" : "+v"(tid_));
    const int tid = tid_, wid = __builtin_amdgcn_readfirstlane(tid >> 6), lane = tid & 63, wr = wid >> 2, wc = wid & 3, fr = lane & 15, fq = lane >> 4;
    const int K = g.K, nt = K / BK;
    unsigned voffA[2], voffB[2];
#pragma unroll
    for (int i = 0; i < 2; ++i) { int R, C; stage_rc(tid * 16 + i * 8192, R, C); const int Rb = Epi::PERM ? ((R & ~31) + perm32(R & 31)) : R;
        voffA[i] = (unsigned)(R * K + C) * 2u; voffB[i] = (unsigned)(Rb * K + C) * 2u; }
    const size_t kstep = (size_t)(BK * 2);
    const size_t hstep = (size_t)HALF * K * 2;
    const size_t tstep = 2 * hstep;
    const unsigned ldsw = (unsigned)wid * 1024u;
    const int aoff = lds_byte(wr * 64 + fr, fq * 8), boff = lds_byte(wc * 32 + fr, fq * 8);
#define PG8_SA(b, h) (((b) * 2 + (h)) * HTB)
#define PG8_SB(b, h) ((4 + (b) * 2 + (h)) * HTB)
#define PG8_STAGE(bufoff, gbase, voff) do { _Pragma("unroll") for (int _i = 0; _i < 2; ++_i) \
        __builtin_amdgcn_global_load_lds((const unsigned*)((const char*)(gbase) + (voff)[_i]), (PG8_LAS unsigned*)(lds + (bufoff) + ldsw + _i * 8192), 16, 0, 0); } while (0)
#define PG8_LDA(dst, b, h) do { _Pragma("unroll") for (int m = 0; m < 4; ++m) _Pragma("unroll") for (int k = 0; k < 2; ++k) dst[m][k] = *(const PG8_LAS bf16x8*)(lds + PG8_SA(b, h) + aoff + m * 2048 + k * 1024); } while (0)
#define PG8_LDB(dst, b, h) do { _Pragma("unroll") for (int n = 0; n < 2; ++n) _Pragma("unroll") for (int k = 0; k < 2; ++k) dst[n][k] = *(const PG8_LAS bf16x8*)(lds + PG8_SB(b, h) + boff + n * 2048 + k * 1024); } while (0)
#define PG8_MMA(ai, bj, At, Bt) do { __builtin_amdgcn_s_setprio(1); _Pragma("unroll") for (int m = 0; m < 4; ++m) _Pragma("unroll") for (int n = 0; n < 2; ++n) _Pragma("unroll") for (int k = 0; k < 2; ++k) \
        acc[ai][bj][m][n] = __builtin_amdgcn_mfma_f32_16x16x32_bf16(Bt[n][k], At[m][k], acc[ai][bj][m][n], 0, 0, 0); __builtin_amdgcn_s_setprio(0); } while (0)
#define PG8_WAIT_V(n) asm volatile("s_waitcnt vmcnt(" #n ")" ::: "memory")
#define PG8_WAIT_L(n) asm volatile("s_waitcnt lgkmcnt(" #n ")" ::: "memory")
#define PG8_BAR __builtin_amdgcn_s_barrier()
#define PG8_SCHED __builtin_amdgcn_sched_barrier(0)
    Unit cur, nxt; int ui = 0;
    if (!S.next(0, cur)) return;
    f32x4 acc[2][2][4][2];
#pragma unroll
    for (int a = 0; a < 2; ++a)
#pragma unroll
        for (int b = 0; b < 2; ++b)
#pragma unroll
            for (int m = 0; m < 4; ++m)
#pragma unroll
                for (int n = 0; n < 2; ++n) acc[a][b][m][n] = (f32x4){0.f, 0.f, 0.f, 0.f};
    bf16x8 At[4][2], B0[2][2], B1[2][2];
    const char* cA = (const char*)g.A + (size_t)cur.pm * tstep; const char* cB = (const char*)g.Bt + (size_t)cur.pn * tstep;
    S.a_ready(cur);
    if constexpr (SP2) {
        PG8_STAGE(PG8_SB(0, 0), cB, voffB); PG8_STAGE(PG8_SB(0, 1), cB + hstep, voffB); PG8_STAGE(PG8_SA(0, 0), cA, voffA); PG8_STAGE(PG8_SA(0, 1), cA + hstep, voffA);
        if (wr == 1) PG8_BAR;
        PG8_WAIT_V(2); PG8_BAR;
        PG8_STAGE(PG8_SB(1, 0), cB + kstep, voffB); PG8_STAGE(PG8_SA(1, 0), cA + kstep, voffA); PG8_STAGE(PG8_SB(1, 1), cB + hstep + kstep, voffB);
        PG8_WAIT_V(6); PG8_BAR;
    } else {
        PG8_STAGE(PG8_SB(0, 0), cB, voffB); PG8_STAGE(PG8_SA(0, 0), cA, voffA); PG8_STAGE(PG8_SB(0, 1), cB + hstep, voffB); PG8_STAGE(PG8_SA(0, 1), cA + hstep, voffA);
        if (wr == 1) PG8_BAR;
        PG8_WAIT_V(4); PG8_BAR;
        PG8_STAGE(PG8_SB(1, 0), cB + kstep, voffB); PG8_STAGE(PG8_SA(1, 0), cA + kstep, voffA); PG8_STAGE(PG8_SB(1, 1), cB + hstep + kstep, voffB);
        PG8_WAIT_V(6); PG8_BAR;
    }
    for (;;) {
        const bool has_next = S.next(ui + 1, nxt);
        const char* nA = has_next ? (const char*)g.A + (size_t)nxt.pm * tstep : cA; const char* nB = has_next ? (const char*)g.Bt + (size_t)nxt.pn * tstep : cB;
        for (int t = 0; t < nt; t += 2) {
            const bool last = (t == nt - 2);
            const char* a1 = cA + (size_t)(t + 1) * kstep;
            const char* a2 = last ? nA : cA + (size_t)(t + 2) * kstep; const char* b2 = last ? nB : cB + (size_t)(t + 2) * kstep;
            const char* a3 = a2 + kstep; const char* b3 = b2 + kstep;
            if (last && has_next) S.a_ready(nxt);
            if constexpr (SP2) {
            PG8_LDB(B0, 0, 0); PG8_LDB(B1, 0, 1); PG8_SCHED; PG8_LDA(At, 0, 0); PG8_STAGE(PG8_SA(1, 1), a1 + hstep, voffA);
            PG8_WAIT_V(8); PG8_WAIT_L(0); PG8_BAR; PG8_MMA(0, 0, At, B0); PG8_MMA(0, 1, At, B1); PG8_BAR; PG8_SCHED;
            PG8_LDA(At, 0, 1); PG8_STAGE(PG8_SB(0, 0), b2, voffB); PG8_STAGE(PG8_SB(0, 1), b2 + hstep, voffB); PG8_STAGE(PG8_SA(0, 0), a2, voffA);
            PG8_WAIT_V(8); PG8_WAIT_L(0); PG8_BAR; PG8_MMA(1, 0, At, B0); PG8_MMA(1, 1, At, B1); PG8_BAR; PG8_SCHED;
            PG8_LDB(B0, 1, 0); PG8_LDB(B1, 1, 1); PG8_SCHED; PG8_LDA(At, 1, 0); PG8_STAGE(PG8_SA(0, 1), a2 + hstep, voffA);
            PG8_WAIT_V(8); PG8_WAIT_L(0); PG8_BAR; PG8_MMA(0, 0, At, B0); PG8_MMA(0, 1, At, B1); PG8_BAR; PG8_SCHED;
            PG8_LDA(At, 1, 1); PG8_STAGE(PG8_SB(1, 0), b3, voffB); PG8_STAGE(PG8_SB(1, 1), b3 + hstep, voffB); PG8_STAGE(PG8_SA(1, 0), a3, voffA);
            PG8_WAIT_V(8); PG8_WAIT_L(0); PG8_BAR; PG8_MMA(1, 0, At, B0); PG8_MMA(1, 1, At, B1); PG8_BAR; PG8_SCHED;
            } else {
            PG8_LDB(B0, 0, 0); PG8_SCHED; PG8_LDA(At, 0, 0); PG8_STAGE(PG8_SA(1, 1), a1 + hstep, voffA);
            PG8_WAIT_L(8); PG8_BAR; PG8_WAIT_L(0); PG8_MMA(0, 0, At, B0); PG8_BAR; PG8_SCHED;
            PG8_LDB(B1, 0, 1); PG8_STAGE(PG8_SB(0, 0), b2, voffB);
            PG8_BAR; PG8_WAIT_L(0); PG8_MMA(0, 1, At, B1); PG8_BAR;
            PG8_LDA(At, 0, 1); PG8_STAGE(PG8_SA(0, 0), a2, voffA);
            PG8_BAR; PG8_WAIT_L(0); PG8_MMA(1, 0, At, B0); PG8_BAR; PG8_SCHED;
            PG8_STAGE(PG8_SB(0, 1), b2 + hstep, voffB);
            PG8_WAIT_V(6); PG8_BAR; PG8_MMA(1, 1, At, B1); PG8_BAR;
            PG8_LDB(B0, 1, 0); PG8_SCHED; PG8_LDA(At, 1, 0); PG8_STAGE(PG8_SA(0, 1), a2 + hstep, voffA);
            PG8_WAIT_L(8); PG8_BAR; PG8_WAIT_L(0); PG8_MMA(0, 0, At, B0); PG8_BAR; PG8_SCHED;
            PG8_LDB(B1, 1, 1); PG8_STAGE(PG8_SB(1, 0), b3, voffB);
            PG8_BAR; PG8_WAIT_L(0); PG8_MMA(0, 1, At, B1); PG8_BAR;
            PG8_LDA(At, 1, 1); PG8_STAGE(PG8_SA(1, 0), a3, voffA);
            PG8_BAR; PG8_WAIT_L(0); PG8_MMA(1, 0, At, B0); PG8_BAR; PG8_SCHED;
            PG8_STAGE(PG8_SB(1, 1), b3 + hstep, voffB);
            PG8_WAIT_V(6); PG8_BAR; PG8_MMA(1, 1, At, B1); PG8_BAR;
            }
        }
        if constexpr (ALIGN_EPI) { if (wr == 0) PG8_BAR; }
        if constexpr (!Epi::AFTER_DRAIN) { E(acc, cur, wr, wc, fr, fq); S.done(cur); }
        if (!has_next) break;
#pragma unroll
        for (int a = 0; a < 2; ++a)
#pragma unroll
            for (int b = 0; b < 2; ++b)
#pragma unroll
                for (int m = 0; m < 4; ++m)
#pragma unroll
                    for (int n = 0; n < 2; ++n) acc[a][b][m][n] = (f32x4){0.f, 0.f, 0.f, 0.f};
        cur = nxt; cA = nA; cB = nB; ++ui;
        if constexpr (ALIGN_EPI) { if (wr == 1) PG8_BAR; }
    }
    PG8_WAIT_V(0);
    if constexpr (!ALIGN_EPI) { if (wr == 0) PG8_BAR; }
    PG8_BAR;
    if constexpr (Epi::AFTER_DRAIN) { E.fused(acc, cur, wr, wc, fr, fq, lds, wid, lane); S.done(cur); }
#undef PG8_SA
#undef PG8_SB
#undef PG8_STAGE
#undef PG8_LDA
#undef PG8_LDB
#undef PG8_MMA
#undef PG8_WAIT_V
#undef PG8_WAIT_L
#undef PG8_BAR
#undef PG8_SCHED
}
}

constexpr int BATCH = 2, SEQ = 16384, DM = 2048, MTOK = BATCH * SEQ;
constexpr int HGH = 8, HGD = 128, HGW = 1024;
constexpr int ATH = 16, ATD = 64, ATW = 1024, WIN = 128;
constexpr int DIN = 9472, DFF = 8192;
constexpr float EPSF = 1e-6f;

#define LAS __attribute__((address_space(3)))
typedef unsigned short bf16;
typedef float f32x4 __attribute__((ext_vector_type(4)));
typedef unsigned u32x4 __attribute__((ext_vector_type(4)));
typedef unsigned u32x2 __attribute__((ext_vector_type(2)));

__device__ __forceinline__ float sigm(float x) { return __builtin_amdgcn_rcpf(1.f + __expf(-x)); }
__device__ __forceinline__ float bflo(unsigned w) { return __uint_as_float(w << 16); }
__device__ __forceinline__ float bfhi(unsigned w) { return __uint_as_float(w & 0xffff0000u); }
typedef __bf16 bf16x2_t __attribute__((ext_vector_type(2)));
typedef float f32x2_t __attribute__((ext_vector_type(2)));
__device__ __forceinline__ unsigned pk2(float lo, float hi) { const f32x2_t v = {lo, hi}; const bf16x2_t b = __builtin_convertvector(v, bf16x2_t); return __builtin_bit_cast(unsigned, b); }

constexpr size_t WS_RS = 0;
constexpr size_t WS_LB = 131072;
constexpr size_t WS_PART = 262144;
constexpr size_t WS_W = WS_PART + (size_t)MTOK * 32 * 4;
constexpr size_t W_IN = 0, W_HG = W_IN + (size_t)DIN * DM * 2, W_AT = W_HG + (size_t)DM * HGW * 2, W_OUT = W_AT + (size_t)DM * ATW * 2,
                 W_UP = W_OUT + (size_t)DM * DM * 2, W_DN = W_UP + (size_t)DFF * DM * 2, W_LAYER = W_DN + (size_t)DM * DFF * 2;
constexpr size_t WS_XB = WS_W + 2 * W_LAYER;
constexpr size_t WS_Z = WS_XB + (size_t)MTOK * DM * 2;
constexpr size_t Z_QF = 0, Z_LOGF = Z_QF + (size_t)MTOK * 1024 * 2, Z_VI = Z_LOGF + (size_t)MTOK * 1024 * 4, Z_HGATE = Z_VI + (size_t)MTOK * 1024 * 2,
                 Z_AQ = Z_HGATE + (size_t)MTOK * 1024 * 2, Z_AKV = Z_AQ + (size_t)MTOK * 1024 * 2, Z_GH = Z_AKV + (size_t)MTOK * 256 * 2,
                 Z_GA = Z_GH + (size_t)MTOK * 2048 * 2, Z_END = Z_GA + (size_t)MTOK * 2048 * 2;
constexpr size_t Z_T1 = 0, Z_MIX = (size_t)MTOK * 2048 * 2;
constexpr size_t Z_U = 0;
constexpr size_t WS_END = WS_Z + Z_END;
static_assert(Z_MIX + (size_t)MTOK * 2048 * 2 <= Z_HGATE, "T1|MIX overlay");
static_assert((size_t)MTOK * DFF * 2 <= Z_END, "U overlay");
static_assert(WS_END <= 1073741824ull, "workspace");

constexpr int LDS_BYTES = 147456;
#ifndef PH
#define PH 0xFFFF
#endif
#define ON(k) ((PH >> (k)) & 1)

namespace pg8 {
struct EpiIn {
    static constexpr bool PERM = true, AFTER_DRAIN = false;
    const float* rs; const float* lb; unsigned char* Z;
    __device__ __forceinline__ void operator()(const f32x4 (&acc)[2][2][4][2], const Unit& u, int wr, int wc, int fr, int fq) const {
        const int pn = u.pn; int kind, ld, tb; size_t zo;
        if (pn < 4)       { kind = 0; zo = Z_QF;    ld = 1024; tb = pn * 256; }
        else if (pn < 8)  { kind = 1; zo = Z_LOGF;  ld = 1024; tb = (pn - 4) * 256; }
        else if (pn < 12) { kind = 2; zo = Z_VI;    ld = 1024; tb = (pn - 8) * 256; }
        else if (pn < 16) { kind = 0; zo = Z_HGATE; ld = 1024; tb = (pn - 12) * 256; }
        else if (pn < 20) { kind = 2; zo = Z_AQ;    ld = 1024; tb = (pn - 16) * 256; }
        else if (pn == 20){ kind = 2; zo = Z_AKV;   ld = 256;  tb = 0; }
        else if (pn < 29) { kind = 3; zo = Z_GH;    ld = 2048; tb = (pn - 21) * 256; }
        else              { kind = 3; zo = Z_GA;    ld = 2048; tb = (pn - 29) * 256; }
        const int row0 = u.pm * BM + wr * 64 + fr, col0 = tb + wc * 32 + 8 * fq;
        if (kind == 1) {
            float* LOGF = (float*)(Z + zo);
            f32x4 lbv[2][2];
#pragma unroll
            for (int bj = 0; bj < 2; ++bj)
#pragma unroll
                for (int n = 0; n < 2; ++n) lbv[bj][n] = *(const f32x4*)(lb + col0 + bj * HALF + 4 * n);
#pragma unroll
            for (int ai = 0; ai < 2; ++ai)
#pragma unroll
                for (int m = 0; m < 4; ++m) { const int row = row0 + ai * HALF + m * 16; const float s = rs[row]; float* rp = LOGF + (size_t)row * 1024 + col0;
#pragma unroll
                    for (int bj = 0; bj < 2; ++bj)
#pragma unroll
                        for (int n = 0; n < 2; ++n) { const f32x4 v = acc[ai][bj][m][n] * s; f32x4 o;
#pragma unroll
                            for (int e = 0; e < 4; ++e) { const float l = lbv[bj][n][e]; o[e] = __logf(l + (1.f - l) * sigm(v[e])); }
                            *(f32x4*)(rp + bj * HALF + 4 * n) = o; } }
        } else {
            bf16_t* dst = (bf16_t*)(Z + zo);
#pragma unroll
            for (int ai = 0; ai < 2; ++ai)
#pragma unroll
                for (int m = 0; m < 4; ++m) { const int row = row0 + ai * HALF + m * 16; const float s = rs[row]; bf16_t* rp = dst + (size_t)row * ld + col0;
#pragma unroll
                    for (int bj = 0; bj < 2; ++bj) { f32x4 v0 = acc[ai][bj][m][0] * s, v1 = acc[ai][bj][m][1] * s;
                        if (kind == 0) {
#pragma unroll
                            for (int e = 0; e < 4; ++e) { v0[e] = v0[e] * sigm(v0[e]); v1[e] = v1[e] * sigm(v1[e]); }
                        } else if (kind == 3) {
#pragma unroll
                            for (int e = 0; e < 4; ++e) { v0[e] = sigm(v0[e]); v1[e] = sigm(v1[e]); }
                        }
                        u32x4 w; w.x = cvt_pk_bf16(v0[0], v0[1]); w.y = cvt_pk_bf16(v0[2], v0[3]); w.z = cvt_pk_bf16(v1[0], v1[1]); w.w = cvt_pk_bf16(v1[2], v1[3]);
                        *(u32x4*)(rp + bj * HALF) = w; } }
        }
    }
};
template <int MODE> struct EpiGate {
    static constexpr bool PERM = true, AFTER_DRAIN = false;
    const bf16_t* gate; const bf16_t* t1; bf16_t* dst;
    __device__ __forceinline__ void operator()(const f32x4 (&acc)[2][2][4][2], const Unit& u, int wr, int wc, int fr, int fq) const {
        const int row0 = u.pm * BM + wr * 64 + fr, col0 = u.pn * BM + wc * 32 + 8 * fq;
#pragma unroll
        for (int ai = 0; ai < 2; ++ai)
#pragma unroll
            for (int m = 0; m < 4; ++m) { const size_t off = (size_t)(row0 + ai * HALF + m * 16) * 2048 + col0;
#pragma unroll
                for (int bj = 0; bj < 2; ++bj) { const u32x4 g = *(const u32x4*)(gate + off + bj * HALF);
                    f32x4 v0 = acc[ai][bj][m][0], v1 = acc[ai][bj][m][1];
                    v0[0] *= bflo(g.x); v0[1] *= bfhi(g.x); v0[2] *= bflo(g.y); v0[3] *= bfhi(g.y); v1[0] *= bflo(g.z); v1[1] *= bfhi(g.z); v1[2] *= bflo(g.w); v1[3] *= bfhi(g.w);
                    if (MODE == 1) { const u32x4 t = *(const u32x4*)(t1 + off + bj * HALF);
                        v0[0] += bflo(t.x); v0[1] += bfhi(t.x); v0[2] += bflo(t.y); v0[3] += bfhi(t.y); v1[0] += bflo(t.z); v1[1] += bfhi(t.z); v1[2] += bflo(t.w); v1[3] += bfhi(t.w); }
                    u32x4 w; w.x = cvt_pk_bf16(v0[0], v0[1]); w.y = cvt_pk_bf16(v0[2], v0[3]); w.z = cvt_pk_bf16(v1[0], v1[1]); w.w = cvt_pk_bf16(v1[2], v1[3]);
                    *(u32x4*)(dst + off + bj * HALF) = w; } }
    }
};
struct EpiRes {
    static constexpr bool PERM = true, AFTER_DRAIN = false;
    const float* resid; float* out; bf16_t* xb; float* part;
    __device__ __forceinline__ void operator()(const f32x4 (&acc)[2][2][4][2], const Unit& u, int wr, int wc, int fr, int fq) const {
        const int row0 = u.pm * BM + wr * 64 + fr, col0 = u.pn * BM + wc * 32 + 8 * fq;
#pragma unroll
        for (int ai = 0; ai < 2; ++ai)
#pragma unroll
            for (int m = 0; m < 4; ++m) { const int row = row0 + ai * HALF + m * 16; const size_t off = (size_t)row * 2048 + col0; float ss = 0.f;
#pragma unroll
                for (int bj = 0; bj < 2; ++bj) { const f32x4 r0 = *(const f32x4*)(resid + off + bj * HALF), r1 = *(const f32x4*)(resid + off + bj * HALF + 4);
                    const f32x4 o0 = r0 + acc[ai][bj][m][0], o1 = r1 + acc[ai][bj][m][1];
                    *(f32x4*)(out + off + bj * HALF) = o0; *(f32x4*)(out + off + bj * HALF + 4) = o1;
                    if (xb) { ss += (o0[0] * o0[0] + o0[1] * o0[1]) + (o0[2] * o0[2] + o0[3] * o0[3]) + (o1[0] * o1[0] + o1[1] * o1[1]) + (o1[2] * o1[2] + o1[3] * o1[3]);
                        u32x4 w; w.x = cvt_pk_bf16(o0[0], o0[1]); w.y = cvt_pk_bf16(o0[2], o0[3]); w.z = cvt_pk_bf16(o1[0], o1[1]); w.w = cvt_pk_bf16(o1[2], o1[3]);
                        *(u32x4*)(xb + off + bj * HALF) = w; } }
                if (xb) { ss += __shfl_xor(ss, 16); ss += __shfl_xor(ss, 32); if (fq == 0) part[(size_t)row * 32 + u.pn * 4 + wc] = ss; } }
    }
};
struct EpiUp {
    static constexpr bool PERM = true, AFTER_DRAIN = false;
    const float* rs; bf16_t* dst;
    __device__ __forceinline__ void operator()(const f32x4 (&acc)[2][2][4][2], const Unit& u, int wr, int wc, int fr, int fq) const {
        const int row0 = u.pm * BM + wr * 64 + fr, col0 = u.pn * BM + wc * 32 + 8 * fq;
#pragma unroll
        for (int ai = 0; ai < 2; ++ai)
#pragma unroll
            for (int m = 0; m < 4; ++m) { const int row = row0 + ai * HALF + m * 16; const float s = rs[row]; bf16_t* rp = dst + (size_t)row * DFF + col0;
#pragma unroll
                for (int bj = 0; bj < 2; ++bj) { f32x4 v0 = acc[ai][bj][m][0] * s, v1 = acc[ai][bj][m][1] * s;
#pragma unroll
                    for (int e = 0; e < 4; ++e) { const float a = fmaxf(v0[e], 0.f), b = fmaxf(v1[e], 0.f); v0[e] = a * a; v1[e] = b * b; }
                    u32x4 w; w.x = cvt_pk_bf16(v0[0], v0[1]); w.y = cvt_pk_bf16(v0[2], v0[3]); w.z = cvt_pk_bf16(v1[0], v1[1]); w.w = cvt_pk_bf16(v1[2], v1[3]);
                    *(u32x4*)(rp + bj * HALF) = w; } }
    }
};
}

__device__ __forceinline__ float wave_sum(float v) {
#pragma unroll
    for (int o = 1; o < 64; o <<= 1) v += __shfl_xor(v, o);
    return v;
}
__device__ __forceinline__ void transpose_item(const float* __restrict__ W, const float* __restrict__ gain, int K, int N, bf16* __restrict__ WT, LAS float* scr, int item, int lane) {
    const int nblk = N / 32, kb = item / nblk, nb = item % nblk, k0 = 64 * kb, n0 = 32 * nb;
#pragma unroll 8
    for (int i = 0; i < 32; ++i) { const int kk = 2 * i + (lane >> 5); const float g = gain ? gain[k0 + kk] : 1.f; scr[kk * 33 + (lane & 31)] = W[(size_t)(k0 + kk) * N + n0 + (lane & 31)] * g; }
    asm volatile("s_waitcnt lgkmcnt(0)" ::: "memory");
    const int c = lane & 7;
#pragma unroll
    for (int j = 0; j < 4; ++j) { const int n = (lane >> 3) + 8 * j; const LAS float* s = scr + (8 * c) * 33 + n;
        u32x4 o; o.x = pk2(s[0 * 33], s[1 * 33]); o.y = pk2(s[2 * 33], s[3 * 33]); o.z = pk2(s[4 * 33], s[5 * 33]); o.w = pk2(s[6 * 33], s[7 * 33]);
        *(u32x4*)(WT + (size_t)(n0 + n) * K + k0 + 8 * c) = o; }
    asm volatile("s_waitcnt lgkmcnt(0)" ::: "memory");
}

struct Args {
    const float *x, *norm_mix, *w_in, *lb_logits, *hg_norm, *q_norm, *k_norm, *sinks, *w_hg_out, *w_at_out, *w_out, *norm_ffn, *w_up, *w_down;
    float* out; unsigned char* ws;
};

__device__ __forceinline__ void hgrn2_seq(const bf16* __restrict__ QF, const float* __restrict__ LOGF, const bf16* __restrict__ VI, float* __restrict__ ORAW, int item, int tid) {
    const int bh = item >> 3, vs = item & 7, b = bh >> 3, h = bh & 7;
    const int lane = tid & 63, w = tid >> 6, kg = lane & 31, v = vs * 16 + w * 2 + (lane >> 5);
    const size_t rowbase = (size_t)b * SEQ;
    const int kc = h * 128 + kg * 4, vc = h * 128 + v;
    float S0 = 0.f, S1 = 0.f, S2 = 0.f, S3 = 0.f;
    f32x4 nlf[4]; u32x2 nq[4]; unsigned short nv[4];
#pragma unroll
    for (int j = 0; j < 4; ++j) { const size_t o = (rowbase + j) * 1024; nlf[j] = *(const f32x4*)(LOGF + o + kc); nq[j] = *(const u32x2*)(QF + o + kc); nv[j] = VI[o + vc]; }
    for (int t = 0; t < SEQ; t += 4) {
        f32x4 clf[4]; u32x2 cq[4]; unsigned short cv[4];
#pragma unroll
        for (int j = 0; j < 4; ++j) { clf[j] = nlf[j]; cq[j] = nq[j]; cv[j] = nv[j]; }
        if (t + 4 < SEQ) {
#pragma unroll
            for (int j = 0; j < 4; ++j) { const size_t o = (rowbase + t + 4 + j) * 1024; nlf[j] = *(const f32x4*)(LOGF + o + kc); nq[j] = *(const u32x2*)(QF + o + kc); nv[j] = VI[o + vc]; }
        }
#pragma unroll
        for (int j = 0; j < 4; ++j) {
            const float f0 = __expf(clf[j][0]), f1 = __expf(clf[j][1]), f2 = __expf(clf[j][2]), f3 = __expf(clf[j][3]);
            const float vv = __uint_as_float((unsigned)cv[j] << 16);
            S0 = f0 * S0 + (1.f - f0) * vv; S1 = f1 * S1 + (1.f - f1) * vv; S2 = f2 * S2 + (1.f - f2) * vv; S3 = f3 * S3 + (1.f - f3) * vv;
            float o = (bflo(cq[j].x) * S0 + bfhi(cq[j].x) * S1) + (bflo(cq[j].y) * S2 + bfhi(cq[j].y) * S3);
            o += __shfl_xor(o, 1); o += __shfl_xor(o, 2); o += __shfl_xor(o, 4); o += __shfl_xor(o, 8); o += __shfl_xor(o, 16);
            if (kg == 0) ORAW[(rowbase + t + j) * 1024 + vc] = o;
        }
    }
}

__device__ __forceinline__ void qk_norm_pass(bf16* AQ, bf16* AKV, const float* qn, const float* kn, int gtid, int NT) {
    const int sub = gtid & 7;
    f32x4 g0 = *(const f32x4*)(qn + sub * 8), g1 = *(const f32x4*)(qn + sub * 8 + 4);
    for (size_t c = gtid; c < (size_t)MTOK * 128; c += NT) {
        u32x4 w = *(u32x4*)(AQ + c * 8);
        float v[8] = {bflo(w.x), bfhi(w.x), bflo(w.y), bfhi(w.y), bflo(w.z), bfhi(w.z), bflo(w.w), bfhi(w.w)};
        float ss = 0.f;
#pragma unroll
        for (int e = 0; e < 8; ++e) ss += v[e] * v[e];
        ss += __shfl_xor(ss, 1); ss += __shfl_xor(ss, 2); ss += __shfl_xor(ss, 4);
        const float r = rsqrtf(ss * (1.f / 64.f) + EPSF) * 0.125f;
        u32x4 o; o.x = pk2(v[0] * r * g0[0], v[1] * r * g0[1]); o.y = pk2(v[2] * r * g0[2], v[3] * r * g0[3]); o.z = pk2(v[4] * r * g1[0], v[5] * r * g1[1]); o.w = pk2(v[6] * r * g1[2], v[7] * r * g1[3]);
        *(u32x4*)(AQ + c * 8) = o;
    }
    g0 = *(const f32x4*)(kn + sub * 8); g1 = *(const f32x4*)(kn + sub * 8 + 4);
    for (size_t c = gtid; c < (size_t)MTOK * 16; c += NT) {
        bf16* p = AKV + (c >> 4) * 256 + (c & 15) * 8;
        u32x4 w = *(u32x4*)p;
        float v[8] = {bflo(w.x), bfhi(w.x), bflo(w.y), bfhi(w.y), bflo(w.z), bfhi(w.z), bflo(w.w), bfhi(w.w)};
        float ss = 0.f;
#pragma unroll
        for (int e = 0; e < 8; ++e) ss += v[e] * v[e];
        ss += __shfl_xor(ss, 1); ss += __shfl_xor(ss, 2); ss += __shfl_xor(ss, 4);
        const float r = rsqrtf(ss * (1.f / 64.f) + EPSF);
        u32x4 o; o.x = pk2(v[0] * r * g0[0], v[1] * r * g0[1]); o.y = pk2(v[2] * r * g0[2], v[3] * r * g0[3]); o.z = pk2(v[4] * r * g1[0], v[5] * r * g1[1]); o.w = pk2(v[6] * r * g1[2], v[7] * r * g1[3]);
        *(u32x4*)p = o;
    }
}

__device__ __forceinline__ void hg_norm_pass(const float* __restrict__ ORAW, bf16* HGATE, const float* hn, int gtid, int NT) {
    const int sub = gtid & 15;
    const f32x4 g0 = *(const f32x4*)(hn + sub * 8), g1 = *(const f32x4*)(hn + sub * 8 + 4);
    for (size_t c = gtid; c < (size_t)MTOK * 128; c += NT) {
        const f32x4 a = *(const f32x4*)(ORAW + c * 8), b = *(const f32x4*)(ORAW + c * 8 + 4);
        float ss = (a[0] * a[0] + a[1] * a[1]) + (a[2] * a[2] + a[3] * a[3]) + (b[0] * b[0] + b[1] * b[1]) + (b[2] * b[2] + b[3] * b[3]);
        ss += __shfl_xor(ss, 1); ss += __shfl_xor(ss, 2); ss += __shfl_xor(ss, 4); ss += __shfl_xor(ss, 8);
        const float r = rsqrtf(ss * (1.f / 128.f) + EPSF);
        const u32x4 w = *(u32x4*)(HGATE + c * 8);
        u32x4 o; o.x = pk2(a[0] * r * g0[0] * bflo(w.x), a[1] * r * g0[1] * bfhi(w.x)); o.y = pk2(a[2] * r * g0[2] * bflo(w.y), a[3] * r * g0[3] * bfhi(w.y));
        o.z = pk2(b[0] * r * g1[0] * bflo(w.z), b[1] * r * g1[1] * bfhi(w.z)); o.w = pk2(b[2] * r * g1[2] * bflo(w.w), b[3] * r * g1[3] * bfhi(w.w));
        *(u32x4*)(HGATE + c * 8) = o;
    }
}

__device__ __forceinline__ void attn_simple(bf16* AQ, const bf16* __restrict__ AKV, const float* __restrict__ sinks, int gtid, int NT) {
    for (int i = gtid; i < MTOK * ATH; i += NT) {
        const int token = i >> 4, h = i & 15, t = token & (SEQ - 1), kvh = h >> 3;
        float q[64], o[64];
        bf16* qp = AQ + (size_t)token * 1024 + h * 64;
#pragma unroll
        for (int j = 0; j < 8; ++j) { const u32x4 w = *(const u32x4*)(qp + j * 8);
            q[j * 8 + 0] = bflo(w.x); q[j * 8 + 1] = bfhi(w.x); q[j * 8 + 2] = bflo(w.y); q[j * 8 + 3] = bfhi(w.y); q[j * 8 + 4] = bflo(w.z); q[j * 8 + 5] = bfhi(w.z); q[j * 8 + 6] = bflo(w.w); q[j * 8 + 7] = bfhi(w.w); }
#pragma unroll
        for (int d = 0; d < 64; ++d) o[d] = 0.f;
        const float slope = exp2f(-0.5f * (float)(h + 1));
        float mx = sinks[h], l = 1.f;
        const int nk = t < WIN - 1 ? t + 1 : WIN;
        const bf16* kp = AKV + (size_t)(token - nk + 1) * 256 + kvh * 64;
        for (int s = 0; s < nk; ++s, kp += 256) {
            float d0 = 0.f, d1 = 0.f;
#pragma unroll
            for (int j = 0; j < 8; ++j) { const u32x4 w = *(const u32x4*)(kp + j * 8);
                d0 += q[j * 8 + 0] * bflo(w.x) + q[j * 8 + 2] * bflo(w.y) + q[j * 8 + 4] * bflo(w.z) + q[j * 8 + 6] * bflo(w.w);
                d1 += q[j * 8 + 1] * bfhi(w.x) + q[j * 8 + 3] * bfhi(w.y) + q[j * 8 + 5] * bfhi(w.z) + q[j * 8 + 7] * bfhi(w.w); }
            const float sc = (d0 + d1) - slope * (float)(nk - 1 - s);
            if (sc > mx) { const float al = __expf(mx - sc); l *= al;
#pragma unroll
                for (int d = 0; d < 64; ++d) o[d] *= al;
                mx = sc; }
            const float p = __expf(sc - mx); l += p;
#pragma unroll
            for (int j = 0; j < 8; ++j) { const u32x4 w = *(const u32x4*)(kp + 128 + j * 8);
                o[j * 8 + 0] += p * bflo(w.x); o[j * 8 + 1] += p * bfhi(w.x); o[j * 8 + 2] += p * bflo(w.y); o[j * 8 + 3] += p * bfhi(w.y);
                o[j * 8 + 4] += p * bflo(w.z); o[j * 8 + 5] += p * bfhi(w.z); o[j * 8 + 6] += p * bflo(w.w); o[j * 8 + 7] += p * bfhi(w.w); }
        }
        const float inv = 1.f / l;
#pragma unroll
        for (int j = 0; j < 8; ++j) { u32x4 w; w.x = pk2(o[j * 8 + 0] * inv, o[j * 8 + 1] * inv); w.y = pk2(o[j * 8 + 2] * inv, o[j * 8 + 3] * inv); w.z = pk2(o[j * 8 + 4] * inv, o[j * 8 + 5] * inv); w.w = pk2(o[j * 8 + 6] * inv, o[j * 8 + 7] * inv);
            *(u32x4*)(qp + j * 8) = w; }
    }
}

typedef short bf16x8 __attribute__((ext_vector_type(8)));
typedef float f32x2 __attribute__((ext_vector_type(2)));
#define MFMA16(a, b, c) __builtin_amdgcn_mfma_f32_16x16x32_bf16((a), (b), (c), 0, 0, 0)
constexpr int HL_CUM = 0, HL_ABUF = 0, HL_TOT = 32768, HL_REF = 34816, HL_QT = 35840, HL_KST = HL_QT, HL_KT = HL_QT + 17408, HL_QO = HL_KT + 17408,
              HL_VT = HL_QO + 17408, HL_ST = HL_VT + 18432, HL_SS = HL_ST + 34816, HL_END = HL_SS + 512;
static_assert(HL_END <= LDS_BYTES, "HGRN2 LDS map");
struct Prep { float cum[16]; float lf[16]; float ref, last; };
__device__ __forceinline__ void hg_step1(LAS unsigned char* lds, const float* __restrict__ LOGF, const bf16* __restrict__ VI, size_t tok0, int h, int tid, Prep& P) {
    const int k = tid & 127, seg = tid >> 7;
    const float* lp = LOGF + (tok0 + 16 * seg) * 1024 + h * 128 + k;
    const bf16* vp = VI + (tok0 + 16 * seg) * 1024 + h * 128 + k;
    unsigned vv[16];
#pragma unroll
    for (int i = 0; i < 16; ++i) { P.lf[i] = lp[i * 1024]; vv[i] = vp[i * 1024]; }
    float run = 0.f;
#pragma unroll
    for (int i = 0; i < 16; ++i) { run += P.lf[i]; P.cum[i] = run; }
    LAS float* TOT = (LAS float*)(lds + HL_TOT);
    TOT[seg * 128 + k] = run;
    u32x4 w0, w1;
    w0.x = vv[0] | (vv[1] << 16); w0.y = vv[2] | (vv[3] << 16); w0.z = vv[4] | (vv[5] << 16); w0.w = vv[6] | (vv[7] << 16);
    w1.x = vv[8] | (vv[9] << 16); w1.y = vv[10] | (vv[11] << 16); w1.z = vv[12] | (vv[13] << 16); w1.w = vv[14] | (vv[15] << 16);
    *(LAS u32x4*)(lds + HL_VT + (k * 72 + 16 * seg) * 2) = w0; *(LAS u32x4*)(lds + HL_VT + (k * 72 + 16 * seg) * 2 + 16) = w1;
    __syncthreads();
    const float t0 = TOT[k], t1 = TOT[128 + k], t2 = TOT[256 + k], t3 = TOT[384 + k];
    const float off = seg == 0 ? 0.f : seg == 1 ? t0 : seg == 2 ? t0 + t1 : (t0 + t1) + t2;
#pragma unroll
    for (int i = 0; i < 16; ++i) P.cum[i] += off;
    P.ref = t0 + t1; P.last = (t0 + t1) + (t2 + t3);
}
__device__ __forceinline__ void hgrn_a_item(LAS unsigned char* lds, const float* __restrict__ LOGF, const bf16* __restrict__ VI, bf16* __restrict__ UT, float* __restrict__ D, int item, int tid) {
    const int h = item & 7; const size_t tok0 = (size_t)(item >> 3) * 64;
    Prep P; hg_step1(lds, LOGF, VI, tok0, h, tid, P);
    const int k = tid & 127, seg = tid >> 7;
    unsigned pk[8];
#pragma unroll
    for (int i = 0; i < 8; ++i) { const float a = (1.f - __expf(P.lf[2 * i])) * __expf(P.last - P.cum[2 * i]), b = (1.f - __expf(P.lf[2 * i + 1])) * __expf(P.last - P.cum[2 * i + 1]); pk[i] = pk2(a, b); }
    *(LAS u32x4*)(lds + HL_KST + (k * 72 + 16 * seg) * 2) = (u32x4){pk[0], pk[1], pk[2], pk[3]};
    *(LAS u32x4*)(lds + HL_KST + (k * 72 + 16 * seg) * 2 + 16) = (u32x4){pk[4], pk[5], pk[6], pk[7]};
    if (seg == 0) D[(size_t)item * 128 + k] = __expf(P.last);
    __syncthreads();
    const int lane = tid & 63, w = tid >> 6, r = lane & 15, q = lane >> 4;
    bf16x8 af[2];
#pragma unroll
    for (int ks = 0; ks < 2; ++ks) af[ks] = *(const LAS bf16x8*)(lds + HL_KST + ((16 * w + r) * 72 + 32 * ks + 8 * q) * 2);
    bf16* ut = UT + (size_t)item * 16384;
#pragma unroll
    for (int nt = 0; nt < 8; ++nt) { f32x4 acc = {0.f, 0.f, 0.f, 0.f};
#pragma unroll
        for (int ks = 0; ks < 2; ++ks) { const bf16x8 bfr = *(const LAS bf16x8*)(lds + HL_VT + ((16 * nt + r) * 72 + 32 * ks + 8 * q) * 2); acc = MFMA16(af[ks], bfr, acc); }
        u32x2 o; o.x = pk2(acc[0], acc[1]); o.y = pk2(acc[2], acc[3]);
        *(u32x2*)(ut + (16 * nt + r) * 128 + 16 * w + 4 * q) = o; }
    __syncthreads();
}
__device__ __forceinline__ void hgrn_scan(bf16* UT, const float* __restrict__ D, int gtid, int NT) {
    for (int e = gtid; e < 16 * 8192; e += NT) {
        const int bh = e >> 13, off = (e & 8191) * 2, b = bh >> 3, h = bh & 7, k = off & 127;
        unsigned* up = (unsigned*)(UT + ((size_t)(b * 256) * 8 + h) * 16384 + off);
        const float* dp = D + ((size_t)(b * 256) * 8 + h) * 128 + k;
        float s0 = 0.f, s1 = 0.f;
        for (int n = 0; n < 256; n += 8) {
            unsigned u[8]; f32x2 d[8];
#pragma unroll
            for (int j = 0; j < 8; ++j) { u[j] = up[(size_t)(n + j) * 65536]; d[j] = *(const f32x2*)(dp + (size_t)(n + j) * 1024); }
#pragma unroll
            for (int j = 0; j < 8; ++j) { up[(size_t)(n + j) * 65536] = pk2(s0, s1); s0 = d[j].x * s0 + bflo(u[j]); s1 = d[j].y * s1 + bfhi(u[j]); }
        }
    }
}
__device__ __forceinline__ void hgrn_c_item(LAS unsigned char* lds, const bf16* __restrict__ QF, const float* __restrict__ LOGF, const bf16* __restrict__ VI, const bf16* __restrict__ ST,
                                            bf16* HGATE, const float* __restrict__ hn, int item, int tid) {
    const int h = item & 7; const size_t tok0 = (size_t)(item >> 3) * 64;
    Prep P; hg_step1(lds, LOGF, VI, tok0, h, tid, P);
    {
        const int k = tid & 127, seg = tid >> 7;
        LAS float* CUM = (LAS float*)(lds + HL_CUM);
#pragma unroll
        for (int i = 0; i < 16; ++i) CUM[(16 * seg + i) * 128 + k] = P.cum[i];
        if (seg == 0) ((LAS float*)(lds + HL_REF))[k] = P.ref;
        const u32x4* sg = (const u32x4*)(ST + (size_t)item * 16384);
#pragma unroll
        for (int j = 0; j < 4; ++j) { const int idx = tid + 512 * j, v = idx >> 4, c = idx & 15; *(LAS u32x4*)(lds + HL_ST + (v * 136 + c * 8) * 2) = sg[idx]; }
    }
    __syncthreads();
    {
        const int t = tid >> 3, k0 = 16 * (tid & 7); const size_t go = (tok0 + t) * 1024 + h * 128 + k0;
        f32x4 lf[4], cm[4], rf[4]; u32x4 qv[2];
#pragma unroll
        for (int j = 0; j < 4; ++j) { lf[j] = *(const f32x4*)(LOGF + go + 4 * j); cm[j] = *(const LAS f32x4*)(lds + HL_CUM + (t * 128 + k0 + 4 * j) * 4); rf[j] = *(const LAS f32x4*)(lds + HL_REF + (k0 + 4 * j) * 4); }
        qv[0] = *(const u32x4*)(QF + go); qv[1] = *(const u32x4*)(QF + go + 8);
        unsigned pq[8], pkk[8], po[8];
#pragma unroll
        for (int j = 0; j < 8; ++j) {
            const unsigned qw = qv[j >> 2][j & 3]; const float q0 = bflo(qw), q1 = bfhi(qw);
            const int e0 = 2 * j, e1 = 2 * j + 1;
            const float c0 = cm[e0 >> 2][e0 & 3], c1 = cm[e1 >> 2][e1 & 3], r0 = rf[e0 >> 2][e0 & 3], r1 = rf[e1 >> 2][e1 & 3];
            const float kf0 = 1.f - __expf(lf[e0 >> 2][e0 & 3]), kf1 = 1.f - __expf(lf[e1 >> 2][e1 & 3]);
            pq[j] = pk2(q0 * __expf(c0 - r0), q1 * __expf(c1 - r1));
            pkk[j] = pk2(kf0 * __expf(r0 - c0), kf1 * __expf(r1 - c1));
            po[j] = pk2(q0 * __expf(c0), q1 * __expf(c1));
        }
        const int lo = (t * 136 + k0) * 2;
        *(LAS u32x4*)(lds + HL_QT + lo) = (u32x4){pq[0], pq[1], pq[2], pq[3]}; *(LAS u32x4*)(lds + HL_QT + lo + 16) = (u32x4){pq[4], pq[5], pq[6], pq[7]};
        *(LAS u32x4*)(lds + HL_KT + lo) = (u32x4){pkk[0], pkk[1], pkk[2], pkk[3]}; *(LAS u32x4*)(lds + HL_KT + lo + 16) = (u32x4){pkk[4], pkk[5], pkk[6], pkk[7]};
        *(LAS u32x4*)(lds + HL_QO + lo) = (u32x4){po[0], po[1], po[2], po[3]}; *(LAS u32x4*)(lds + HL_QO + lo + 16) = (u32x4){po[4], po[5], po[6], po[7]};
    }
    __syncthreads();
    const int lane = tid & 63, w = tid >> 6, r = lane & 15, q = lane >> 4, nt = w & 3, vh = w >> 2;
    {
#pragma unroll
        for (int mm = 0; mm < 2; ++mm) { const int mt = vh * 2 + mm; f32x4 acc = {0.f, 0.f, 0.f, 0.f};
            if (mt <= nt) {
#pragma unroll
                for (int ks = 0; ks < 4; ++ks) { const bf16x8 a = *(const LAS bf16x8*)(lds + HL_KT + ((16 * mt + r) * 136 + 32 * ks + 8 * q) * 2), b = *(const LAS bf16x8*)(lds + HL_QT + ((16 * nt + r) * 136 + 32 * ks + 8 * q) * 2);
                    acc = MFMA16(a, b, acc); } }
            const int c = 16 * nt + r, s0 = 16 * mt + 4 * q;
            const float a0 = (mt <= nt && s0 + 0 <= c) ? acc[0] : 0.f, a1 = (mt <= nt && s0 + 1 <= c) ? acc[1] : 0.f, a2 = (mt <= nt && s0 + 2 <= c) ? acc[2] : 0.f, a3 = (mt <= nt && s0 + 3 <= c) ? acc[3] : 0.f;
            u32x2 o; o.x = pk2(a0, a1); o.y = pk2(a2, a3);
            *(LAS u32x2*)(lds + HL_ABUF + (c * 72 + s0) * 2) = o; }
    }
    __syncthreads();
    {
        bf16x8 bA[2], bQ[4];
#pragma unroll
        for (int ks = 0; ks < 2; ++ks) bA[ks] = *(const LAS bf16x8*)(lds + HL_ABUF + ((16 * nt + r) * 72 + 32 * ks + 8 * q) * 2);
#pragma unroll
        for (int ks = 0; ks < 4; ++ks) bQ[ks] = *(const LAS bf16x8*)(lds + HL_QO + ((16 * nt + r) * 136 + 32 * ks + 8 * q) * 2);
        f32x4 acc[4]; float ss = 0.f;
#pragma unroll
        for (int j = 0; j < 4; ++j) { const int vt = 4 * vh + j; acc[j] = (f32x4){0.f, 0.f, 0.f, 0.f};
#pragma unroll
            for (int ks = 0; ks < 2; ++ks) { const bf16x8 a = *(const LAS bf16x8*)(lds + HL_VT + ((16 * vt + r) * 72 + 32 * ks + 8 * q) * 2); acc[j] = MFMA16(a, bA[ks], acc[j]); }
#pragma unroll
            for (int ks = 0; ks < 4; ++ks) { const bf16x8 a = *(const LAS bf16x8*)(lds + HL_ST + ((16 * vt + r) * 136 + 32 * ks + 8 * q) * 2); acc[j] = MFMA16(a, bQ[ks], acc[j]); }
            ss += (acc[j][0] * acc[j][0] + acc[j][1] * acc[j][1]) + (acc[j][2] * acc[j][2] + acc[j][3] * acc[j][3]); }
        ss += __shfl_xor(ss, 16); ss += __shfl_xor(ss, 32);
        LAS float* SS = (LAS float*)(lds + HL_SS);
        if (q == 0) SS[vh * 64 + 16 * nt + r] = ss;
        __syncthreads();
        const float rr = rsqrtf((SS[16 * nt + r] + SS[64 + 16 * nt + r]) * (1.f / 128.f) + EPSF);
        bf16* hp = HGATE + (tok0 + 16 * nt + r) * 1024 + h * 128;
#pragma unroll
        for (int j = 0; j < 4; ++j) { const int vb = 16 * (4 * vh + j) + 4 * q; const f32x4 g = *(const f32x4*)(hn + vb); const u32x2 hg = *(const u32x2*)(hp + vb);
            u32x2 o; o.x = pk2(acc[j][0] * rr * g[0] * bflo(hg.x), acc[j][1] * rr * g[1] * bfhi(hg.x)); o.y = pk2(acc[j][2] * rr * g[2] * bflo(hg.y), acc[j][3] * rr * g[3] * bfhi(hg.y));
            *(u32x2*)(hp + vb) = o; }
    }
    __syncthreads();
}

__device__ __forceinline__ void rowstats_pass(const float* __restrict__ part, float* __restrict__ rs, int gtid, int NT) {
    for (int r = gtid; r < MTOK; r += NT) { const f32x4* p = (const f32x4*)(part + (size_t)r * 32); float s = 0.f;
#pragma unroll
        for (int j = 0; j < 8; ++j) { const f32x4 v = p[j]; s += (v[0] + v[1]) + (v[2] + v[3]); }
        rs[r] = rsqrtf(s * (1.f / DM) + EPSF); }
}

__device__ __forceinline__ const Args* kargs() { const Args* p = (const Args*)__builtin_amdgcn_kernarg_segment_ptr(); asm volatile("" : "+s"(p)); return p; }
#define ZP(off) (ka->ws + WS_Z + (off))
#define WL(off) ((const bf16*)(ka->ws + WS_W + (size_t)l * W_LAYER + (off)))
__global__ void __launch_bounds__(512, 2) fwd_mega(Args a_unused) {
    extern __shared__ __attribute__((aligned(16))) unsigned char lds_raw[];
    LAS unsigned char* lds = (LAS unsigned char*)lds_raw;
    cg::grid_group grid = cg::this_grid();
    const int G = gridDim.x, bx = blockIdx.x;
#define TIDS int tid_ = threadIdx.x; asm volatile("" : "+v"(tid_)); const int tid = tid_, lane = tid & 63, wave = __builtin_amdgcn_readfirstlane(tid >> 6), gw = bx * 8 + wave, NGW = G * 8, gtid = bx * 512 + tid, NT = G * 512; (void)lane; (void)gw; (void)NGW; (void)gtid; (void)NT;

    {
        const Args* ka = kargs(); TIDS
        unsigned char* ws = ka->ws; float* RS = (float*)(ws + WS_RS); float* LB = (float*)(ws + WS_LB); bf16* XB = (bf16*)(ws + WS_XB);
        LAS float* scr = (LAS float*)(lds + wave * 16384);
        constexpr int I_IN = (DM / 64) * (DIN / 32), I_HG = (HGW / 64) * (DM / 32), I_AT = (ATW / 64) * (DM / 32), I_OUT = (DM / 64) * (DM / 32), I_UP = (DM / 64) * (DFF / 32), I_DN = (DFF / 64) * (DM / 32);
        constexpr int I_LAYER = I_IN + I_HG + I_AT + I_OUT + I_UP + I_DN;
        for (int it = gw; it < 2 * I_LAYER; it += NGW) {
            const int l = it >= I_LAYER ? 1 : 0; int r = it - l * I_LAYER; unsigned char* wl = ws + WS_W + (size_t)l * W_LAYER;
            if (r < I_IN) { transpose_item(ka->w_in + (size_t)l * DM * DIN, ka->norm_mix + l * DM, DM, DIN, (bf16*)(wl + W_IN), scr, r, lane); continue; } r -= I_IN;
            if (r < I_HG) { transpose_item(ka->w_hg_out + (size_t)l * HGW * DM, nullptr, HGW, DM, (bf16*)(wl + W_HG), scr, r, lane); continue; } r -= I_HG;
            if (r < I_AT) { transpose_item(ka->w_at_out + (size_t)l * ATW * DM, nullptr, ATW, DM, (bf16*)(wl + W_AT), scr, r, lane); continue; } r -= I_AT;
            if (r < I_OUT) { transpose_item(ka->w_out + (size_t)l * DM * DM, nullptr, DM, DM, (bf16*)(wl + W_OUT), scr, r, lane); continue; } r -= I_OUT;
            if (r < I_UP) { transpose_item(ka->w_up + (size_t)l * DM * DFF, ka->norm_ffn + l * DM, DM, DFF, (bf16*)(wl + W_UP), scr, r, lane); continue; } r -= I_UP;
            transpose_item(ka->w_down + (size_t)l * DFF * DM, nullptr, DFF, DM, (bf16*)(wl + W_DN), scr, r, lane);
        }
        for (int c = gtid; c < 1024; c += NT) { LB[c] = 0.f; LB[1024 + c] = sigm(ka->lb_logits[1024 + c] - ka->lb_logits[c]); }
        const float* x = ka->x;
        for (int m = gw; m < MTOK; m += NGW) {
            const f32x4* xr = (const f32x4*)(x + (size_t)m * DM) + lane; f32x4 v[8]; float s = 0.f;
#pragma unroll
            for (int j = 0; j < 8; ++j) { v[j] = xr[64 * j]; s += (v[j][0] * v[j][0] + v[j][1] * v[j][1]) + (v[j][2] * v[j][2] + v[j][3] * v[j][3]); }
            s = wave_sum(s);
            if (lane == 0) RS[m] = rsqrtf(s * (1.f / DM) + EPSF);
            u32x2* o8 = (u32x2*)(XB + (size_t)m * DM) + lane;
#pragma unroll
            for (int j = 0; j < 8; ++j) { u32x2 w; w.x = pk2(v[j][0], v[j][1]); w.y = pk2(v[j][2], v[j][3]); o8[64 * j] = w; }
        }
    }
    grid.sync();

    for (int l = 0; l < 2; ++l) {
        if (ON(1)) {
            const Args* ka = kargs();
            pg8::Gemm g{(const bf16*)(ka->ws + WS_XB), WL(W_IN), MTOK, DIN, DM}; pg8::StaticOrder S; S.init(MTOK, DIN, G, bx);
            pg8::EpiIn E{(const float*)(ka->ws + WS_RS), (const float*)(ka->ws + WS_LB) + l * 1024, ka->ws + WS_Z};
            pg8::gemm_phase<pg8::EpiIn, pg8::StaticOrder, true, true>(lds, g, S, E);
        }
        grid.sync();
        {
            const Args* ka = kargs(); TIDS
            if (ON(2)) for (int item = bx; item < 4096; item += G) hgrn_a_item(lds, (const float*)ZP(Z_LOGF), (const bf16*)ZP(Z_VI), (bf16*)(ka->ws + WS_XB), (float*)(ka->ws + WS_PART), item, tid);
            if (ON(3)) qk_norm_pass((bf16*)ZP(Z_AQ), (bf16*)ZP(Z_AKV), ka->q_norm + l * 64, ka->k_norm + l * 64, gtid, NT);
        }
        grid.sync();
        {
            const Args* ka = kargs(); TIDS
            if (ON(2)) hgrn_scan((bf16*)(ka->ws + WS_XB), (const float*)(ka->ws + WS_PART), gtid, NT);
            if (ON(5)) attn_simple((bf16*)ZP(Z_AQ), (const bf16*)ZP(Z_AKV), ka->sinks + l * 16, gtid, NT);
        }
        grid.sync();
        {
            const Args* ka = kargs(); TIDS
            if (ON(4)) for (int item = bx; item < 4096; item += G) hgrn_c_item(lds, (const bf16*)ZP(Z_QF), (const float*)ZP(Z_LOGF), (const bf16*)ZP(Z_VI), (const bf16*)(ka->ws + WS_XB), (bf16*)ZP(Z_HGATE), ka->hg_norm + l * 128, item, tid);
        }
        grid.sync();
        if (ON(6)) {
            const Args* ka = kargs();
            pg8::Gemm g{(const bf16*)ZP(Z_HGATE), WL(W_HG), MTOK, DM, HGW}; pg8::StaticOrder S; S.init(MTOK, DM, G, bx);
            pg8::EpiGate<0> E{(const bf16*)ZP(Z_GH), nullptr, (bf16*)ZP(Z_T1)};
            pg8::gemm_phase<pg8::EpiGate<0>, pg8::StaticOrder, true, true>(lds, g, S, E);
        }
        if (ON(7)) {
            const Args* ka = kargs();
            pg8::Gemm g{(const bf16*)ZP(Z_AQ), WL(W_AT), MTOK, DM, ATW}; pg8::StaticOrder S; S.init(MTOK, DM, G, bx);
            pg8::EpiGate<1> E{(const bf16*)ZP(Z_GA), (const bf16*)ZP(Z_T1), (bf16*)ZP(Z_MIX)};
            pg8::gemm_phase<pg8::EpiGate<1>, pg8::StaticOrder, true, true>(lds, g, S, E);
        }
        grid.sync();
        if (ON(8)) {
            const Args* ka = kargs();
            pg8::Gemm g{(const bf16*)ZP(Z_MIX), WL(W_OUT), MTOK, DM, DM}; pg8::StaticOrder S; S.init(MTOK, DM, G, bx);
            pg8::EpiRes E{l == 0 ? ka->x : (const float*)ka->out, ka->out, (bf16*)(ka->ws + WS_XB), (float*)(ka->ws + WS_PART)};
            pg8::gemm_phase<pg8::EpiRes, pg8::StaticOrder, true, true>(lds, g, S, E);
        }
        grid.sync();
        { const Args* ka = kargs(); TIDS rowstats_pass((const float*)(ka->ws + WS_PART), (float*)(ka->ws + WS_RS), gtid, NT); }
        grid.sync();
        if (ON(9)) {
            const Args* ka = kargs();
            pg8::Gemm g{(const bf16*)(ka->ws + WS_XB), WL(W_UP), MTOK, DFF, DM}; pg8::StaticOrder S; S.init(MTOK, DFF, G, bx);
            pg8::EpiUp E{(const float*)(ka->ws + WS_RS), (bf16*)ZP(Z_U)};
            pg8::gemm_phase<pg8::EpiUp, pg8::StaticOrder, true, true>(lds, g, S, E);
        }
        grid.sync();
        if (ON(10)) {
            const Args* ka = kargs();
            pg8::Gemm g{(const bf16*)ZP(Z_U), WL(W_DN), MTOK, DM, DFF}; pg8::StaticOrder S; S.init(MTOK, DM, G, bx);
            pg8::EpiRes E{ka->out, ka->out, l == 0 ? (bf16*)(ka->ws + WS_XB) : nullptr, (float*)(ka->ws + WS_PART)};
            pg8::gemm_phase<pg8::EpiRes, pg8::StaticOrder, true, true>(lds, g, S, E);
        }
        if (l == 0) { grid.sync(); { const Args* ka = kargs(); TIDS rowstats_pass((const float*)(ka->ws + WS_PART), (float*)(ka->ws + WS_RS), gtid, NT); } grid.sync(); }
    }
}

extern "C" void kernel_launch(void* const* d_in, const int* in_sizes, int n_in, void* d_out, int out_size, void* d_ws, size_t ws_size, hipStream_t stream) {
    static int grid = 0;
    if (grid == 0) {
        if (n_in != 14 || out_size != MTOK * DM || ws_size < WS_END) { fprintf(stderr, "kernel_launch: unexpected shapes (n_in %d out %d ws %zu need %zu)\n", n_in, out_size, ws_size, (size_t)WS_END); grid = -1; return; }
        int dev = 0, cus = 0, per_cu = 0;
        (void)hipGetDevice(&dev); (void)hipDeviceGetAttribute(&cus, hipDeviceAttributeMultiprocessorCount, dev);
        if (hipFuncSetAttribute((const void*)fwd_mega, hipFuncAttributeMaxDynamicSharedMemorySize, LDS_BYTES) != hipSuccess) { fprintf(stderr, "hipFuncSetAttribute failed\n"); grid = -1; return; }
        if (hipOccupancyMaxActiveBlocksPerMultiprocessor(&per_cu, (const void*)fwd_mega, 512, LDS_BYTES) != hipSuccess || per_cu < 1) { fprintf(stderr, "occupancy query: %d\n", per_cu); per_cu = 1; }
        (void)hipGetLastError();
        grid = cus * 1;
    }
    if (grid < 0) return;
    Args a{};
    a.x = (const float*)d_in[0]; a.norm_mix = (const float*)d_in[1]; a.w_in = (const float*)d_in[2]; a.lb_logits = (const float*)d_in[3]; a.hg_norm = (const float*)d_in[4];
    a.q_norm = (const float*)d_in[5]; a.k_norm = (const float*)d_in[6]; a.sinks = (const float*)d_in[7]; a.w_hg_out = (const float*)d_in[8]; a.w_at_out = (const float*)d_in[9];
    a.w_out = (const float*)d_in[10]; a.norm_ffn = (const float*)d_in[11]; a.w_up = (const float*)d_in[12]; a.w_down = (const float*)d_in[13];
    a.out = (float*)d_out; a.ws = (unsigned char*)d_ws;
    void* args[] = {&a};
    hipError_t e = hipLaunchCooperativeKernel((const void*)fwd_mega, dim3(grid), dim3(512), args, LDS_BYTES, stream);
    if (e != hipSuccess) fprintf(stderr, "cooperative launch failed: %s (grid %d)\n", hipGetErrorString(e), grid);
}
```

```cpp
#include <hip/hip_runtime.h>
#include <hip/hip_cooperative_groups.h>
#include <cstdio>
#include <cstdint>
namespace cg = cooperative_groups;
namespace pg8 {
#define PG8_LAS __attribute__((address_space(3)))
typedef unsigned short bf16_t;
typedef short bf16x8 __attribute__((ext_vector_type(8)));
typedef float f32x4 __attribute__((ext_vector_type(4)));
typedef unsigned u32x4 __attribute__((ext_vector_type(4)));
constexpr int BM = 256, BK = 64, HALF = 128, HTB = HALF * BK * 2  , STAGE_BYTES = 8 * HTB, NXCD = 8, WGM = 8;

__host__ __device__ __forceinline__ int lds_byte(int r, int c) { const int st = (r >> 4) * 2 + (c >> 5), rr = r & 15, cc = c & 31, ob = rr * 64 + cc * 2; return st * 1024 + (ob ^ (((ob >> 9) & 1) << 5)); }
__host__ __device__ __forceinline__ void stage_rc(int b, int& R, int& C) { const int st = b / 1024, sb = b % 1024, swz = sb ^ (((sb >> 9) & 1) << 5); R = (st >> 1) * 16 + swz / 64; C = (st & 1) * 32 + (swz % 64) / 2; }
__host__ __device__ __forceinline__ int perm32(int rho) { const int n = rho >> 4, i = rho & 15; return 8 * (i >> 2) + 4 * n + (i & 3); }

struct Unit { int pm, pn; };
struct Gemm { const bf16_t* A; const bf16_t* Bt; int M, N, K; };

struct StaticOrder {
    int nM, nN, nwg, G, c;
    __host__ __device__ void init(int M, int N, int G_, int c_) { nM = M / BM; nN = N / BM; nwg = nM * nN; G = G_; c = c_; }
    __host__ __device__ bool next(int i, Unit& u) const {
        const long L = (long)i * G + c; if (L >= nwg) return false;
        int wgid = (int)L; { const int q = nwg / NXCD, r = nwg % NXCD, xcd = wgid % NXCD, off = wgid / NXCD; wgid = (xcd < r ? xcd * (q + 1) : r * (q + 1) + (xcd - r) * q) + off; }
        const int nig = WGM * nN, gid = wgid / nig, fm = gid * WGM, gsz = (nM - fm) < WGM ? (nM - fm) : WGM;
        u.pm = fm + ((wgid % nig) % gsz); u.pn = (wgid % nig) / gsz; return true;
    }
    __device__ __forceinline__ void a_ready(const Unit&) const {}
    __device__ __forceinline__ void done(const Unit&) const {}
};
__device__ __forceinline__ unsigned cvt_pk_bf16(float lo, float hi) { unsigned r; asm volatile("v_cvt_pk_bf16_f32 %0, %1, %2" : "=v"(r) : "v"(lo), "v"(hi)); return r; }
typedef float f32x2 __attribute__((ext_vector_type(2)));
template <class Epi, class Sched, bool ALIGN_EPI = false, bool SP2 = false>
__device__ __forceinline__ void gemm_phase(PG8_LAS unsigned char* lds, const Gemm g, const Sched& S, const Epi& E) {
    int tid_ = threadIdx.x; asm volatile("" : "+v"(tid_));
    const int tid = tid_, wid = __builtin_amdgcn_readfirstlane(tid >> 6), lane = tid & 63, wr = wid >> 2, wc = wid & 3, fr = lane & 15, fq = lane >> 4;
    const int K = g.K, nt = K / BK;
    unsigned voffA[2], voffB[2];
#pragma unroll
    for (int i = 0; i < 2; ++i) { int R, C; stage_rc(tid * 16 + i * 8192, R, C); const int Rb = Epi::PERM ? ((R & ~31) + perm32(R & 31)) : R;
        voffA[i] = (unsigned)(R * K + C) * 2u; voffB[i] = (unsigned)(Rb * K + C) * 2u; }
    const size_t kstep = (size_t)(BK * 2);
    const size_t hstep = (size_t)HALF * K * 2;
    const size_t tstep = 2 * hstep;
    const unsigned ldsw = (unsigned)wid * 1024u;
    const int aoff = lds_byte(wr * 64 + fr, fq * 8), boff = lds_byte(wc * 32 + fr, fq * 8);
#define PG8_SA(b, h) (((b) * 2 + (h)) * HTB)
#define PG8_SB(b, h) ((4 + (b) * 2 + (h)) * HTB)
#define PG8_STAGE(bufoff, gbase, voff) do { _Pragma("unroll") for (int _i = 0; _i < 2; ++_i) \
        __builtin_amdgcn_global_load_lds((const unsigned*)((const char*)(gbase) + (voff)[_i]), (PG8_LAS unsigned*)(lds + (bufoff) + ldsw + _i * 8192), 16, 0, 0); } while (0)
#define PG8_LDA(dst, b, h) do { _Pragma("unroll") for (int m = 0; m < 4; ++m) _Pragma("unroll") for (int k = 0; k < 2; ++k) dst[m][k] = *(const PG8_LAS bf16x8*)(lds + PG8_SA(b, h) + aoff + m * 2048 + k * 1024); } while (0)
#define PG8_LDB(dst, b, h) do { _Pragma("unroll") for (int n = 0; n < 2; ++n) _Pragma("unroll") for (int k = 0; k < 2; ++k) dst[n][k] = *(const PG8_LAS bf16x8*)(lds + PG8_SB(b, h) + boff + n * 2048 + k * 1024); } while (0)
#define PG8_MMA(ai, bj, At, Bt) do { __builtin_amdgcn_s_setprio(1); _Pragma("unroll") for (int m = 0; m < 4; ++m) _Pragma("unroll") for (int n = 0; n < 2; ++n) _Pragma("unroll") for (int k = 0; k < 2; ++k) \
        acc[ai][bj][m][n] = __builtin_amdgcn_mfma_f32_16x16x32_bf16(Bt[n][k], At[m][k], acc[ai][bj][m][n], 0, 0, 0); __builtin_amdgcn_s_setprio(0); } while (0)
#define PG8_WAIT_V(n) asm volatile("s_waitcnt vmcnt(" #n ")" ::: "memory")
#define PG8_WAIT_L(n) asm volatile("s_waitcnt lgkmcnt(" #n ")" ::: "memory")
#define PG8_BAR __builtin_amdgcn_s_barrier()
#define PG8_SCHED __builtin_amdgcn_sched_barrier(0)
    Unit cur, nxt; int ui = 0;
    if (!S.next(0, cur)) return;
    f32x4 acc[2][2][4][2];
#pragma unroll
    for (int a = 0; a < 2; ++a)
#pragma unroll
        for (int b = 0; b < 2; ++b)
#pragma unroll
            for (int m = 0; m < 4; ++m)
#pragma unroll
                for (int n = 0; n < 2; ++n) acc[a][b][m][n] = (f32x4){0.f, 0.f, 0.f, 0.f};
    bf16x8 At[4][2], B0[2][2], B1[2][2];
    const char* cA = (const char*)g.A + (size_t)cur.pm * tstep; const char* cB = (const char*)g.Bt + (size_t)cur.pn * tstep;
    S.a_ready(cur);
    if constexpr (SP2) {
        PG8_STAGE(PG8_SB(0, 0), cB, voffB); PG8_STAGE(PG8_SB(0, 1), cB + hstep, voffB); PG8_STAGE(PG8_SA(0, 0), cA, voffA); PG8_STAGE(PG8_SA(0, 1), cA + hstep, voffA);
        if (wr == 1) PG8_BAR;
        PG8_WAIT_V(2); PG8_BAR;
        PG8_STAGE(PG8_SB(1, 0), cB + kstep, voffB); PG8_STAGE(PG8_SA(1, 0), cA + kstep, voffA); PG8_STAGE(PG8_SB(1, 1), cB + hstep + kstep, voffB);
        PG8_WAIT_V(6); PG8_BAR;
    } else {
        PG8_STAGE(PG8_SB(0, 0), cB, voffB); PG8_STAGE(PG8_SA(0, 0), cA, voffA); PG8_STAGE(PG8_SB(0, 1), cB + hstep, voffB); PG8_STAGE(PG8_SA(0, 1), cA + hstep, voffA);
        if (wr == 1) PG8_BAR;
        PG8_WAIT_V(4); PG8_BAR;
        PG8_STAGE(PG8_SB(1, 0), cB + kstep, voffB); PG8_STAGE(PG8_SA(1, 0), cA + kstep, voffA); PG8_STAGE(PG8_SB(1, 1), cB + hstep + kstep, voffB);
        PG8_WAIT_V(6); PG8_BAR;
    }
    for (;;) {
        const bool has_next = S.next(ui + 1, nxt);
        const char* nA = has_next ? (const char*)g.A + (size_t)nxt.pm * tstep : cA; const char* nB = has_next ? (const char*)g.Bt + (size_t)nxt.pn * tstep : cB;
        for (int t = 0; t < nt; t += 2) {
            const bool last = (t == nt - 2);
            const char* a1 = cA + (size_t)(t + 1) * kstep;
            const char* a2 = last ? nA : cA + (size_t)(t + 2) * kstep; const char* b2 = last ? nB : cB + (size_t)(t + 2) * kstep;
            const char* a3 = a2 + kstep; const char* b3 = b2 + kstep;
            if (last && has_next) S.a_ready(nxt);
            if constexpr (SP2) {
            PG8_LDB(B0, 0, 0); PG8_LDB(B1, 0, 1); PG8_SCHED; PG8_LDA(At, 0, 0); PG8_STAGE(PG8_SA(1, 1), a1 + hstep, voffA);
            PG8_WAIT_V(8); PG8_WAIT_L(0); PG8_BAR; PG8_MMA(0, 0, At, B0); PG8_MMA(0, 1, At, B1); PG8_BAR; PG8_SCHED;
            PG8_LDA(At, 0, 1); PG8_STAGE(PG8_SB(0, 0), b2, voffB); PG8_STAGE(PG8_SB(0, 1), b2 + hstep, voffB); PG8_STAGE(PG8_SA(0, 0), a2, voffA);
            PG8_WAIT_V(8); PG8_WAIT_L(0); PG8_BAR; PG8_MMA(1, 0, At, B0); PG8_MMA(1, 1, At, B1); PG8_BAR; PG8_SCHED;
            PG8_LDB(B0, 1, 0); PG8_LDB(B1, 1, 1); PG8_SCHED; PG8_LDA(At, 1, 0); PG8_STAGE(PG8_SA(0, 1), a2 + hstep, voffA);
            PG8_WAIT_V(8); PG8_WAIT_L(0); PG8_BAR; PG8_MMA(0, 0, At, B0); PG8_MMA(0, 1, At, B1); PG8_BAR; PG8_SCHED;
            PG8_LDA(At, 1, 1); PG8_STAGE(PG8_SB(1, 0), b3, voffB); PG8_STAGE(PG8_SB(1, 1), b3 + hstep, voffB); PG8_STAGE(PG8_SA(1, 0), a3, voffA);
            PG8_WAIT_V(8); PG8_WAIT_L(0); PG8_BAR; PG8_MMA(1, 0, At, B0); PG8_MMA(1, 1, At, B1); PG8_BAR; PG8_SCHED;
            } else {
            PG8_LDB(B0, 0, 0); PG8_SCHED; PG8_LDA(At, 0, 0); PG8_STAGE(PG8_SA(1, 1), a1 + hstep, voffA);
            PG8_WAIT_L(8); PG8_BAR; PG8_WAIT_L(0); PG8_MMA(0, 0, At, B0); PG8_BAR; PG8_SCHED;
            PG8_LDB(B1, 0, 1); PG8_STAGE(PG8_SB(0, 0), b2, voffB);
            PG8_BAR; PG8_WAIT_L(0); PG8_MMA(0, 1, At, B1); PG8_BAR;
            PG8_LDA(At, 0, 1); PG8_STAGE(PG8_SA(0, 0), a2, voffA);
            PG8_BAR; PG8_WAIT_L(0); PG8_MMA(1, 0, At, B0); PG8_BAR; PG8_SCHED;
            PG8_STAGE(PG8_SB(0, 1), b2 + hstep, voffB);
            PG8_WAIT_V(6); PG8_BAR; PG8_MMA(1, 1, At, B1); PG8_BAR;
            PG8_LDB(B0, 1, 0); PG8_SCHED; PG8_LDA(At, 1, 0); PG8_STAGE(PG8_SA(0, 1), a2 + hstep, voffA);
            PG8_WAIT_L(8); PG8_BAR; PG8_WAIT_L(0); PG8_MMA(0, 0, At, B0); PG8_BAR; PG8_SCHED;
            PG8_LDB(B1, 1, 1); PG8_STAGE(PG8_SB(1, 0), b3, voffB);
            PG8_BAR; PG8_WAIT_L(0); PG8_MMA(0, 1, At, B1); PG8_BAR;
            PG8_LDA(At, 1, 1); PG8_STAGE(PG8_SA(1, 0), a3, voffA);
            PG8_BAR; PG8_WAIT_L(0); PG8_MMA(1, 0, At, B0); PG8_BAR; PG8_SCHED;
            PG8_STAGE(PG8_SB(1, 1), b3 + hstep, voffB);
            PG8_WAIT_V(6); PG8_BAR; PG8_MMA(1, 1, At, B1); PG8_BAR;
            }
        }
        if constexpr (ALIGN_EPI) { if (wr == 0) PG8_BAR; }
        if constexpr (!Epi::AFTER_DRAIN) { E(acc, cur, wr, wc, fr, fq); S.done(cur); }
        if (!has_next) break;
#pragma unroll
        for (int a = 0; a < 2; ++a)
#pragma unroll
            for (int b = 0; b < 2; ++b)
#pragma unroll
                for (int m = 0; m < 4; ++m)
#pragma unroll
                    for (int n = 0; n < 2; ++n) acc[a][b][m][n] = (f32x4){0.f, 0.f, 0.f, 0.f};
        cur = nxt; cA = nA; cB = nB; ++ui;
        if constexpr (ALIGN_EPI) { if (wr == 1) PG8_BAR; }
    }
    PG8_WAIT_V(0);
    if constexpr (!ALIGN_EPI) { if (wr == 0) PG8_BAR; }
    PG8_BAR;
    if constexpr (Epi::AFTER_DRAIN) { E.fused(acc, cur, wr, wc, fr, fq, lds, wid, lane); S.done(cur); }
#undef PG8_SA
#undef PG8_SB
#undef PG8_STAGE
#undef PG8_LDA
#undef PG8_LDB
#undef PG8_MMA
#undef PG8_WAIT_V
#undef PG8_WAIT_L
#undef PG8_BAR
#undef PG8_SCHED
}
}

constexpr int BATCH = 2, SEQ = 16384, DM = 2048, MTOK = BATCH * SEQ;
constexpr int HGH = 8, HGD = 128, HGW = 1024;
constexpr int ATH = 16, ATD = 64, ATW = 1024, WIN = 128;
constexpr int DIN = 9472, DFF = 8192;
constexpr float EPSF = 1e-6f;

#define LAS __attribute__((address_space(3)))
typedef unsigned short bf16;
typedef float f32x4 __attribute__((ext_vector_type(4)));
typedef unsigned u32x4 __attribute__((ext_vector_type(4)));
typedef unsigned u32x2 __attribute__((ext_vector_type(2)));

__device__ __forceinline__ float sigm(float x) { return __builtin_amdgcn_rcpf(1.f + __expf(-x)); }
__device__ __forceinline__ float bflo(unsigned w) { return __uint_as_float(w << 16); }
__device__ __forceinline__ float bfhi(unsigned w) { return __uint_as_float(w & 0xffff0000u); }
typedef __bf16 bf16x2_t __attribute__((ext_vector_type(2)));
typedef float f32x2_t __attribute__((ext_vector_type(2)));
__device__ __forceinline__ unsigned pk2(float lo, float hi) { const f32x2_t v = {lo, hi}; const bf16x2_t b = __builtin_convertvector(v, bf16x2_t); return __builtin_bit_cast(unsigned, b); }

constexpr size_t WS_RS = 0;
constexpr size_t WS_LB = 131072;
constexpr size_t WS_PART = 262144;
constexpr size_t WS_W = WS_PART + (size_t)MTOK * 32 * 4;
constexpr size_t W_IN = 0, W_HG = W_IN + (size_t)DIN * DM * 2, W_AT = W_HG + (size_t)DM * HGW * 2, W_OUT = W_AT + (size_t)DM * ATW * 2,
                 W_UP = W_OUT + (size_t)DM * DM * 2, W_DN = W_UP + (size_t)DFF * DM * 2, W_LAYER = W_DN + (size_t)DM * DFF * 2;
constexpr size_t WS_XB = WS_W + 2 * W_LAYER;
constexpr size_t WS_Z = WS_XB + (size_t)MTOK * DM * 2;
constexpr size_t Z_QF = 0, Z_LOGF = Z_QF + (size_t)MTOK * 1024 * 2, Z_VI = Z_LOGF + (size_t)MTOK * 1024 * 4, Z_HGATE = Z_VI + (size_t)MTOK * 1024 * 2,
                 Z_AQ = Z_HGATE + (size_t)MTOK * 1024 * 2, Z_AKV = Z_AQ + (size_t)MTOK * 1024 * 2, Z_GH = Z_AKV + (size_t)MTOK * 256 * 2,
                 Z_GA = Z_GH + (size_t)MTOK * 2048 * 2, Z_END = Z_GA + (size_t)MTOK * 2048 * 2;
constexpr size_t Z_T1 = 0, Z_MIX = (size_t)MTOK * 2048 * 2;
constexpr size_t Z_U = 0;
constexpr size_t WS_END = WS_Z + Z_END;
static_assert(Z_MIX + (size_t)MTOK * 2048 * 2 <= Z_HGATE, "T1|MIX overlay");
static_assert((size_t)MTOK * DFF * 2 <= Z_END, "U overlay");
static_assert(WS_END <= 1073741824ull, "workspace");

constexpr int LDS_BYTES = 147456;
#ifndef PH
#define PH 0xFFFF
#endif
#define ON(k) ((PH >> (k)) & 1)

namespace pg8 {
struct EpiIn {
    static constexpr bool PERM = true, AFTER_DRAIN = false;
    const float* rs; const float* lb; unsigned char* Z;
    __device__ __forceinline__ void operator()(const f32x4 (&acc)[2][2][4][2], const Unit& u, int wr, int wc, int fr, int fq) const {
        const int pn = u.pn; int kind, ld, tb; size_t zo;
        if (pn < 4)       { kind = 0; zo = Z_QF;    ld = 1024; tb = pn * 256; }
        else if (pn < 8)  { kind = 1; zo = Z_LOGF;  ld = 1024; tb = (pn - 4) * 256; }
        else if (pn < 12) { kind = 2; zo = Z_VI;    ld = 1024; tb = (pn - 8) * 256; }
        else if (pn < 16) { kind = 0; zo = Z_HGATE; ld = 1024; tb = (pn - 12) * 256; }
        else if (pn < 20) { kind = 2; zo = Z_AQ;    ld = 1024; tb = (pn - 16) * 256; }
        else if (pn == 20){ kind = 2; zo = Z_AKV;   ld = 256;  tb = 0; }
        else if (pn < 29) { kind = 3; zo = Z_GH;    ld = 2048; tb = (pn - 21) * 256; }
        else              { kind = 3; zo = Z_GA;    ld = 2048; tb = (pn - 29) * 256; }
        const int row0 = u.pm * BM + wr * 64 + fr, col0 = tb + wc * 32 + 8 * fq;
        if (kind == 1) {
            float* LOGF = (float*)(Z + zo);
            f32x4 lbv[2][2];
#pragma unroll
            for (int bj = 0; bj < 2; ++bj)
#pragma unroll
                for (int n = 0; n < 2; ++n) lbv[bj][n] = *(const f32x4*)(lb + col0 + bj * HALF + 4 * n);
#pragma unroll
            for (int ai = 0; ai < 2; ++ai)
#pragma unroll
                for (int m = 0; m < 4; ++m) { const int row = row0 + ai * HALF + m * 16; const float s = rs[row]; float* rp = LOGF + (size_t)row * 1024 + col0;
#pragma unroll
                    for (int bj = 0; bj < 2; ++bj)
#pragma unroll
                        for (int n = 0; n < 2; ++n) { const f32x4 v = acc[ai][bj][m][n] * s; f32x4 o;
#pragma unroll
                            for (int e = 0; e < 4; ++e) { const float l = lbv[bj][n][e]; o[e] = __logf(l + (1.f - l) * sigm(v[e])); }
                            *(f32x4*)(rp + bj * HALF + 4 * n) = o; } }
        } else {
            bf16_t* dst = (bf16_t*)(Z + zo);
#pragma unroll
            for (int ai = 0; ai < 2; ++ai)
#pragma unroll
                for (int m = 0; m < 4; ++m) { const int row = row0 + ai * HALF + m * 16; const float s = rs[row]; bf16_t* rp = dst + (size_t)row * ld + col0;
#pragma unroll
                    for (int bj = 0; bj < 2; ++bj) { f32x4 v0 = acc[ai][bj][m][0] * s, v1 = acc[ai][bj][m][1] * s;
                        if (kind == 0) {
#pragma unroll
                            for (int e = 0; e < 4; ++e) { v0[e] = v0[e] * sigm(v0[e]); v1[e] = v1[e] * sigm(v1[e]); }
                        } else if (kind == 3) {
#pragma unroll
                            for (int e = 0; e < 4; ++e) { v0[e] = sigm(v0[e]); v1[e] = sigm(v1[e]); }
                        }
                        u32x4 w; w.x = cvt_pk_bf16(v0[0], v0[1]); w.y = cvt_pk_bf16(v0[2], v0[3]); w.z = cvt_pk_bf16(v1[0], v1[1]); w.w = cvt_pk_bf16(v1[2], v1[3]);
                        *(u32x4*)(rp + bj * HALF) = w; } }
        }
    }
};
template <int MODE> struct EpiGate {
    static constexpr bool PERM = true, AFTER_DRAIN = false;
    const bf16_t* gate; const bf16_t* t1; bf16_t* dst;
    __device__ __forceinline__ void operator()(const f32x4 (&acc)[2][2][4][2], const Unit& u, int wr, int wc, int fr, int fq) const {
        const int row0 = u.pm * BM + wr * 64 + fr, col0 = u.pn * BM + wc * 32 + 8 * fq;
#pragma unroll
        for (int ai = 0; ai < 2; ++ai)
#pragma unroll
            for (int m = 0; m < 4; ++m) { const size_t off = (size_t)(row0 + ai * HALF + m * 16) * 2048 + col0;
#pragma unroll
                for (int bj = 0; bj < 2; ++bj) { const u32x4 g = *(const u32x4*)(gate + off + bj * HALF);
                    f32x4 v0 = acc[ai][bj][m][0], v1 = acc[ai][bj][m][1];
                    v0[0] *= bflo(g.x); v0[1] *= bfhi(g.x); v0[2] *= bflo(g.y); v0[3] *= bfhi(g.y); v1[0] *= bflo(g.z); v1[1] *= bfhi(g.z); v1[2] *= bflo(g.w); v1[3] *= bfhi(g.w);
                    if (MODE == 1) { const u32x4 t = *(const u32x4*)(t1 + off + bj * HALF);
                        v0[0] += bflo(t.x); v0[1] += bfhi(t.x); v0[2] += bflo(t.y); v0[3] += bfhi(t.y); v1[0] += bflo(t.z); v1[1] += bfhi(t.z); v1[2] += bflo(t.w); v1[3] += bfhi(t.w); }
                    u32x4 w; w.x = cvt_pk_bf16(v0[0], v0[1]); w.y = cvt_pk_bf16(v0[2], v0[3]); w.z = cvt_pk_bf16(v1[0], v1[1]); w.w = cvt_pk_bf16(v1[2], v1[3]);
                    *(u32x4*)(dst + off + bj * HALF) = w; } }
    }
};
struct EpiRes {
    static constexpr bool PERM = true, AFTER_DRAIN = false;
    const float* resid; float* out; bf16_t* xb; float* part;
    __device__ __forceinline__ void operator()(const f32x4 (&acc)[2][2][4][2], const Unit& u, int wr, int wc, int fr, int fq) const {
        const int row0 = u.pm * BM + wr * 64 + fr, col0 = u.pn * BM + wc * 32 + 8 * fq;
#pragma unroll
        for (int ai = 0; ai < 2; ++ai)
#pragma unroll
            for (int m = 0; m < 4; ++m) { const int row = row0 + ai * HALF + m * 16; const size_t off = (size_t)row * 2048 + col0; float ss = 0.f;
#pragma unroll
                for (int bj = 0; bj < 2; ++bj) { const f32x4 r0 = *(const f32x4*)(resid + off + bj * HALF), r1 = *(const f32x4*)(resid + off + bj * HALF + 4);
                    const f32x4 o0 = r0 + acc[ai][bj][m][0], o1 = r1 + acc[ai][bj][m][1];
                    *(f32x4*)(out + off + bj * HALF) = o0; *(f32x4*)(out + off + bj * HALF + 4) = o1;
                    if (xb) { ss += (o0[0] * o0[0] + o0[1] * o0[1]) + (o0[2] * o0[2] + o0[3] * o0[3]) + (o1[0] * o1[0] + o1[1] * o1[1]) + (o1[2] * o1[2] + o1[3] * o1[3]);
                        u32x4 w; w.x = cvt_pk_bf16(o0[0], o0[1]); w.y = cvt_pk_bf16(o0[2], o0[3]); w.z = cvt_pk_bf16(o1[0], o1[1]); w.w = cvt_pk_bf16(o1[2], o1[3]);
                        *(u32x4*)(xb + off + bj * HALF) = w; } }
                if (xb) { ss += __shfl_xor(ss, 16); ss += __shfl_xor(ss, 32); if (fq == 0) part[(size_t)row * 32 + u.pn * 4 + wc] = ss; } }
    }
};
struct EpiUp {
    static constexpr bool PERM = true, AFTER_DRAIN = false;
    const float* rs; bf16_t* dst;
    __device__ __forceinline__ void operator()(const f32x4 (&acc)[2][2][4][2], const Unit& u, int wr, int wc, int fr, int fq) const {
        const int row0 = u.pm * BM + wr * 64 + fr, col0 = u.pn * BM + wc * 32 + 8 * fq;
#pragma unroll
        for (int ai = 0; ai < 2; ++ai)
#pragma unroll
            for (int m = 0; m < 4; ++m) { const int row = row0 + ai * HALF + m * 16; const float s = rs[row]; bf16_t* rp = dst + (size_t)row * DFF + col0;
#pragma unroll
                for (int bj = 0; bj < 2; ++bj) { f32x4 v0 = acc[ai][bj][m][0] * s, v1 = acc[ai][bj][m][1] * s;
#pragma unroll
                    for (int e = 0; e < 4; ++e) { const float a = fmaxf(v0[e], 0.f), b = fmaxf(v1[e], 0.f); v0[e] = a * a; v1[e] = b * b; }
                    u32x4 w; w.x = cvt_pk_bf16(v0[0], v0[1]); w.y = cvt_pk_bf16(v0[2], v0[3]); w.z = cvt_pk_bf16(v1[0], v1[1]); w.w = cvt_pk_bf16(v1[2], v1[3]);
                    *(u32x4*)(rp + bj * HALF) = w; } }
    }
};
}

__device__ __forceinline__ float wave_sum(float v) {
#pragma unroll
    for (int o = 1; o < 64; o <<= 1) v += __shfl_xor(v, o);
    return v;
}
__device__ __forceinline__ void transpose_item(const float* __restrict__ W, const float* __restrict__ gain, int K, int N, bf16* __restrict__ WT, LAS float* scr, int item, int lane) {
    const int nblk = N / 32, kb = item / nblk, nb = item % nblk, k0 = 64 * kb, n0 = 32 * nb;
#pragma unroll 8
    for (int i = 0; i < 32; ++i) { const int kk = 2 * i + (lane >> 5); const float g = gain ? gain[k0 + kk] : 1.f; scr[kk * 33 + (lane & 31)] = W[(size_t)(k0 + kk) * N + n0 + (lane & 31)] * g; }
    asm volatile("s_waitcnt lgkmcnt(0)" ::: "memory");
    const int c = lane & 7;
#pragma unroll
    for (int j = 0; j < 4; ++j) { const int n = (lane >> 3) + 8 * j; const LAS float* s = scr + (8 * c) * 33 + n;
        u32x4 o; o.x = pk2(s[0 * 33], s[1 * 33]); o.y = pk2(s[2 * 33], s[3 * 33]); o.z = pk2(s[4 * 33], s[5 * 33]); o.w = pk2(s[6 * 33], s[7 * 33]);
        *(u32x4*)(WT + (size_t)(n0 + n) * K + k0 + 8 * c) = o; }
    asm volatile("s_waitcnt lgkmcnt(0)" ::: "memory");
}

struct Args {
    const float *x, *norm_mix, *w_in, *lb_logits, *hg_norm, *q_norm, *k_norm, *sinks, *w_hg_out, *w_at_out, *w_out, *norm_ffn, *w_up, *w_down;
    float* out; unsigned char* ws;
};

__device__ __forceinline__ void hgrn2_seq(const bf16* __restrict__ QF, const float* __restrict__ LOGF, const bf16* __restrict__ VI, float* __restrict__ ORAW, int item, int tid) {
    const int bh = item >> 3, vs = item & 7, b = bh >> 3, h = bh & 7;
    const int lane = tid & 63, w = tid >> 6, kg = lane & 31, v = vs * 16 + w * 2 + (lane >> 5);
    const size_t rowbase = (size_t)b * SEQ;
    const int kc = h * 128 + kg * 4, vc = h * 128 + v;
    float S0 = 0.f, S1 = 0.f, S2 = 0.f, S3 = 0.f;
    f32x4 nlf[4]; u32x2 nq[4]; unsigned short nv[4];
#pragma unroll
    for (int j = 0; j < 4; ++j) { const size_t o = (rowbase + j) * 1024; nlf[j] = *(const f32x4*)(LOGF + o + kc); nq[j] = *(const u32x2*)(QF + o + kc); nv[j] = VI[o + vc]; }
    for (int t = 0; t < SEQ; t += 4) {
        f32x4 clf[4]; u32x2 cq[4]; unsigned short cv[4];
#pragma unroll
        for (int j = 0; j < 4; ++j) { clf[j] = nlf[j]; cq[j] = nq[j]; cv[j] = nv[j]; }
        if (t + 4 < SEQ) {
#pragma unroll
            for (int j = 0; j < 4; ++j) { const size_t o = (rowbase + t + 4 + j) * 1024; nlf[j] = *(const f32x4*)(LOGF + o + kc); nq[j] = *(const u32x2*)(QF + o + kc); nv[j] = VI[o + vc]; }
        }
#pragma unroll
        for (int j = 0; j < 4; ++j) {
            const float f0 = __expf(clf[j][0]), f1 = __expf(clf[j][1]), f2 = __expf(clf[j][2]), f3 = __expf(clf[j][3]);
            const float vv = __uint_as_float((unsigned)cv[j] << 16);
            S0 = f0 * S0 + (1.f - f0) * vv; S1 = f1 * S1 + (1.f - f1) * vv; S2 = f2 * S2 + (1.f - f2) * vv; S3 = f3 * S3 + (1.f - f3) * vv;
            float o = (bflo(cq[j].x) * S0 + bfhi(cq[j].x) * S1) + (bflo(cq[j].y) * S2 + bfhi(cq[j].y) * S3);
            o += __shfl_xor(o, 1); o += __shfl_xor(o, 2); o += __shfl_xor(o, 4); o += __shfl_xor(o, 8); o += __shfl_xor(o, 16);
            if (kg == 0) ORAW[(rowbase + t + j) * 1024 + vc] = o;
        }
    }
}

__device__ __forceinline__ void qk_norm_pass(bf16* AQ, bf16* AKV, const float* qn, const float* kn, int gtid, int NT) {
    const int sub = gtid & 7;
    f32x4 g0 = *(const f32x4*)(qn + sub * 8), g1 = *(const f32x4*)(qn + sub * 8 + 4);
    for (size_t c = gtid; c < (size_t)MTOK * 128; c += NT) {
        u32x4 w = *(u32x4*)(AQ + c * 8);
        float v[8] = {bflo(w.x), bfhi(w.x), bflo(w.y), bfhi(w.y), bflo(w.z), bfhi(w.z), bflo(w.w), bfhi(w.w)};
        float ss = 0.f;
#pragma unroll
        for (int e = 0; e < 8; ++e) ss += v[e] * v[e];
        ss += __shfl_xor(ss, 1); ss += __shfl_xor(ss, 2); ss += __shfl_xor(ss, 4);
        const float r = rsqrtf(ss * (1.f / 64.f) + EPSF) * 0.125f;
        u32x4 o; o.x = pk2(v[0] * r * g0[0], v[1] * r * g0[1]); o.y = pk2(v[2] * r * g0[2], v[3] * r * g0[3]); o.z = pk2(v[4] * r * g1[0], v[5] * r * g1[1]); o.w = pk2(v[6] * r * g1[2], v[7] * r * g1[3]);
        *(u32x4*)(AQ + c * 8) = o;
    }
    g0 = *(const f32x4*)(kn + sub * 8); g1 = *(const f32x4*)(kn + sub * 8 + 4);
    for (size_t c = gtid; c < (size_t)MTOK * 16; c += NT) {
        bf16* p = AKV + (c >> 4) * 256 + (c & 15) * 8;
        u32x4 w = *(u32x4*)p;
        float v[8] = {bflo(w.x), bfhi(w.x), bflo(w.y), bfhi(w.y), bflo(w.z), bfhi(w.z), bflo(w.w), bfhi(w.w)};
        float ss = 0.f;
#pragma unroll
        for (int e = 0; e < 8; ++e) ss += v[e] * v[e];
        ss += __shfl_xor(ss, 1); ss += __shfl_xor(ss, 2); ss += __shfl_xor(ss, 4);
        const float r = rsqrtf(ss * (1.f / 64.f) + EPSF);
        u32x4 o; o.x = pk2(v[0] * r * g0[0], v[1] * r * g0[1]); o.y = pk2(v[2] * r * g0[2], v[3] * r * g0[3]); o.z = pk2(v[4] * r * g1[0], v[5] * r * g1[1]); o.w = pk2(v[6] * r * g1[2], v[7] * r * g1[3]);
        *(u32x4*)p = o;
    }
}

__device__ __forceinline__ void hg_norm_pass(const float* __restrict__ ORAW, bf16* HGATE, const float* hn, int gtid, int NT) {
    const int sub = gtid & 15;
    const f32x4 g0 = *(const f32x4*)(hn + sub * 8), g1 = *(const f32x4*)(hn + sub * 8 + 4);
    for (size_t c = gtid; c < (size_t)MTOK * 128; c += NT) {
        const f32x4 a = *(const f32x4*)(ORAW + c * 8), b = *(const f32x4*)(ORAW + c * 8 + 4);
        float ss = (a[0] * a[0] + a[1] * a[1]) + (a[2] * a[2] + a[3] * a[3]) + (b[0] * b[0] + b[1] * b[1]) + (b[2] * b[2] + b[3] * b[3]);
        ss += __shfl_xor(ss, 1); ss += __shfl_xor(ss, 2); ss += __shfl_xor(ss, 4); ss += __shfl_xor(ss, 8);
        const float r = rsqrtf(ss * (1.f / 128.f) + EPSF);
        const u32x4 w = *(u32x4*)(HGATE + c * 8);
        u32x4 o; o.x = pk2(a[0] * r * g0[0] * bflo(w.x), a[1] * r * g0[1] * bfhi(w.x)); o.y = pk2(a[2] * r * g0[2] * bflo(w.y), a[3] * r * g0[3] * bfhi(w.y));
        o.z = pk2(b[0] * r * g1[0] * bflo(w.z), b[1] * r * g1[1] * bfhi(w.z)); o.w = pk2(b[2] * r * g1[2] * bflo(w.w), b[3] * r * g1[3] * bfhi(w.w));
        *(u32x4*)(HGATE + c * 8) = o;
    }
}

__device__ __forceinline__ void attn_simple(bf16* AQ, const bf16* __restrict__ AKV, const float* __restrict__ sinks, int gtid, int NT) {
    for (int i = gtid; i < MTOK * ATH; i += NT) {
        const int token = i >> 4, h = i & 15, t = token & (SEQ - 1), kvh = h >> 3;
        float q[64], o[64];
        bf16* qp = AQ + (size_t)token * 1024 + h * 64;
#pragma unroll
        for (int j = 0; j < 8; ++j) { const u32x4 w = *(const u32x4*)(qp + j * 8);
            q[j * 8 + 0] = bflo(w.x); q[j * 8 + 1] = bfhi(w.x); q[j * 8 + 2] = bflo(w.y); q[j * 8 + 3] = bfhi(w.y); q[j * 8 + 4] = bflo(w.z); q[j * 8 + 5] = bfhi(w.z); q[j * 8 + 6] = bflo(w.w); q[j * 8 + 7] = bfhi(w.w); }
#pragma unroll
        for (int d = 0; d < 64; ++d) o[d] = 0.f;
        const float slope = exp2f(-0.5f * (float)(h + 1));
        float mx = sinks[h], l = 1.f;
        const int nk = t < WIN - 1 ? t + 1 : WIN;
        const bf16* kp = AKV + (size_t)(token - nk + 1) * 256 + kvh * 64;
        for (int s = 0; s < nk; ++s, kp += 256) {
            float d0 = 0.f, d1 = 0.f;
#pragma unroll
            for (int j = 0; j < 8; ++j) { const u32x4 w = *(const u32x4*)(kp + j * 8);
                d0 += q[j * 8 + 0] * bflo(w.x) + q[j * 8 + 2] * bflo(w.y) + q[j * 8 + 4] * bflo(w.z) + q[j * 8 + 6] * bflo(w.w);
                d1 += q[j * 8 + 1] * bfhi(w.x) + q[j * 8 + 3] * bfhi(w.y) + q[j * 8 + 5] * bfhi(w.z) + q[j * 8 + 7] * bfhi(w.w); }
            const float sc = (d0 + d1) - slope * (float)(nk - 1 - s);
            if (sc > mx) { const float al = __expf(mx - sc); l *= al;
#pragma unroll
                for (int d = 0; d < 64; ++d) o[d] *= al;
                mx = sc; }
            const float p = __expf(sc - mx); l += p;
#pragma unroll
            for (int j = 0; j < 8; ++j) { const u32x4 w = *(const u32x4*)(kp + 128 + j * 8);
                o[j * 8 + 0] += p * bflo(w.x); o[j * 8 + 1] += p * bfhi(w.x); o[j * 8 + 2] += p * bflo(w.y); o[j * 8 + 3] += p * bfhi(w.y);
                o[j * 8 + 4] += p * bflo(w.z); o[j * 8 + 5] += p * bfhi(w.z); o[j * 8 + 6] += p * bflo(w.w); o[j * 8 + 7] += p * bfhi(w.w); }
        }
        const float inv = 1.f / l;
#pragma unroll
        for (int j = 0; j < 8; ++j) { u32x4 w; w.x = pk2(o[j * 8 + 0] * inv, o[j * 8 + 1] * inv); w.y = pk2(o[j * 8 + 2] * inv, o[j * 8 + 3] * inv); w.z = pk2(o[j * 8 + 4] * inv, o[j * 8 + 5] * inv); w.w = pk2(o[j * 8 + 6] * inv, o[j * 8 + 7] * inv);
            *(u32x4*)(qp + j * 8) = w; }
    }
}

typedef short bf16x8 __attribute__((ext_vector_type(8)));
typedef float f32x2 __attribute__((ext_vector_type(2)));
#define MFMA16(a, b, c) __builtin_amdgcn_mfma_f32_16x16x32_bf16((a), (b), (c), 0, 0, 0)
constexpr int HL_CUM = 0, HL_ABUF = 0, HL_TOT = 32768, HL_REF = 34816, HL_QT = 35840, HL_KST = HL_QT, HL_KT = HL_QT + 17408, HL_QO = HL_KT + 17408,
              HL_VT = HL_QO + 17408, HL_ST = HL_VT + 18432, HL_SS = HL_ST + 34816, HL_END = HL_SS + 512;
static_assert(HL_END <= LDS_BYTES, "HGRN2 LDS map");
struct Prep { float cum[16]; float lf[16]; float ref, last; };
__device__ __forceinline__ void hg_step1(LAS unsigned char* lds, const float* __restrict__ LOGF, const bf16* __restrict__ VI, size_t tok0, int h, int tid, Prep& P) {
    const int k = tid & 127, seg = tid >> 7;
    const float* lp = LOGF + (tok0 + 16 * seg) * 1024 + h * 128 + k;
    const bf16* vp = VI + (tok0 + 16 * seg) * 1024 + h * 128 + k;
    unsigned vv[16];
#pragma unroll
    for (int i = 0; i < 16; ++i) { P.lf[i] = lp[i * 1024]; vv[i] = vp[i * 1024]; }
    float run = 0.f;
#pragma unroll
    for (int i = 0; i < 16; ++i) { run += P.lf[i]; P.cum[i] = run; }
    LAS float* TOT = (LAS float*)(lds + HL_TOT);
    TOT[seg * 128 + k] = run;
    u32x4 w0, w1;
    w0.x = vv[0] | (vv[1] << 16); w0.y = vv[2] | (vv[3] << 16); w0.z = vv[4] | (vv[5] << 16); w0.w = vv[6] | (vv[7] << 16);
    w1.x = vv[8] | (vv[9] << 16); w1.y = vv[10] | (vv[11] << 16); w1.z = vv[12] | (vv[13] << 16); w1.w = vv[14] | (vv[15] << 16);
    *(LAS u32x4*)(lds + HL_VT + (k * 72 + 16 * seg) * 2) = w0; *(LAS u32x4*)(lds + HL_VT + (k * 72 + 16 * seg) * 2 + 16) = w1;
    __syncthreads();
    const float t0 = TOT[k], t1 = TOT[128 + k], t2 = TOT[256 + k], t3 = TOT[384 + k];
    const float off = seg == 0 ? 0.f : seg == 1 ? t0 : seg == 2 ? t0 + t1 : (t0 + t1) + t2;
#pragma unroll
    for (int i = 0; i < 16; ++i) P.cum[i] += off;
    P.ref = t0 + t1; P.last = (t0 + t1) + (t2 + t3);
}
__device__ __forceinline__ void hgrn_a_item(LAS unsigned char* lds, const float* __restrict__ LOGF, const bf16* __restrict__ VI, bf16* __restrict__ UT, float* __restrict__ D, int item, int tid) {
    const int h = item & 7; const size_t tok0 = (size_t)(item >> 3) * 64;
    Prep P; hg_step1(lds, LOGF, VI, tok0, h, tid, P);
    const int k = tid & 127, seg = tid >> 7;
    unsigned pk[8];
#pragma unroll
    for (int i = 0; i < 8; ++i) { const float a = (1.f - __expf(P.lf[2 * i])) * __expf(P.last - P.cum[2 * i]), b = (1.f - __expf(P.lf[2 * i + 1])) * __expf(P.last - P.cum[2 * i + 1]); pk[i] = pk2(a, b); }
    *(LAS u32x4*)(lds + HL_KST + (k * 72 + 16 * seg) * 2) = (u32x4){pk[0], pk[1], pk[2], pk[3]};
    *(LAS u32x4*)(lds + HL_KST + (k * 72 + 16 * seg) * 2 + 16) = (u32x4){pk[4], pk[5], pk[6], pk[7]};
    if (seg == 0) D[(size_t)item * 128 + k] = __expf(P.last);
    __syncthreads();
    const int lane = tid & 63, w = tid >> 6, r = lane & 15, q = lane >> 4;
    bf16x8 af[2];
#pragma unroll
    for (int ks = 0; ks < 2; ++ks) af[ks] = *(const LAS bf16x8*)(lds + HL_KST + ((16 * w + r) * 72 + 32 * ks + 8 * q) * 2);
    bf16* ut = UT + (size_t)item * 16384;
#pragma unroll
    for (int nt = 0; nt < 8; ++nt) { f32x4 acc = {0.f, 0.f, 0.f, 0.f};
#pragma unroll
        for (int ks = 0; ks < 2; ++ks) { const bf16x8 bfr = *(const LAS bf16x8*)(lds + HL_VT + ((16 * nt + r) * 72 + 32 * ks + 8 * q) * 2); acc = MFMA16(af[ks], bfr, acc); }
        u32x2 o; o.x = pk2(acc[0], acc[1]); o.y = pk2(acc[2], acc[3]);
        *(u32x2*)(ut + (16 * nt + r) * 128 + 16 * w + 4 * q) = o; }
    __syncthreads();
}
__device__ __forceinline__ void hgrn_scan(bf16* UT, const float* __restrict__ D, int gtid, int NT) {
    for (int e = gtid; e < 16 * 8192; e += NT) {
        const int bh = e >> 13, off = (e & 8191) * 2, b = bh >> 3, h = bh & 7, k = off & 127;
        unsigned* up = (unsigned*)(UT + ((size_t)(b * 256) * 8 + h) * 16384 + off);
        const float* dp = D + ((size_t)(b * 256) * 8 + h) * 128 + k;
        float s0 = 0.f, s1 = 0.f;
        for (int n = 0; n < 256; n += 8) {
            unsigned u[8]; f32x2 d[8];
#pragma unroll
            for (int j = 0; j < 8; ++j) { u[j] = up[(size_t)(n + j) * 65536]; d[j] = *(const f32x2*)(dp + (size_t)(n + j) * 1024); }
#pragma unroll
            for (int j = 0; j < 8; ++j) { up[(size_t)(n + j) * 65536] = pk2(s0, s1); s0 = d[j].x * s0 + bflo(u[j]); s1 = d[j].y * s1 + bfhi(u[j]); }
        }
    }
}
__device__ __forceinline__ void hgrn_c_item(LAS unsigned char* lds, const bf16* __restrict__ QF, const float* __restrict__ LOGF, const bf16* __restrict__ VI, const bf16* __restrict__ ST,
                                            bf16* HGATE, const float* __restrict__ hn, int item, int tid) {
    const int h = item & 7; const size_t tok0 = (size_t)(item >> 3) * 64;
    Prep P; hg_step1(lds, LOGF, VI, tok0, h, tid, P);
    {
        const int k = tid & 127, seg = tid >> 7;
        LAS float* CUM = (LAS float*)(lds + HL_CUM);
#pragma unroll
        for (int i = 0; i < 16; ++i) CUM[(16 * seg + i) * 128 + k] = P.cum[i];
        if (seg == 0) ((LAS float*)(lds + HL_REF))[k] = P.ref;
        const u32x4* sg = (const u32x4*)(ST + (size_t)item * 16384);
#pragma unroll
        for (int j = 0; j < 4; ++j) { const int idx = tid + 512 * j, v = idx >> 4, c = idx & 15; *(LAS u32x4*)(lds + HL_ST + (v * 136 + c * 8) * 2) = sg[idx]; }
    }
    __syncthreads();
    {
        const int t = tid >> 3, k0 = 16 * (tid & 7); const size_t go = (tok0 + t) * 1024 + h * 128 + k0;
        f32x4 lf[4], cm[4], rf[4]; u32x4 qv[2];
#pragma unroll
        for (int j = 0; j < 4; ++j) { lf[j] = *(const f32x4*)(LOGF + go + 4 * j); cm[j] = *(const LAS f32x4*)(lds + HL_CUM + (t * 128 + k0 + 4 * j) * 4); rf[j] = *(const LAS f32x4*)(lds + HL_REF + (k0 + 4 * j) * 4); }
        qv[0] = *(const u32x4*)(QF + go); qv[1] = *(const u32x4*)(QF + go + 8);
        unsigned pq[8], pkk[8], po[8];
#pragma unroll
        for (int j = 0; j < 8; ++j) {
            const unsigned qw = qv[j >> 2][j & 3]; const float q0 = bflo(qw), q1 = bfhi(qw);
            const int e0 = 2 * j, e1 = 2 * j + 1;
            const float c0 = cm[e0 >> 2][e0 & 3], c1 = cm[e1 >> 2][e1 & 3], r0 = rf[e0 >> 2][e0 & 3], r1 = rf[e1 >> 2][e1 & 3];
            const float kf0 = 1.f - __expf(lf[e0 >> 2][e0 & 3]), kf1 = 1.f - __expf(lf[e1 >> 2][e1 & 3]);
            pq[j] = pk2(q0 * __expf(c0 - r0), q1 * __expf(c1 - r1));
            pkk[j] = pk2(kf0 * __expf(r0 - c0), kf1 * __expf(r1 - c1));
            po[j] = pk2(q0 * __expf(c0), q1 * __expf(c1));
        }
        const int lo = (t * 136 + k0) * 2;
        *(LAS u32x4*)(lds + HL_QT + lo) = (u32x4){pq[0], pq[1], pq[2], pq[3]}; *(LAS u32x4*)(lds + HL_QT + lo + 16) = (u32x4){pq[4], pq[5], pq[6], pq[7]};
        *(LAS u32x4*)(lds + HL_KT + lo) = (u32x4){pkk[0], pkk[1], pkk[2], pkk[3]}; *(LAS u32x4*)(lds + HL_KT + lo + 16) = (u32x4){pkk[4], pkk[5], pkk[6], pkk[7]};
        *(LAS u32x4*)(lds + HL_QO + lo) = (u32x4){po[0], po[1], po[2], po[3]}; *(LAS u32x4*)(lds + HL_QO + lo + 16) = (u32x4){po[4], po[5], po[6], po[7]};
    }
    __syncthreads();
    const int lane = tid & 63, w = tid >> 6, r = lane & 15, q = lane >> 4, nt = w & 3, vh = w >> 2;
    {
#pragma unroll
        for (int mm = 0; mm < 2; ++mm) { const int mt = vh * 2 + mm; f32x4 acc = {0.f, 0.f, 0.f, 0.f};
            if (mt <= nt) {
#pragma unroll
                for (int ks = 0; ks < 4; ++ks) { const bf16x8 a = *(const LAS bf16x8*)(lds + HL_KT + ((16 * mt + r) * 136 + 32 * ks + 8 * q) * 2), b = *(const LAS bf16x8*)(lds + HL_QT + ((16 * nt + r) * 136 + 32 * ks + 8 * q) * 2);
                    acc = MFMA16(a, b, acc); } }
            const int c = 16 * nt + r, s0 = 16 * mt + 4 * q;
            const float a0 = (mt <= nt && s0 + 0 <= c) ? acc[0] : 0.f, a1 = (mt <= nt && s0 + 1 <= c) ? acc[1] : 0.f, a2 = (mt <= nt && s0 + 2 <= c) ? acc[2] : 0.f, a3 = (mt <= nt && s0 + 3 <= c) ? acc[3] : 0.f;
            u32x2 o; o.x = pk2(a0, a1); o.y = pk2(a2, a3);
            *(LAS u32x2*)(lds + HL_ABUF + (c * 72 + s0) * 2) = o; }
    }
    __syncthreads();
    {
        bf16x8 bA[2], bQ[4];
#pragma unroll
        for (int ks = 0; ks < 2; ++ks) bA[ks] = *(const LAS bf16x8*)(lds + HL_ABUF + ((16 * nt + r) * 72 + 32 * ks + 8 * q) * 2);
#pragma unroll
        for (int ks = 0; ks < 4; ++ks) bQ[ks] = *(const LAS bf16x8*)(lds + HL_QO + ((16 * nt + r) * 136 + 32 * ks + 8 * q) * 2);
        f32x4 acc[4]; float ss = 0.f;
#pragma unroll
        for (int j = 0; j < 4; ++j) { const int vt = 4 * vh + j; acc[j] = (f32x4){0.f, 0.f, 0.f, 0.f};
#pragma unroll
            for (int ks = 0; ks < 2; ++ks) { const bf16x8 a = *(const LAS bf16x8*)(lds + HL_VT + ((16 * vt + r) * 72 + 32 * ks + 8 * q) * 2); acc[j] = MFMA16(a, bA[ks], acc[j]); }
#pragma unroll
            for (int ks = 0; ks < 4; ++ks) { const bf16x8 a = *(const LAS bf16x8*)(lds + HL_ST + ((16 * vt + r) * 136 + 32 * ks + 8 * q) * 2); acc[j] = MFMA16(a, bQ[ks], acc[j]); }
            ss += (acc[j][0] * acc[j][0] + acc[j][1] * acc[j][1]) + (acc[j][2] * acc[j][2] + acc[j][3] * acc[j][3]); }
        ss += __shfl_xor(ss, 16); ss += __shfl_xor(ss, 32);
        LAS float* SS = (LAS float*)(lds + HL_SS);
        if (q == 0) SS[vh * 64 + 16 * nt + r] = ss;
        __syncthreads();
        const float rr = rsqrtf((SS[16 * nt + r] + SS[64 + 16 * nt + r]) * (1.f / 128.f) + EPSF);
        bf16* hp = HGATE + (tok0 + 16 * nt + r) * 1024 + h * 128;
#pragma unroll
        for (int j = 0; j < 4; ++j) { const int vb = 16 * (4 * vh + j) + 4 * q; const f32x4 g = *(const f32x4*)(hn + vb); const u32x2 hg = *(const u32x2*)(hp + vb);
            u32x2 o; o.x = pk2(acc[j][0] * rr * g[0] * bflo(hg.x), acc[j][1] * rr * g[1] * bfhi(hg.x)); o.y = pk2(acc[j][2] * rr * g[2] * bflo(hg.y), acc[j][3] * rr * g[3] * bfhi(hg.y));
            *(u32x2*)(hp + vb) = o; }
    }
    __syncthreads();
}

constexpr int AL_K = 0, AL_VT = 208 * 144, AL_END = AL_VT + 64 * 432;
static_assert(AL_END <= LDS_BYTES, "attention LDS map");
__device__ __forceinline__ void attn_item(LAS unsigned char* lds, bf16* AQ, const bf16* __restrict__ AKV, const float* __restrict__ sinks, int item, int tid) {
    const int b = item >> 9, kvh = (item >> 8) & 1, qb = item & 255, t0 = qb * 64;
    const size_t tokb = (size_t)b * SEQ;
#pragma unroll
    for (int j = 0; j < 3; ++j) { const int idx = tid + 512 * j, key = idx >> 3, c = idx & 7, s = t0 - 128 + key; u32x4 v = {0u, 0u, 0u, 0u};
        if (s >= 0) v = *(const u32x4*)(AKV + (tokb + s) * 256 + kvh * 64 + c * 8);
        *(LAS u32x4*)(lds + AL_K + (key * 72 + c * 8) * 2) = v; }
    {
        const int d = tid & 63, kseg = tid >> 6; unsigned vv[24];
#pragma unroll
        for (int i = 0; i < 24; ++i) { const int s = t0 - 128 + 24 * kseg + i; vv[i] = s >= 0 ? (unsigned)AKV[(tokb + s) * 256 + 128 + kvh * 64 + d] : 0u; }
#pragma unroll
        for (int j = 0; j < 3; ++j) { u32x4 w; w.x = vv[8 * j] | (vv[8 * j + 1] << 16); w.y = vv[8 * j + 2] | (vv[8 * j + 3] << 16); w.z = vv[8 * j + 4] | (vv[8 * j + 5] << 16); w.w = vv[8 * j + 6] | (vv[8 * j + 7] << 16);
            *(LAS u32x4*)(lds + AL_VT + (d * 216 + 24 * kseg + 8 * j) * 2) = w; }
        if (kseg == 0) { *(LAS u32x4*)(lds + AL_VT + (d * 216 + 192) * 2) = (u32x4){0u, 0u, 0u, 0u}; *(LAS u32x4*)(lds + AL_VT + (d * 216 + 200) * 2) = (u32x4){0u, 0u, 0u, 0u}; }
    }
    __syncthreads();
    const int lane = tid & 63, w = tid >> 6, r = lane & 15, quad = lane >> 4, h = kvh * 8 + w;
    const float slope = exp2f(-0.5f * (float)(h + 1)), sink = sinks[h];
    bf16* qbase = AQ + (tokb + t0) * 1024 + h * 64;
#pragma unroll 1
    for (int qt = 0; qt < 4; ++qt) {
        bf16x8 qf[2];
#pragma unroll
        for (int ks = 0; ks < 2; ++ks) qf[ks] = *(const bf16x8*)(qbase + (size_t)(16 * qt + r) * 1024 + 32 * ks + 8 * quad);
        f32x4 s[10];
#pragma unroll
        for (int a = 0; a < 10; ++a) { s[a] = (f32x4){0.f, 0.f, 0.f, 0.f};
#pragma unroll
            for (int ks = 0; ks < 2; ++ks) { const bf16x8 kf = *(const LAS bf16x8*)(lds + AL_K + ((16 * (qt + a) + r) * 72 + 32 * ks + 8 * quad) * 2); s[a] = MFMA16(kf, qf[ks], s[a]); } }
        const int iq = 16 * qt + r; float mx = sink;
#pragma unroll
        for (int a = 0; a < 10; ++a)
#pragma unroll
            for (int i = 0; i < 4; ++i) { const int j = 16 * (qt + a) + 4 * quad + i, dist = 128 + iq - j; const bool valid = (unsigned)dist < 128u && (t0 - 128 + j) >= 0;
                const float v = valid ? s[a][i] - slope * (float)dist : -INFINITY; s[a][i] = v; mx = fmaxf(mx, v); }
        mx = fmaxf(mx, __shfl_xor(mx, 16)); mx = fmaxf(mx, __shfl_xor(mx, 32));
        float sum = 0.f;
#pragma unroll
        for (int a = 0; a < 10; ++a)
#pragma unroll
            for (int i = 0; i < 4; ++i) { const float p = __expf(s[a][i] - mx); s[a][i] = p; sum += p; }
        sum += __shfl_xor(sum, 16); sum += __shfl_xor(sum, 32); sum += __expf(sink - mx);
        const float inv = 1.f / sum;
        f32x4 o[4];
#pragma unroll
        for (int dt = 0; dt < 4; ++dt) o[dt] = (f32x4){0.f, 0.f, 0.f, 0.f};
#pragma unroll
        for (int kp = 0; kp < 5; ++kp) {
            const u32x4 pw = {pk2(s[2 * kp][0], s[2 * kp][1]), pk2(s[2 * kp][2], s[2 * kp][3]), pk2(s[2 * kp + 1][0], s[2 * kp + 1][1]), pk2(s[2 * kp + 1][2], s[2 * kp + 1][3])};
            const bf16x8 pb = __builtin_bit_cast(bf16x8, pw);
#pragma unroll
            for (int dt = 0; dt < 4; ++dt) {
                const u32x2 lo = *(const LAS u32x2*)(lds + AL_VT + ((16 * dt + r) * 216 + 16 * (qt + 2 * kp) + 4 * quad) * 2), hi = *(const LAS u32x2*)(lds + AL_VT + ((16 * dt + r) * 216 + 16 * (qt + 2 * kp + 1) + 4 * quad) * 2);
                const u32x4 vw = {lo.x, lo.y, hi.x, hi.y};
                o[dt] = MFMA16(__builtin_bit_cast(bf16x8, vw), pb, o[dt]); }
        }
#pragma unroll
        for (int dt = 0; dt < 4; ++dt) { u32x2 wv; wv.x = pk2(o[dt][0] * inv, o[dt][1] * inv); wv.y = pk2(o[dt][2] * inv, o[dt][3] * inv);
            *(u32x2*)(qbase + (size_t)iq * 1024 + 16 * dt + 4 * quad) = wv; }
    }
    __syncthreads();
}

__device__ __forceinline__ void rowstats_pass(const float* __restrict__ part, float* __restrict__ rs, int gtid, int NT) {
    for (int r = gtid; r < MTOK; r += NT) { const f32x4* p = (const f32x4*)(part + (size_t)r * 32); float s = 0.f;
#pragma unroll
        for (int j = 0; j < 8; ++j) { const f32x4 v = p[j]; s += (v[0] + v[1]) + (v[2] + v[3]); }
        rs[r] = rsqrtf(s * (1.f / DM) + EPSF); }
}

__device__ __forceinline__ const Args* kargs() { const Args* p = (const Args*)__builtin_amdgcn_kernarg_segment_ptr(); asm volatile("" : "+s"(p)); return p; }
#define ZP(off) (ka->ws + WS_Z + (off))
#define WL(off) ((const bf16*)(ka->ws + WS_W + (size_t)l * W_LAYER + (off)))
__global__ void __launch_bounds__(512, 2) fwd_mega(Args a_unused) {
    extern __shared__ __attribute__((aligned(16))) unsigned char lds_raw[];
    LAS unsigned char* lds = (LAS unsigned char*)lds_raw;
    cg::grid_group grid = cg::this_grid();
    const int G = gridDim.x, bx = blockIdx.x;
#define TIDS int tid_ = threadIdx.x; asm volatile("" : "+v"(tid_)); const int tid = tid_, lane = tid & 63, wave = __builtin_amdgcn_readfirstlane(tid >> 6), gw = bx * 8 + wave, NGW = G * 8, gtid = bx * 512 + tid, NT = G * 512; (void)lane; (void)gw; (void)NGW; (void)gtid; (void)NT;

    {
        const Args* ka = kargs(); TIDS
        unsigned char* ws = ka->ws; float* RS = (float*)(ws + WS_RS); float* LB = (float*)(ws + WS_LB); bf16* XB = (bf16*)(ws + WS_XB);
        LAS float* scr = (LAS float*)(lds + wave * 16384);
        constexpr int I_IN = (DM / 64) * (DIN / 32), I_HG = (HGW / 64) * (DM / 32), I_AT = (ATW / 64) * (DM / 32), I_OUT = (DM / 64) * (DM / 32), I_UP = (DM / 64) * (DFF / 32), I_DN = (DFF / 64) * (DM / 32);
        constexpr int I_LAYER = I_IN + I_HG + I_AT + I_OUT + I_UP + I_DN;
        for (int it = gw; it < 2 * I_LAYER; it += NGW) {
            const int l = it >= I_LAYER ? 1 : 0; int r = it - l * I_LAYER; unsigned char* wl = ws + WS_W + (size_t)l * W_LAYER;
            if (r < I_IN) { transpose_item(ka->w_in + (size_t)l * DM * DIN, ka->norm_mix + l * DM, DM, DIN, (bf16*)(wl + W_IN), scr, r, lane); continue; } r -= I_IN;
            if (r < I_HG) { transpose_item(ka->w_hg_out + (size_t)l * HGW * DM, nullptr, HGW, DM, (bf16*)(wl + W_HG), scr, r, lane); continue; } r -= I_HG;
            if (r < I_AT) { transpose_item(ka->w_at_out + (size_t)l * ATW * DM, nullptr, ATW, DM, (bf16*)(wl + W_AT), scr, r, lane); continue; } r -= I_AT;
            if (r < I_OUT) { transpose_item(ka->w_out + (size_t)l * DM * DM, nullptr, DM, DM, (bf16*)(wl + W_OUT), scr, r, lane); continue; } r -= I_OUT;
            if (r < I_UP) { transpose_item(ka->w_up + (size_t)l * DM * DFF, ka->norm_ffn + l * DM, DM, DFF, (bf16*)(wl + W_UP), scr, r, lane); continue; } r -= I_UP;
            transpose_item(ka->w_down + (size_t)l * DFF * DM, nullptr, DFF, DM, (bf16*)(wl + W_DN), scr, r, lane);
        }
        for (int c = gtid; c < 1024; c += NT) { LB[c] = 0.f; LB[1024 + c] = sigm(ka->lb_logits[1024 + c] - ka->lb_logits[c]); }
        const float* x = ka->x;
        for (int m = gw; m < MTOK; m += NGW) {
            const f32x4* xr = (const f32x4*)(x + (size_t)m * DM) + lane; f32x4 v[8]; float s = 0.f;
#pragma unroll
            for (int j = 0; j < 8; ++j) { v[j] = xr[64 * j]; s += (v[j][0] * v[j][0] + v[j][1] * v[j][1]) + (v[j][2] * v[j][2] + v[j][3] * v[j][3]); }
            s = wave_sum(s);
            if (lane == 0) RS[m] = rsqrtf(s * (1.f / DM) + EPSF);
            u32x2* o8 = (u32x2*)(XB + (size_t)m * DM) + lane;
#pragma unroll
            for (int j = 0; j < 8; ++j) { u32x2 w; w.x = pk2(v[j][0], v[j][1]); w.y = pk2(v[j][2], v[j][3]); o8[64 * j] = w; }
        }
    }
    grid.sync();

    for (int l = 0; l < 2; ++l) {
        if (ON(1)) {
            const Args* ka = kargs();
            pg8::Gemm g{(const bf16*)(ka->ws + WS_XB), WL(W_IN), MTOK, DIN, DM}; pg8::StaticOrder S; S.init(MTOK, DIN, G, bx);
            pg8::EpiIn E{(const float*)(ka->ws + WS_RS), (const float*)(ka->ws + WS_LB) + l * 1024, ka->ws + WS_Z};
            pg8::gemm_phase<pg8::EpiIn, pg8::StaticOrder, true, true>(lds, g, S, E);
        }
        grid.sync();
        {
            const Args* ka = kargs(); TIDS
            if (ON(2)) for (int item = bx; item < 4096; item += G) hgrn_a_item(lds, (const float*)ZP(Z_LOGF), (const bf16*)ZP(Z_VI), (bf16*)(ka->ws + WS_XB), (float*)(ka->ws + WS_PART), item, tid);
            if (ON(3)) qk_norm_pass((bf16*)ZP(Z_AQ), (bf16*)ZP(Z_AKV), ka->q_norm + l * 64, ka->k_norm + l * 64, gtid, NT);
        }
        grid.sync();
        {
            const Args* ka = kargs(); TIDS
            if (ON(2)) hgrn_scan((bf16*)(ka->ws + WS_XB), (const float*)(ka->ws + WS_PART), gtid, NT);
            if (ON(5)) for (int item = bx; item < 1024; item += G) attn_item(lds, (bf16*)ZP(Z_AQ), (const bf16*)ZP(Z_AKV), ka->sinks + l * 16, item, tid);
        }
        grid.sync();
        {
            const Args* ka = kargs(); TIDS
            if (ON(4)) for (int item = bx; item < 4096; item += G) hgrn_c_item(lds, (const bf16*)ZP(Z_QF), (const float*)ZP(Z_LOGF), (const bf16*)ZP(Z_VI), (const bf16*)(ka->ws + WS_XB), (bf16*)ZP(Z_HGATE), ka->hg_norm + l * 128, item, tid);
        }
        grid.sync();
        if (ON(6)) {
            const Args* ka = kargs();
            pg8::Gemm g{(const bf16*)ZP(Z_HGATE), WL(W_HG), MTOK, DM, HGW}; pg8::StaticOrder S; S.init(MTOK, DM, G, bx);
            pg8::EpiGate<0> E{(const bf16*)ZP(Z_GH), nullptr, (bf16*)ZP(Z_T1)};
            pg8::gemm_phase<pg8::EpiGate<0>, pg8::StaticOrder, true, true>(lds, g, S, E);
        }
        if (ON(7)) {
            const Args* ka = kargs();
            pg8::Gemm g{(const bf16*)ZP(Z_AQ), WL(W_AT), MTOK, DM, ATW}; pg8::StaticOrder S; S.init(MTOK, DM, G, bx);
            pg8::EpiGate<1> E{(const bf16*)ZP(Z_GA), (const bf16*)ZP(Z_T1), (bf16*)ZP(Z_MIX)};
            pg8::gemm_phase<pg8::EpiGate<1>, pg8::StaticOrder, true, true>(lds, g, S, E);
        }
        grid.sync();
        if (ON(8)) {
            const Args* ka = kargs();
            pg8::Gemm g{(const bf16*)ZP(Z_MIX), WL(W_OUT), MTOK, DM, DM}; pg8::StaticOrder S; S.init(MTOK, DM, G, bx);
            pg8::EpiRes E{l == 0 ? ka->x : (const float*)ka->out, ka->out, (bf16*)(ka->ws + WS_XB), (float*)(ka->ws + WS_PART)};
            pg8::gemm_phase<pg8::EpiRes, pg8::StaticOrder, true, true>(lds, g, S, E);
        }
        grid.sync();
        { const Args* ka = kargs(); TIDS rowstats_pass((const float*)(ka->ws + WS_PART), (float*)(ka->ws + WS_RS), gtid, NT); }
        grid.sync();
        if (ON(9)) {
            const Args* ka = kargs();
            pg8::Gemm g{(const bf16*)(ka->ws + WS_XB), WL(W_UP), MTOK, DFF, DM}; pg8::StaticOrder S; S.init(MTOK, DFF, G, bx);
            pg8::EpiUp E{(const float*)(ka->ws + WS_RS), (bf16*)ZP(Z_U)};
            pg8::gemm_phase<pg8::EpiUp, pg8::StaticOrder, true, true>(lds, g, S, E);
        }
        grid.sync();
        if (ON(10)) {
            const Args* ka = kargs();
            pg8::Gemm g{(const bf16*)ZP(Z_U), WL(W_DN), MTOK, DM, DFF}; pg8::StaticOrder S; S.init(MTOK, DM, G, bx);
            pg8::EpiRes E{ka->out, ka->out, l == 0 ? (bf16*)(ka->ws + WS_XB) : nullptr, (float*)(ka->ws + WS_PART)};
            pg8::gemm_phase<pg8::EpiRes, pg8::StaticOrder, true, true>(lds, g, S, E);
        }
        if (l == 0) { grid.sync(); { const Args* ka = kargs(); TIDS rowstats_pass((const float*)(ka->ws + WS_PART), (float*)(ka->ws + WS_RS), gtid, NT); } grid.sync(); }
    }
}

extern "C" void kernel_launch(void* const* d_in, const int* in_sizes, int n_in, void* d_out, int out_size, void* d_ws, size_t ws_size, hipStream_t stream) {
    static int grid = 0;
    if (grid == 0) {
        if (n_in != 14 || out_size != MTOK * DM || ws_size < WS_END) { fprintf(stderr, "kernel_launch: unexpected shapes (n_in %d out %d ws %zu need %zu)\n", n_in, out_size, ws_size, (size_t)WS_END); grid = -1; return; }
        int dev = 0, cus = 0, per_cu = 0;
        (void)hipGetDevice(&dev); (void)hipDeviceGetAttribute(&cus, hipDeviceAttributeMultiprocessorCount, dev);
        if (hipFuncSetAttribute((const void*)fwd_mega, hipFuncAttributeMaxDynamicSharedMemorySize, LDS_BYTES) != hipSuccess) { fprintf(stderr, "hipFuncSetAttribute failed\n"); grid = -1; return; }
        if (hipOccupancyMaxActiveBlocksPerMultiprocessor(&per_cu, (const void*)fwd_mega, 512, LDS_BYTES) != hipSuccess || per_cu < 1) { fprintf(stderr, "occupancy query: %d\n", per_cu); per_cu = 1; }
        (void)hipGetLastError();
        grid = cus * 1;
    }
    if (grid < 0) return;
    Args a{};
    a.x = (const float*)d_in[0]; a.norm_mix = (const float*)d_in[1]; a.w_in = (const float*)d_in[2]; a.lb_logits = (const float*)d_in[3]; a.hg_norm = (const float*)d_in[4];
    a.q_norm = (const float*)d_in[5]; a.k_norm = (const float*)d_in[6]; a.sinks = (const float*)d_in[7]; a.w_hg_out = (const float*)d_in[8]; a.w_at_out = (const float*)d_in[9];
    a.w_out = (const float*)d_in[10]; a.norm_ffn = (const float*)d_in[11]; a.w_up = (const float*)d_in[12]; a.w_down = (const float*)d_in[13];
    a.out = (float*)d_out; a.ws = (unsigned char*)d_ws;
    void* args[] = {&a};
    hipError_t e = hipLaunchCooperativeKernel((const void*)fwd_mega, dim3(grid), dim3(512), args, LDS_BYTES, stream);
    if (e != hipSuccess) fprintf(stderr, "cooperative launch failed: %s (grid %d)\n", hipGetErrorString(e), grid);
}
```

```cpp
#include <hip/hip_runtime.h>
#include <hip/hip_cooperative_groups.h>
#include <cstdio>
#include <cstdint>
namespace cg = cooperative_groups;
namespace pg8 {
#define PG8_LAS __attribute__((address_space(3)))
typedef unsigned short bf16_t;
typedef short bf16x8 __attribute__((ext_vector_type(8)));
typedef float f32x4 __attribute__((ext_vector_type(4)));
typedef unsigned u32x4 __attribute__((ext_vector_type(4)));
constexpr int BM = 256, BK = 64, HALF = 128, HTB = HALF * BK * 2  , STAGE_BYTES = 8 * HTB, NXCD = 8, WGM = 8;

__host__ __device__ __forceinline__ int lds_byte(int r, int c) { const int st = (r >> 4) * 2 + (c >> 5), rr = r & 15, cc = c & 31, ob = rr * 64 + cc * 2; return st * 1024 + (ob ^ (((ob >> 9) & 1) << 5)); }
__host__ __device__ __forceinline__ void stage_rc(int b, int& R, int& C) { const int st = b / 1024, sb = b % 1024, swz = sb ^ (((sb >> 9) & 1) << 5); R = (st >> 1) * 16 + swz / 64; C = (st & 1) * 32 + (swz % 64) / 2; }
__host__ __device__ __forceinline__ int perm32(int rho) { const int n = rho >> 4, i = rho & 15; return 8 * (i >> 2) + 4 * n + (i & 3); }

struct Unit { int pm, pn; };
struct Gemm { const bf16_t* A; const bf16_t* Bt; int M, N, K; };

struct StaticOrder {
    int nM, nN, nwg, G, c, rep;
    __host__ __device__ void init(int M, int N, int G_, int c_, int rep_ = 1) { nM = M / BM; nN = N / BM; nwg = nM * nN; G = G_; c = c_; rep = rep_; }
    __host__ __device__ bool next(int i, Unit& u) const {
        int L = i * G + c; if (L >= nwg * rep) return false; if (L >= nwg) L -= nwg;
        int wgid = (int)L; { const int q = nwg / NXCD, r = nwg % NXCD, xcd = wgid % NXCD, off = wgid / NXCD; wgid = (xcd < r ? xcd * (q + 1) : r * (q + 1) + (xcd - r) * q) + off; }
        const int nig = WGM * nN, gid = wgid / nig, fm = gid * WGM, gsz = (nM - fm) < WGM ? (nM - fm) : WGM;
        u.pm = fm + ((wgid % nig) % gsz); u.pn = (wgid % nig) / gsz; return true;
    }
    __device__ __forceinline__ void a_ready(const Unit&) const {}
    __device__ __forceinline__ void done(const Unit&) const {}
};
__device__ __forceinline__ unsigned cvt_pk_bf16(float lo, float hi) { unsigned r; asm volatile("v_cvt_pk_bf16_f32 %0, %1, %2" : "=v"(r) : "v"(lo), "v"(hi)); return r; }
typedef float f32x2 __attribute__((ext_vector_type(2)));
template <class Epi, class Sched, bool ALIGN_EPI = false, bool SP2 = false>
__device__ __forceinline__ void gemm_phase(PG8_LAS unsigned char* lds, const Gemm g, const Sched& S, const Epi& E, int tid_in) {
    int tid_ = tid_in; asm volatile("" : "+v"(tid_));
    const int tid = tid_, wid = __builtin_amdgcn_readfirstlane(tid >> 6), lane = tid & 63, wr = wid >> 2, wc = wid & 3, fr = lane & 15, fq = lane >> 4;
    const int K = g.K, nt = K / BK;
    unsigned voffA[2], voffB[2];
#pragma unroll
    for (int i = 0; i < 2; ++i) { int R, C; stage_rc(tid * 16 + i * 8192, R, C); const int Rb = Epi::PERM ? ((R & ~31) + perm32(R & 31)) : R;
        voffA[i] = (unsigned)(R * K + C) * 2u; voffB[i] = (unsigned)(Rb * K + C) * 2u; }
    const size_t kstep = (size_t)(BK * 2);
    const size_t hstep = (size_t)HALF * K * 2;
    const size_t tstep = 2 * hstep;
    const unsigned ldsw = (unsigned)wid * 1024u;
    const int aoff = lds_byte(wr * 64 + fr, fq * 8), boff = lds_byte(wc * 32 + fr, fq * 8);
#define PG8_SA(b, h) (((b) * 2 + (h)) * HTB)
#define PG8_SB(b, h) ((4 + (b) * 2 + (h)) * HTB)
#define PG8_STAGE(bufoff, gbase, voff) do { _Pragma("unroll") for (int _i = 0; _i < 2; ++_i) \
        __builtin_amdgcn_global_load_lds((const unsigned*)((const char*)(gbase) + (voff)[_i]), (PG8_LAS unsigned*)(lds + (bufoff) + ldsw + _i * 8192), 16, 0, 0); } while (0)
#define PG8_LDA(dst, b, h) do { _Pragma("unroll") for (int m = 0; m < 4; ++m) _Pragma("unroll") for (int k = 0; k < 2; ++k) dst[m][k] = *(const PG8_LAS bf16x8*)(lds + PG8_SA(b, h) + aoff + m * 2048 + k * 1024); } while (0)
#define PG8_LDB(dst, b, h) do { _Pragma("unroll") for (int n = 0; n < 2; ++n) _Pragma("unroll") for (int k = 0; k < 2; ++k) dst[n][k] = *(const PG8_LAS bf16x8*)(lds + PG8_SB(b, h) + boff + n * 2048 + k * 1024); } while (0)
#define PG8_MMA(ai, bj, At, Bt) do { __builtin_amdgcn_s_setprio(1); _Pragma("unroll") for (int m = 0; m < 4; ++m) _Pragma("unroll") for (int n = 0; n < 2; ++n) _Pragma("unroll") for (int k = 0; k < 2; ++k) \
        acc[ai][bj][m][n] = __builtin_amdgcn_mfma_f32_16x16x32_bf16(Bt[n][k], At[m][k], acc[ai][bj][m][n], 0, 0, 0); __builtin_amdgcn_s_setprio(0); } while (0)
#define PG8_WAIT_V(n) asm volatile("s_waitcnt vmcnt(" #n ")" ::: "memory")
#define PG8_WAIT_L(n) asm volatile("s_waitcnt lgkmcnt(" #n ")" ::: "memory")
#define PG8_BAR __builtin_amdgcn_s_barrier()
#define PG8_SCHED __builtin_amdgcn_sched_barrier(0)
    Unit cur, nxt; int ui = 0;
    if (!S.next(0, cur)) return;
    f32x4 acc[2][2][4][2];
#pragma unroll
    for (int a = 0; a < 2; ++a)
#pragma unroll
        for (int b = 0; b < 2; ++b)
#pragma unroll
            for (int m = 0; m < 4; ++m)
#pragma unroll
                for (int n = 0; n < 2; ++n) acc[a][b][m][n] = (f32x4){0.f, 0.f, 0.f, 0.f};
    bf16x8 At[4][2], B0[2][2], B1[2][2];
    const char* cA = (const char*)g.A + (size_t)cur.pm * tstep; const char* cB = (const char*)g.Bt + (size_t)cur.pn * tstep;
    S.a_ready(cur);
    if constexpr (SP2) {
        PG8_STAGE(PG8_SB(0, 0), cB, voffB); PG8_STAGE(PG8_SB(0, 1), cB + hstep, voffB); PG8_STAGE(PG8_SA(0, 0), cA, voffA); PG8_STAGE(PG8_SA(0, 1), cA + hstep, voffA);
        if (wr == 1) PG8_BAR;
        PG8_WAIT_V(2); PG8_BAR;
        PG8_STAGE(PG8_SB(1, 0), cB + kstep, voffB); PG8_STAGE(PG8_SA(1, 0), cA + kstep, voffA); PG8_STAGE(PG8_SB(1, 1), cB + hstep + kstep, voffB);
        PG8_WAIT_V(6); PG8_BAR;
    } else {
        PG8_STAGE(PG8_SB(0, 0), cB, voffB); PG8_STAGE(PG8_SA(0, 0), cA, voffA); PG8_STAGE(PG8_SB(0, 1), cB + hstep, voffB); PG8_STAGE(PG8_SA(0, 1), cA + hstep, voffA);
        if (wr == 1) PG8_BAR;
        PG8_WAIT_V(4); PG8_BAR;
        PG8_STAGE(PG8_SB(1, 0), cB + kstep, voffB); PG8_STAGE(PG8_SA(1, 0), cA + kstep, voffA); PG8_STAGE(PG8_SB(1, 1), cB + hstep + kstep, voffB);
        PG8_WAIT_V(6); PG8_BAR;
    }
    for (;;) {
        const bool has_next = S.next(ui + 1, nxt);
        const char* nA = has_next ? (const char*)g.A + (size_t)nxt.pm * tstep : cA; const char* nB = has_next ? (const char*)g.Bt + (size_t)nxt.pn * tstep : cB;
        for (int t = 0; t < nt; t += 2) {
            const bool last = (t == nt - 2);
            const char* a1 = cA + (size_t)(t + 1) * kstep;
            const char* a2 = last ? nA : cA + (size_t)(t + 2) * kstep; const char* b2 = last ? nB : cB + (size_t)(t + 2) * kstep;
            const char* a3 = a2 + kstep; const char* b3 = b2 + kstep;
            if (last && has_next) S.a_ready(nxt);
            if constexpr (SP2) {
            PG8_LDB(B0, 0, 0); PG8_LDB(B1, 0, 1); PG8_SCHED; PG8_LDA(At, 0, 0); PG8_STAGE(PG8_SA(1, 1), a1 + hstep, voffA);
            PG8_WAIT_V(8); PG8_WAIT_L(0); PG8_BAR; PG8_MMA(0, 0, At, B0); PG8_MMA(0, 1, At, B1); PG8_BAR; PG8_SCHED;
            PG8_LDA(At, 0, 1); PG8_STAGE(PG8_SB(0, 0), b2, voffB); PG8_STAGE(PG8_SB(0, 1), b2 + hstep, voffB); PG8_STAGE(PG8_SA(0, 0), a2, voffA);
            PG8_WAIT_V(8); PG8_WAIT_L(0); PG8_BAR; PG8_MMA(1, 0, At, B0); PG8_MMA(1, 1, At, B1); PG8_BAR; PG8_SCHED;
            PG8_LDB(B0, 1, 0); PG8_LDB(B1, 1, 1); PG8_SCHED; PG8_LDA(At, 1, 0); PG8_STAGE(PG8_SA(0, 1), a2 + hstep, voffA);
            PG8_WAIT_V(8); PG8_WAIT_L(0); PG8_BAR; PG8_MMA(0, 0, At, B0); PG8_MMA(0, 1, At, B1); PG8_BAR; PG8_SCHED;
            PG8_LDA(At, 1, 1); PG8_STAGE(PG8_SB(1, 0), b3, voffB); PG8_STAGE(PG8_SB(1, 1), b3 + hstep, voffB); PG8_STAGE(PG8_SA(1, 0), a3, voffA);
            PG8_WAIT_V(8); PG8_WAIT_L(0); PG8_BAR; PG8_MMA(1, 0, At, B0); PG8_MMA(1, 1, At, B1); PG8_BAR; PG8_SCHED;
            } else {
            PG8_LDB(B0, 0, 0); PG8_SCHED; PG8_LDA(At, 0, 0); PG8_STAGE(PG8_SA(1, 1), a1 + hstep, voffA);
            PG8_WAIT_L(8); PG8_BAR; PG8_WAIT_L(0); PG8_MMA(0, 0, At, B0); PG8_BAR; PG8_SCHED;
            PG8_LDB(B1, 0, 1); PG8_STAGE(PG8_SB(0, 0), b2, voffB);
            PG8_BAR; PG8_WAIT_L(0); PG8_MMA(0, 1, At, B1); PG8_BAR;
            PG8_LDA(At, 0, 1); PG8_STAGE(PG8_SA(0, 0), a2, voffA);
            PG8_BAR; PG8_WAIT_L(0); PG8_MMA(1, 0, At, B0); PG8_BAR; PG8_SCHED;
            PG8_STAGE(PG8_SB(0, 1), b2 + hstep, voffB);
            PG8_WAIT_V(6); PG8_BAR; PG8_MMA(1, 1, At, B1); PG8_BAR;
            PG8_LDB(B0, 1, 0); PG8_SCHED; PG8_LDA(At, 1, 0); PG8_STAGE(PG8_SA(0, 1), a2 + hstep, voffA);
            PG8_WAIT_L(8); PG8_BAR; PG8_WAIT_L(0); PG8_MMA(0, 0, At, B0); PG8_BAR; PG8_SCHED;
            PG8_LDB(B1, 1, 1); PG8_STAGE(PG8_SB(1, 0), b3, voffB);
            PG8_BAR; PG8_WAIT_L(0); PG8_MMA(0, 1, At, B1); PG8_BAR;
            PG8_LDA(At, 1, 1); PG8_STAGE(PG8_SA(1, 0), a3, voffA);
            PG8_BAR; PG8_WAIT_L(0); PG8_MMA(1, 0, At, B0); PG8_BAR; PG8_SCHED;
            PG8_STAGE(PG8_SB(1, 1), b3 + hstep, voffB);
            PG8_WAIT_V(6); PG8_BAR; PG8_MMA(1, 1, At, B1); PG8_BAR;
            }
        }
        if constexpr (ALIGN_EPI) { if (wr == 0) PG8_BAR; }
        if constexpr (!Epi::AFTER_DRAIN) { E(acc, cur, wr, wc, fr, fq); S.done(cur); }
        if (!has_next) break;
#pragma unroll
        for (int a = 0; a < 2; ++a)
#pragma unroll
            for (int b = 0; b < 2; ++b)
#pragma unroll
                for (int m = 0; m < 4; ++m)
#pragma unroll
                    for (int n = 0; n < 2; ++n) acc[a][b][m][n] = (f32x4){0.f, 0.f, 0.f, 0.f};
        cur = nxt; cA = nA; cB = nB; ++ui;
        if constexpr (ALIGN_EPI) { if (wr == 1) PG8_BAR; }
    }
    PG8_WAIT_V(0);
    if constexpr (!ALIGN_EPI) { if (wr == 0) PG8_BAR; }
    PG8_BAR;
    if constexpr (Epi::AFTER_DRAIN) { E.fused(acc, cur, wr, wc, fr, fq, lds, wid, lane); S.done(cur); }
#undef PG8_SA
#undef PG8_SB
#undef PG8_STAGE
#undef PG8_LDA
#undef PG8_LDB
#undef PG8_MMA
#undef PG8_WAIT_V
#undef PG8_WAIT_L
#undef PG8_BAR
#undef PG8_SCHED
}
}

constexpr int BATCH = 2, SEQ = 16384, DM = 2048, MTOK = BATCH * SEQ;
constexpr int HGH = 8, HGD = 128, HGW = 1024;
constexpr int ATH = 16, ATD = 64, ATW = 1024, WIN = 128;
constexpr int DIN = 9472, DFF = 8192;
constexpr float EPSF = 1e-6f;

#define LAS __attribute__((address_space(3)))
typedef unsigned short bf16;
typedef float f32x4 __attribute__((ext_vector_type(4)));
typedef unsigned u32x4 __attribute__((ext_vector_type(4)));
typedef unsigned u32x2 __attribute__((ext_vector_type(2)));

__device__ __forceinline__ float sigm(float x) { return __builtin_amdgcn_rcpf(1.f + __expf(-x)); }
__device__ __forceinline__ float bflo(unsigned w) { return __uint_as_float(w << 16); }
__device__ __forceinline__ float bfhi(unsigned w) { return __uint_as_float(w & 0xffff0000u); }
typedef __bf16 bf16x2_t __attribute__((ext_vector_type(2)));
typedef float f32x2_t __attribute__((ext_vector_type(2)));
__device__ __forceinline__ unsigned pk2(float lo, float hi) { const f32x2_t v = {lo, hi}; const bf16x2_t b = __builtin_convertvector(v, bf16x2_t); return __builtin_bit_cast(unsigned, b); }

constexpr size_t WS_RS = 0;
constexpr size_t WS_LB = 131072;
constexpr size_t WS_BAR = 196608;
constexpr size_t WS_PART = 262144;
constexpr size_t WS_W = WS_PART + (size_t)MTOK * 32 * 4;
constexpr size_t W_IN = 0, W_HG = W_IN + (size_t)DIN * DM * 2, W_AT = W_HG + (size_t)DM * HGW * 2, W_OUT = W_AT + (size_t)DM * ATW * 2,
                 W_UP = W_OUT + (size_t)DM * DM * 2, W_DN = W_UP + (size_t)DFF * DM * 2, W_LAYER = W_DN + (size_t)DM * DFF * 2;
constexpr size_t WS_XB = WS_W + 2 * W_LAYER;
constexpr size_t WS_Z = WS_XB + (size_t)MTOK * DM * 2;
constexpr size_t Z_QF = 0, Z_LOGF = Z_QF + (size_t)MTOK * 1024 * 2, Z_VI = Z_LOGF + (size_t)MTOK * 1024 * 4, Z_HGATE = Z_VI + (size_t)MTOK * 1024 * 2,
                 Z_AQ = Z_HGATE + (size_t)MTOK * 1024 * 2, Z_AKV = Z_AQ + (size_t)MTOK * 1024 * 2, Z_GH = Z_AKV + (size_t)MTOK * 256 * 2,
                 Z_GA = Z_GH + (size_t)MTOK * 2048 * 2, Z_END = Z_GA + (size_t)MTOK * 2048 * 2;
constexpr size_t Z_T1 = 0, Z_MIX = (size_t)MTOK * 2048 * 2;
constexpr size_t Z_U = 0;
constexpr size_t WS_END = WS_Z + Z_END;
static_assert(Z_MIX + (size_t)MTOK * 2048 * 2 <= Z_HGATE, "T1|MIX overlay");
static_assert((size_t)MTOK * DFF * 2 <= Z_END, "U overlay");
static_assert(WS_END <= 1073741824ull, "workspace");

constexpr int LDS_BYTES = 147456;
#ifndef PH
#define PH 0xFFFF
#endif
#define ON(k) ((PH >> (k)) & 1)
#ifndef REP_G1
#define REP_G1 1
#endif
#ifndef REP_G5
#define REP_G5 1
#endif
#ifndef REP_G23
#define REP_G23 1
#endif
#ifndef REP_P0
#define REP_P0 1
#endif
#ifndef XSYNC
#define XSYNC 0
#endif
#ifndef REP_HA
#define REP_HA 1
#endif

namespace pg8 {
struct EpiIn {
    static constexpr bool PERM = true, AFTER_DRAIN = false;
    const float* rs; const float* lb; unsigned char* Z;
    __device__ __forceinline__ void operator()(const f32x4 (&acc)[2][2][4][2], const Unit& u, int wr, int wc, int fr, int fq) const {
        const int pn = u.pn; int kind, ld, tb; size_t zo;
        if (pn < 4)       { kind = 0; zo = Z_QF;    ld = 1024; tb = pn * 256; }
        else if (pn < 8)  { kind = 1; zo = Z_LOGF;  ld = 1024; tb = (pn - 4) * 256; }
        else if (pn < 12) { kind = 2; zo = Z_VI;    ld = 1024; tb = (pn - 8) * 256; }
        else if (pn < 16) { kind = 0; zo = Z_HGATE; ld = 1024; tb = (pn - 12) * 256; }
        else if (pn < 20) { kind = 2; zo = Z_AQ;    ld = 1024; tb = (pn - 16) * 256; }
        else if (pn == 20){ kind = 2; zo = Z_AKV;   ld = 256;  tb = 0; }
        else if (pn < 29) { kind = 3; zo = Z_GH;    ld = 2048; tb = (pn - 21) * 256; }
        else              { kind = 3; zo = Z_GA;    ld = 2048; tb = (pn - 29) * 256; }
        const int row0 = u.pm * BM + wr * 64 + fr, col0 = tb + wc * 32 + 8 * fq;
        if (kind == 1) {
            float* LOGF = (float*)(Z + zo);
            f32x4 lbv[2][2];
#pragma unroll
            for (int bj = 0; bj < 2; ++bj)
#pragma unroll
                for (int n = 0; n < 2; ++n) lbv[bj][n] = *(const f32x4*)(lb + col0 + bj * HALF + 4 * n);
#pragma unroll
            for (int ai = 0; ai < 2; ++ai)
#pragma unroll
                for (int m = 0; m < 4; ++m) { const int row = row0 + ai * HALF + m * 16; const float s = rs[row]; float* rp = LOGF + (size_t)row * 1024 + col0;
#pragma unroll
                    for (int bj = 0; bj < 2; ++bj)
#pragma unroll
                        for (int n = 0; n < 2; ++n) { const f32x4 v = acc[ai][bj][m][n] * s; f32x4 o;
#pragma unroll
                            for (int e = 0; e < 4; ++e) { const float l = lbv[bj][n][e]; o[e] = __logf(l + (1.f - l) * sigm(v[e])); }
                            *(f32x4*)(rp + bj * HALF + 4 * n) = o; } }
        } else {
            bf16_t* dst = (bf16_t*)(Z + zo);
#pragma unroll
            for (int ai = 0; ai < 2; ++ai)
#pragma unroll
                for (int m = 0; m < 4; ++m) { const int row = row0 + ai * HALF + m * 16; const float s = rs[row]; bf16_t* rp = dst + (size_t)row * ld + col0;
#pragma unroll
                    for (int bj = 0; bj < 2; ++bj) { f32x4 v0 = acc[ai][bj][m][0] * s, v1 = acc[ai][bj][m][1] * s;
                        if (kind == 0) {
#pragma unroll
                            for (int e = 0; e < 4; ++e) { v0[e] = v0[e] * sigm(v0[e]); v1[e] = v1[e] * sigm(v1[e]); }
                        } else if (kind == 3) {
#pragma unroll
                            for (int e = 0; e < 4; ++e) { v0[e] = sigm(v0[e]); v1[e] = sigm(v1[e]); }
                        }
                        u32x4 w; w.x = cvt_pk_bf16(v0[0], v0[1]); w.y = cvt_pk_bf16(v0[2], v0[3]); w.z = cvt_pk_bf16(v1[0], v1[1]); w.w = cvt_pk_bf16(v1[2], v1[3]);
                        *(u32x4*)(rp + bj * HALF) = w; } }
        }
    }
};
template <int MODE> struct EpiGate {
    static constexpr bool PERM = true, AFTER_DRAIN = false;
    const bf16_t* gate; const bf16_t* t1; bf16_t* dst;
    __device__ __forceinline__ void operator()(const f32x4 (&acc)[2][2][4][2], const Unit& u, int wr, int wc, int fr, int fq) const {
        const int row0 = u.pm * BM + wr * 64 + fr, col0 = u.pn * BM + wc * 32 + 8 * fq;
#pragma unroll
        for (int ai = 0; ai < 2; ++ai)
#pragma unroll
            for (int m = 0; m < 4; ++m) { const size_t off = (size_t)(row0 + ai * HALF + m * 16) * 2048 + col0;
#pragma unroll
                for (int bj = 0; bj < 2; ++bj) { const u32x4 g = *(const u32x4*)(gate + off + bj * HALF);
                    f32x4 v0 = acc[ai][bj][m][0], v1 = acc[ai][bj][m][1];
                    v0[0] *= bflo(g.x); v0[1] *= bfhi(g.x); v0[2] *= bflo(g.y); v0[3] *= bfhi(g.y); v1[0] *= bflo(g.z); v1[1] *= bfhi(g.z); v1[2] *= bflo(g.w); v1[3] *= bfhi(g.w);
                    if (MODE == 1) { const u32x4 t = *(const u32x4*)(t1 + off + bj * HALF);
                        v0[0] += bflo(t.x); v0[1] += bfhi(t.x); v0[2] += bflo(t.y); v0[3] += bfhi(t.y); v1[0] += bflo(t.z); v1[1] += bfhi(t.z); v1[2] += bflo(t.w); v1[3] += bfhi(t.w); }
                    u32x4 w; w.x = cvt_pk_bf16(v0[0], v0[1]); w.y = cvt_pk_bf16(v0[2], v0[3]); w.z = cvt_pk_bf16(v1[0], v1[1]); w.w = cvt_pk_bf16(v1[2], v1[3]);
                    *(u32x4*)(dst + off + bj * HALF) = w; } }
    }
};
struct EpiRes {
    static constexpr bool PERM = true, AFTER_DRAIN = false;
    const float* resid; float* out; bf16_t* xb; float* part;
    __device__ __forceinline__ void operator()(const f32x4 (&acc)[2][2][4][2], const Unit& u, int wr, int wc, int fr, int fq) const {
        const int row0 = u.pm * BM + wr * 64 + fr, col0 = u.pn * BM + wc * 32 + 8 * fq;
#pragma unroll
        for (int ai = 0; ai < 2; ++ai)
#pragma unroll
            for (int m = 0; m < 4; ++m) { const int row = row0 + ai * HALF + m * 16; const size_t off = (size_t)row * 2048 + col0; float ss = 0.f;
#pragma unroll
                for (int bj = 0; bj < 2; ++bj) { const f32x4 r0 = *(const f32x4*)(resid + off + bj * HALF), r1 = *(const f32x4*)(resid + off + bj * HALF + 4);
                    const f32x4 o0 = r0 + acc[ai][bj][m][0], o1 = r1 + acc[ai][bj][m][1];
                    *(f32x4*)(out + off + bj * HALF) = o0; *(f32x4*)(out + off + bj * HALF + 4) = o1;
                    if (xb) { ss += (o0[0] * o0[0] + o0[1] * o0[1]) + (o0[2] * o0[2] + o0[3] * o0[3]) + (o1[0] * o1[0] + o1[1] * o1[1]) + (o1[2] * o1[2] + o1[3] * o1[3]);
                        u32x4 w; w.x = cvt_pk_bf16(o0[0], o0[1]); w.y = cvt_pk_bf16(o0[2], o0[3]); w.z = cvt_pk_bf16(o1[0], o1[1]); w.w = cvt_pk_bf16(o1[2], o1[3]);
                        *(u32x4*)(xb + off + bj * HALF) = w; } }
                if (xb) { ss += __shfl_xor(ss, 16); ss += __shfl_xor(ss, 32); if (fq == 0) part[(size_t)row * 32 + u.pn * 4 + wc] = ss; } }
    }
};
struct EpiUp {
    static constexpr bool PERM = true, AFTER_DRAIN = false;
    const float* rs; bf16_t* dst;
    __device__ __forceinline__ void operator()(const f32x4 (&acc)[2][2][4][2], const Unit& u, int wr, int wc, int fr, int fq) const {
        const int row0 = u.pm * BM + wr * 64 + fr, col0 = u.pn * BM + wc * 32 + 8 * fq;
#pragma unroll
        for (int ai = 0; ai < 2; ++ai)
#pragma unroll
            for (int m = 0; m < 4; ++m) { const int row = row0 + ai * HALF + m * 16; const float s = rs[row]; bf16_t* rp = dst + (size_t)row * DFF + col0;
#pragma unroll
                for (int bj = 0; bj < 2; ++bj) { f32x4 v0 = acc[ai][bj][m][0] * s, v1 = acc[ai][bj][m][1] * s;
#pragma unroll
                    for (int e = 0; e < 4; ++e) { const float a = fmaxf(v0[e], 0.f), b = fmaxf(v1[e], 0.f); v0[e] = a * a; v1[e] = b * b; }
                    u32x4 w; w.x = cvt_pk_bf16(v0[0], v0[1]); w.y = cvt_pk_bf16(v0[2], v0[3]); w.z = cvt_pk_bf16(v1[0], v1[1]); w.w = cvt_pk_bf16(v1[2], v1[3]);
                    *(u32x4*)(rp + bj * HALF) = w; } }
    }
};
}

__device__ __forceinline__ float wave_sum(float v) {
#pragma unroll
    for (int o = 1; o < 64; o <<= 1) v += __shfl_xor(v, o);
    return v;
}
__device__ __forceinline__ void transpose_item(const float* __restrict__ W, const float* __restrict__ gain, int K, int N, bf16* __restrict__ WT, LAS float* scr, int item, int lane) {
    const int nblk = N / 32, kb = item / nblk, nb = item % nblk, k0 = 64 * kb, n0 = 32 * nb;
    float wv[32];
#pragma unroll
    for (int i = 0; i < 32; ++i) { const int kk = 2 * i + (lane >> 5); wv[i] = W[(size_t)(k0 + kk) * N + n0 + (lane & 31)]; }
    const float g0 = gain ? gain[k0 + (lane & 63)] : 1.f;
#pragma unroll
    for (int i = 0; i < 32; ++i) { const int kk = 2 * i + (lane >> 5); const float g = __shfl(g0, kk); scr[kk * 33 + (lane & 31)] = wv[i] * g; }
    asm volatile("s_waitcnt lgkmcnt(0)" ::: "memory");
    const int c = lane & 7;
#pragma unroll
    for (int j = 0; j < 4; ++j) { const int n = (lane >> 3) + 8 * j; const LAS float* s = scr + (8 * c) * 33 + n;
        u32x4 o; o.x = pk2(s[0 * 33], s[1 * 33]); o.y = pk2(s[2 * 33], s[3 * 33]); o.z = pk2(s[4 * 33], s[5 * 33]); o.w = pk2(s[6 * 33], s[7 * 33]);
        *(u32x4*)(WT + (size_t)(n0 + n) * K + k0 + 8 * c) = o; }
    asm volatile("s_waitcnt lgkmcnt(0)" ::: "memory");
}

struct Args {
    const float *x, *norm_mix, *w_in, *lb_logits, *hg_norm, *q_norm, *k_norm, *sinks, *w_hg_out, *w_at_out, *w_out, *norm_ffn, *w_up, *w_down;
    float* out; unsigned char* ws;
};

__device__ __forceinline__ void hgrn2_seq(const bf16* __restrict__ QF, const float* __restrict__ LOGF, const bf16* __restrict__ VI, float* __restrict__ ORAW, int item, int tid) {
    const int bh = item >> 3, vs = item & 7, b = bh >> 3, h = bh & 7;
    const int lane = tid & 63, w = tid >> 6, kg = lane & 31, v = vs * 16 + w * 2 + (lane >> 5);
    const size_t rowbase = (size_t)b * SEQ;
    const int kc = h * 128 + kg * 4, vc = h * 128 + v;
    float S0 = 0.f, S1 = 0.f, S2 = 0.f, S3 = 0.f;
    f32x4 nlf[4]; u32x2 nq[4]; unsigned short nv[4];
#pragma unroll
    for (int j = 0; j < 4; ++j) { const size_t o = (rowbase + j) * 1024; nlf[j] = *(const f32x4*)(LOGF + o + kc); nq[j] = *(const u32x2*)(QF + o + kc); nv[j] = VI[o + vc]; }
    for (int t = 0; t < SEQ; t += 4) {
        f32x4 clf[4]; u32x2 cq[4]; unsigned short cv[4];
#pragma unroll
        for (int j = 0; j < 4; ++j) { clf[j] = nlf[j]; cq[j] = nq[j]; cv[j] = nv[j]; }
        if (t + 4 < SEQ) {
#pragma unroll
            for (int j = 0; j < 4; ++j) { const size_t o = (rowbase + t + 4 + j) * 1024; nlf[j] = *(const f32x4*)(LOGF + o + kc); nq[j] = *(const u32x2*)(QF + o + kc); nv[j] = VI[o + vc]; }
        }
#pragma unroll
        for (int j = 0; j < 4; ++j) {
            const float f0 = __expf(clf[j][0]), f1 = __expf(clf[j][1]), f2 = __expf(clf[j][2]), f3 = __expf(clf[j][3]);
            const float vv = __uint_as_float((unsigned)cv[j] << 16);
            S0 = f0 * S0 + (1.f - f0) * vv; S1 = f1 * S1 + (1.f - f1) * vv; S2 = f2 * S2 + (1.f - f2) * vv; S3 = f3 * S3 + (1.f - f3) * vv;
            float o = (bflo(cq[j].x) * S0 + bfhi(cq[j].x) * S1) + (bflo(cq[j].y) * S2 + bfhi(cq[j].y) * S3);
            o += __shfl_xor(o, 1); o += __shfl_xor(o, 2); o += __shfl_xor(o, 4); o += __shfl_xor(o, 8); o += __shfl_xor(o, 16);
            if (kg == 0) ORAW[(rowbase + t + j) * 1024 + vc] = o;
        }
    }
}

__device__ __forceinline__ void qk_norm_pass(bf16* AQ, bf16* AKV, const float* qn, const float* kn, int gtid, int NT) {
    const int sub = gtid & 7;
    f32x4 g0 = *(const f32x4*)(qn + sub * 8), g1 = *(const f32x4*)(qn + sub * 8 + 4);
    for (size_t c = gtid; c < (size_t)MTOK * 128; c += NT) {
        u32x4 w = *(u32x4*)(AQ + c * 8);
        float v[8] = {bflo(w.x), bfhi(w.x), bflo(w.y), bfhi(w.y), bflo(w.z), bfhi(w.z), bflo(w.w), bfhi(w.w)};
        float ss = 0.f;
#pragma unroll
        for (int e = 0; e < 8; ++e) ss += v[e] * v[e];
        ss += __shfl_xor(ss, 1); ss += __shfl_xor(ss, 2); ss += __shfl_xor(ss, 4);
        const float r = rsqrtf(ss * (1.f / 64.f) + EPSF) * 0.125f;
        u32x4 o; o.x = pk2(v[0] * r * g0[0], v[1] * r * g0[1]); o.y = pk2(v[2] * r * g0[2], v[3] * r * g0[3]); o.z = pk2(v[4] * r * g1[0], v[5] * r * g1[1]); o.w = pk2(v[6] * r * g1[2], v[7] * r * g1[3]);
        *(u32x4*)(AQ + c * 8) = o;
    }
    g0 = *(const f32x4*)(kn + sub * 8); g1 = *(const f32x4*)(kn + sub * 8 + 4);
    for (size_t c = gtid; c < (size_t)MTOK * 16; c += NT) {
        bf16* p = AKV + (c >> 4) * 256 + (c & 15) * 8;
        u32x4 w = *(u32x4*)p;
        float v[8] = {bflo(w.x), bfhi(w.x), bflo(w.y), bfhi(w.y), bflo(w.z), bfhi(w.z), bflo(w.w), bfhi(w.w)};
        float ss = 0.f;
#pragma unroll
        for (int e = 0; e < 8; ++e) ss += v[e] * v[e];
        ss += __shfl_xor(ss, 1); ss += __shfl_xor(ss, 2); ss += __shfl_xor(ss, 4);
        const float r = rsqrtf(ss * (1.f / 64.f) + EPSF);
        u32x4 o; o.x = pk2(v[0] * r * g0[0], v[1] * r * g0[1]); o.y = pk2(v[2] * r * g0[2], v[3] * r * g0[3]); o.z = pk2(v[4] * r * g1[0], v[5] * r * g1[1]); o.w = pk2(v[6] * r * g1[2], v[7] * r * g1[3]);
        *(u32x4*)p = o;
    }
}

__device__ __forceinline__ void hg_norm_pass(const float* __restrict__ ORAW, bf16* HGATE, const float* hn, int gtid, int NT) {
    const int sub = gtid & 15;
    const f32x4 g0 = *(const f32x4*)(hn + sub * 8), g1 = *(const f32x4*)(hn + sub * 8 + 4);
    for (size_t c = gtid; c < (size_t)MTOK * 128; c += NT) {
        const f32x4 a = *(const f32x4*)(ORAW + c * 8), b = *(const f32x4*)(ORAW + c * 8 + 4);
        float ss = (a[0] * a[0] + a[1] * a[1]) + (a[2] * a[2] + a[3] * a[3]) + (b[0] * b[0] + b[1] * b[1]) + (b[2] * b[2] + b[3] * b[3]);
        ss += __shfl_xor(ss, 1); ss += __shfl_xor(ss, 2); ss += __shfl_xor(ss, 4); ss += __shfl_xor(ss, 8);
        const float r = rsqrtf(ss * (1.f / 128.f) + EPSF);
        const u32x4 w = *(u32x4*)(HGATE + c * 8);
        u32x4 o; o.x = pk2(a[0] * r * g0[0] * bflo(w.x), a[1] * r * g0[1] * bfhi(w.x)); o.y = pk2(a[2] * r * g0[2] * bflo(w.y), a[3] * r * g0[3] * bfhi(w.y));
        o.z = pk2(b[0] * r * g1[0] * bflo(w.z), b[1] * r * g1[1] * bfhi(w.z)); o.w = pk2(b[2] * r * g1[2] * bflo(w.w), b[3] * r * g1[3] * bfhi(w.w));
        *(u32x4*)(HGATE + c * 8) = o;
    }
}

__device__ __forceinline__ void attn_simple(bf16* AQ, const bf16* __restrict__ AKV, const float* __restrict__ sinks, int gtid, int NT) {
    for (int i = gtid; i < MTOK * ATH; i += NT) {
        const int token = i >> 4, h = i & 15, t = token & (SEQ - 1), kvh = h >> 3;
        float q[64], o[64];
        bf16* qp = AQ + (size_t)token * 1024 + h * 64;
#pragma unroll
        for (int j = 0; j < 8; ++j) { const u32x4 w = *(const u32x4*)(qp + j * 8);
            q[j * 8 + 0] = bflo(w.x); q[j * 8 + 1] = bfhi(w.x); q[j * 8 + 2] = bflo(w.y); q[j * 8 + 3] = bfhi(w.y); q[j * 8 + 4] = bflo(w.z); q[j * 8 + 5] = bfhi(w.z); q[j * 8 + 6] = bflo(w.w); q[j * 8 + 7] = bfhi(w.w); }
#pragma unroll
        for (int d = 0; d < 64; ++d) o[d] = 0.f;
        const float slope = exp2f(-0.5f * (float)(h + 1));
        float mx = sinks[h], l = 1.f;
        const int nk = t < WIN - 1 ? t + 1 : WIN;
        const bf16* kp = AKV + (size_t)(token - nk + 1) * 256 + kvh * 64;
        for (int s = 0; s < nk; ++s, kp += 256) {
            float d0 = 0.f, d1 = 0.f;
#pragma unroll
            for (int j = 0; j < 8; ++j) { const u32x4 w = *(const u32x4*)(kp + j * 8);
                d0 += q[j * 8 + 0] * bflo(w.x) + q[j * 8 + 2] * bflo(w.y) + q[j * 8 + 4] * bflo(w.z) + q[j * 8 + 6] * bflo(w.w);
                d1 += q[j * 8 + 1] * bfhi(w.x) + q[j * 8 + 3] * bfhi(w.y) + q[j * 8 + 5] * bfhi(w.z) + q[j * 8 + 7] * bfhi(w.w); }
            const float sc = (d0 + d1) - slope * (float)(nk - 1 - s);
            if (sc > mx) { const float al = __expf(mx - sc); l *= al;
#pragma unroll
                for (int d = 0; d < 64; ++d) o[d] *= al;
                mx = sc; }
            const float p = __expf(sc - mx); l += p;
#pragma unroll
            for (int j = 0; j < 8; ++j) { const u32x4 w = *(const u32x4*)(kp + 128 + j * 8);
                o[j * 8 + 0] += p * bflo(w.x); o[j * 8 + 1] += p * bfhi(w.x); o[j * 8 + 2] += p * bflo(w.y); o[j * 8 + 3] += p * bfhi(w.y);
                o[j * 8 + 4] += p * bflo(w.z); o[j * 8 + 5] += p * bfhi(w.z); o[j * 8 + 6] += p * bflo(w.w); o[j * 8 + 7] += p * bfhi(w.w); }
        }
        const float inv = 1.f / l;
#pragma unroll
        for (int j = 0; j < 8; ++j) { u32x4 w; w.x = pk2(o[j * 8 + 0] * inv, o[j * 8 + 1] * inv); w.y = pk2(o[j * 8 + 2] * inv, o[j * 8 + 3] * inv); w.z = pk2(o[j * 8 + 4] * inv, o[j * 8 + 5] * inv); w.w = pk2(o[j * 8 + 6] * inv, o[j * 8 + 7] * inv);
            *(u32x4*)(qp + j * 8) = w; }
    }
}

typedef short bf16x8 __attribute__((ext_vector_type(8)));
typedef float f32x2 __attribute__((ext_vector_type(2)));
#define MFMA16(a, b, c) __builtin_amdgcn_mfma_f32_16x16x32_bf16((a), (b), (c), 0, 0, 0)
constexpr int HL_CUM = 0, HL_ABUF = 0, HL_TOT = 32768, HL_REF = 34816, HL_QT = 35840, HL_KST = HL_QT, HL_KT = HL_QT + 17408, HL_QO = HL_KT + 17408,
              HL_VT = HL_QO + 17408, HL_ST = HL_VT + 18432, HL_SS = HL_ST + 34816, HL_END = HL_SS + 512;
static_assert(HL_END <= LDS_BYTES, "HGRN2 LDS map");
struct Prep { float cum[16]; float lf[16]; float ref, last; };
__device__ __forceinline__ void hg_step1(LAS unsigned char* lds, const float* __restrict__ LOGF, const bf16* __restrict__ VI, size_t tok0, int h, int tid, Prep& P) {
    const int k = tid & 127, seg = tid >> 7;
    const float* lp = LOGF + (tok0 + 16 * seg) * 1024 + h * 128 + k;
    const bf16* vp = VI + (tok0 + 16 * seg) * 1024 + h * 128 + k;
    unsigned vv[16];
#pragma unroll
    for (int i = 0; i < 16; ++i) { P.lf[i] = lp[i * 1024]; vv[i] = vp[i * 1024]; }
    float run = 0.f;
#pragma unroll
    for (int i = 0; i < 16; ++i) { run += P.lf[i]; P.cum[i] = run; }
    LAS float* TOT = (LAS float*)(lds + HL_TOT);
    TOT[seg * 128 + k] = run;
    u32x4 w0, w1;
    w0.x = vv[0] | (vv[1] << 16); w0.y = vv[2] | (vv[3] << 16); w0.z = vv[4] | (vv[5] << 16); w0.w = vv[6] | (vv[7] << 16);
    w1.x = vv[8] | (vv[9] << 16); w1.y = vv[10] | (vv[11] << 16); w1.z = vv[12] | (vv[13] << 16); w1.w = vv[14] | (vv[15] << 16);
    *(LAS u32x4*)(lds + HL_VT + (k * 72 + 16 * seg) * 2) = w0; *(LAS u32x4*)(lds + HL_VT + (k * 72 + 16 * seg) * 2 + 16) = w1;
    __syncthreads();
    const float t0 = TOT[k], t1 = TOT[128 + k], t2 = TOT[256 + k], t3 = TOT[384 + k];
    const float off = seg == 0 ? 0.f : seg == 1 ? t0 : seg == 2 ? t0 + t1 : (t0 + t1) + t2;
#pragma unroll
    for (int i = 0; i < 16; ++i) P.cum[i] += off;
    P.ref = t0 + t1; P.last = (t0 + t1) + (t2 + t3);
}
__device__ __forceinline__ void hgrn_a_item(LAS unsigned char* lds, const float* __restrict__ LOGF, const bf16* __restrict__ VI, bf16* __restrict__ UT, float* __restrict__ D, int item, int tid) {
    const int h = item & 7; const size_t tok0 = (size_t)(item >> 3) * 64;
    Prep P; hg_step1(lds, LOGF, VI, tok0, h, tid, P);
    const int k = tid & 127, seg = tid >> 7;
    unsigned pk[8];
#pragma unroll
    for (int i = 0; i < 8; ++i) { const float a = (1.f - __expf(P.lf[2 * i])) * __expf(P.last - P.cum[2 * i]), b = (1.f - __expf(P.lf[2 * i + 1])) * __expf(P.last - P.cum[2 * i + 1]); pk[i] = pk2(a, b); }
    *(LAS u32x4*)(lds + HL_KST + (k * 72 + 16 * seg) * 2) = (u32x4){pk[0], pk[1], pk[2], pk[3]};
    *(LAS u32x4*)(lds + HL_KST + (k * 72 + 16 * seg) * 2 + 16) = (u32x4){pk[4], pk[5], pk[6], pk[7]};
    if (seg == 0) D[(size_t)item * 128 + k] = __expf(P.last);
    __syncthreads();
    const int lane = tid & 63, w = tid >> 6, r = lane & 15, q = lane >> 4;
    bf16x8 af[2];
#pragma unroll
    for (int ks = 0; ks < 2; ++ks) af[ks] = *(const LAS bf16x8*)(lds + HL_KST + ((16 * w + r) * 72 + 32 * ks + 8 * q) * 2);
    bf16* ut = UT + (size_t)item * 16384;
#pragma unroll
    for (int nt = 0; nt < 8; ++nt) { f32x4 acc = {0.f, 0.f, 0.f, 0.f};
#pragma unroll
        for (int ks = 0; ks < 2; ++ks) { const bf16x8 bfr = *(const LAS bf16x8*)(lds + HL_VT + ((16 * nt + r) * 72 + 32 * ks + 8 * q) * 2); acc = MFMA16(af[ks], bfr, acc); }
        u32x2 o; o.x = pk2(acc[0], acc[1]); o.y = pk2(acc[2], acc[3]);
        *(u32x2*)(ut + (16 * nt + r) * 128 + 16 * w + 4 * q) = o; }
    __syncthreads();
}
__device__ __forceinline__ void hgrn_scan(bf16* UT, const float* __restrict__ D, int gtid, int NT) {
    for (int e = gtid; e < 16 * 8192; e += NT) {
        const int bh = e >> 13, off = (e & 8191) * 2, b = bh >> 3, h = bh & 7, k = off & 127;
        unsigned* up = (unsigned*)(UT + ((size_t)(b * 256) * 8 + h) * 16384 + off);
        const float* dp = D + ((size_t)(b * 256) * 8 + h) * 128 + k;
        float s0 = 0.f, s1 = 0.f;
        for (int n = 0; n < 256; n += 8) {
            unsigned u[8]; f32x2 d[8];
#pragma unroll
            for (int j = 0; j < 8; ++j) { u[j] = up[(size_t)(n + j) * 65536]; d[j] = *(const f32x2*)(dp + (size_t)(n + j) * 1024); }
#pragma unroll
            for (int j = 0; j < 8; ++j) { up[(size_t)(n + j) * 65536] = pk2(s0, s1); s0 = d[j].x * s0 + bflo(u[j]); s1 = d[j].y * s1 + bfhi(u[j]); }
        }
    }
}
__device__ __forceinline__ void hgrn_c_item(LAS unsigned char* lds, const bf16* __restrict__ QF, const float* __restrict__ LOGF, const bf16* __restrict__ VI, const bf16* __restrict__ ST,
                                            bf16* HGATE, const float* __restrict__ hn, int item, int tid) {
    const int h = item & 7; const size_t tok0 = (size_t)(item >> 3) * 64;
    Prep P; hg_step1(lds, LOGF, VI, tok0, h, tid, P);
    {
        const int k = tid & 127, seg = tid >> 7;
        LAS float* CUM = (LAS float*)(lds + HL_CUM);
#pragma unroll
        for (int i = 0; i < 16; ++i) CUM[(16 * seg + i) * 128 + k] = P.cum[i];
        if (seg == 0) ((LAS float*)(lds + HL_REF))[k] = P.ref;
        const u32x4* sg = (const u32x4*)(ST + (size_t)item * 16384);
#pragma unroll
        for (int j = 0; j < 4; ++j) { const int idx = tid + 512 * j, v = idx >> 4, c = idx & 15; *(LAS u32x4*)(lds + HL_ST + (v * 136 + c * 8) * 2) = sg[idx]; }
    }
    __syncthreads();
    {
        const int t = tid >> 3, k0 = 16 * (tid & 7); const size_t go = (tok0 + t) * 1024 + h * 128 + k0;
        f32x4 lf[4], cm[4], rf[4]; u32x4 qv[2];
#pragma unroll
        for (int j = 0; j < 4; ++j) { lf[j] = *(const f32x4*)(LOGF + go + 4 * j); cm[j] = *(const LAS f32x4*)(lds + HL_CUM + (t * 128 + k0 + 4 * j) * 4); rf[j] = *(const LAS f32x4*)(lds + HL_REF + (k0 + 4 * j) * 4); }
        qv[0] = *(const u32x4*)(QF + go); qv[1] = *(const u32x4*)(QF + go + 8);
        unsigned pq[8], pkk[8], po[8];
#pragma unroll
        for (int j = 0; j < 8; ++j) {
            const unsigned qw = qv[j >> 2][j & 3]; const float q0 = bflo(qw), q1 = bfhi(qw);
            const int e0 = 2 * j, e1 = 2 * j + 1;
            const float c0 = cm[e0 >> 2][e0 & 3], c1 = cm[e1 >> 2][e1 & 3], r0 = rf[e0 >> 2][e0 & 3], r1 = rf[e1 >> 2][e1 & 3];
            const float kf0 = 1.f - __expf(lf[e0 >> 2][e0 & 3]), kf1 = 1.f - __expf(lf[e1 >> 2][e1 & 3]);
            pq[j] = pk2(q0 * __expf(c0 - r0), q1 * __expf(c1 - r1));
            pkk[j] = pk2(kf0 * __expf(r0 - c0), kf1 * __expf(r1 - c1));
            po[j] = pk2(q0 * __expf(c0), q1 * __expf(c1));
        }
        const int lo = (t * 136 + k0) * 2;
        *(LAS u32x4*)(lds + HL_QT + lo) = (u32x4){pq[0], pq[1], pq[2], pq[3]}; *(LAS u32x4*)(lds + HL_QT + lo + 16) = (u32x4){pq[4], pq[5], pq[6], pq[7]};
        *(LAS u32x4*)(lds + HL_KT + lo) = (u32x4){pkk[0], pkk[1], pkk[2], pkk[3]}; *(LAS u32x4*)(lds + HL_KT + lo + 16) = (u32x4){pkk[4], pkk[5], pkk[6], pkk[7]};
        *(LAS u32x4*)(lds + HL_QO + lo) = (u32x4){po[0], po[1], po[2], po[3]}; *(LAS u32x4*)(lds + HL_QO + lo + 16) = (u32x4){po[4], po[5], po[6], po[7]};
    }
    __syncthreads();
    const int lane = tid & 63, w = tid >> 6, r = lane & 15, q = lane >> 4, nt = w & 3, vh = w >> 2;
    {
#pragma unroll
        for (int mm = 0; mm < 2; ++mm) { const int mt = vh * 2 + mm; f32x4 acc = {0.f, 0.f, 0.f, 0.f};
            if (mt <= nt) {
#pragma unroll
                for (int ks = 0; ks < 4; ++ks) { const bf16x8 a = *(const LAS bf16x8*)(lds + HL_KT + ((16 * mt + r) * 136 + 32 * ks + 8 * q) * 2), b = *(const LAS bf16x8*)(lds + HL_QT + ((16 * nt + r) * 136 + 32 * ks + 8 * q) * 2);
                    acc = MFMA16(a, b, acc); } }
            const int c = 16 * nt + r, s0 = 16 * mt + 4 * q;
            const float a0 = (mt <= nt && s0 + 0 <= c) ? acc[0] : 0.f, a1 = (mt <= nt && s0 + 1 <= c) ? acc[1] : 0.f, a2 = (mt <= nt && s0 + 2 <= c) ? acc[2] : 0.f, a3 = (mt <= nt && s0 + 3 <= c) ? acc[3] : 0.f;
            u32x2 o; o.x = pk2(a0, a1); o.y = pk2(a2, a3);
            *(LAS u32x2*)(lds + HL_ABUF + (c * 72 + s0) * 2) = o; }
    }
    __syncthreads();
    {
        bf16x8 bA[2], bQ[4];
#pragma unroll
        for (int ks = 0; ks < 2; ++ks) bA[ks] = *(const LAS bf16x8*)(lds + HL_ABUF + ((16 * nt + r) * 72 + 32 * ks + 8 * q) * 2);
#pragma unroll
        for (int ks = 0; ks < 4; ++ks) bQ[ks] = *(const LAS bf16x8*)(lds + HL_QO + ((16 * nt + r) * 136 + 32 * ks + 8 * q) * 2);
        f32x4 acc[4]; float ss = 0.f;
#pragma unroll
        for (int j = 0; j < 4; ++j) { const int vt = 4 * vh + j; acc[j] = (f32x4){0.f, 0.f, 0.f, 0.f};
#pragma unroll
            for (int ks = 0; ks < 2; ++ks) { const bf16x8 a = *(const LAS bf16x8*)(lds + HL_VT + ((16 * vt + r) * 72 + 32 * ks + 8 * q) * 2); acc[j] = MFMA16(a, bA[ks], acc[j]); }
#pragma unroll
            for (int ks = 0; ks < 4; ++ks) { const bf16x8 a = *(const LAS bf16x8*)(lds + HL_ST + ((16 * vt + r) * 136 + 32 * ks + 8 * q) * 2); acc[j] = MFMA16(a, bQ[ks], acc[j]); }
            ss += (acc[j][0] * acc[j][0] + acc[j][1] * acc[j][1]) + (acc[j][2] * acc[j][2] + acc[j][3] * acc[j][3]); }
        ss += __shfl_xor(ss, 16); ss += __shfl_xor(ss, 32);
        LAS float* SS = (LAS float*)(lds + HL_SS);
        if (q == 0) SS[vh * 64 + 16 * nt + r] = ss;
        __syncthreads();
        const float rr = rsqrtf((SS[16 * nt + r] + SS[64 + 16 * nt + r]) * (1.f / 128.f) + EPSF);
        bf16* hp = HGATE + (tok0 + 16 * nt + r) * 1024 + h * 128;
#pragma unroll
        for (int j = 0; j < 4; ++j) { const int vb = 16 * (4 * vh + j) + 4 * q; const f32x4 g = *(const f32x4*)(hn + vb); const u32x2 hg = *(const u32x2*)(hp + vb);
            u32x2 o; o.x = pk2(acc[j][0] * rr * g[0] * bflo(hg.x), acc[j][1] * rr * g[1] * bfhi(hg.x)); o.y = pk2(acc[j][2] * rr * g[2] * bflo(hg.y), acc[j][3] * rr * g[3] * bfhi(hg.y));
            *(u32x2*)(hp + vb) = o; }
    }
    __syncthreads();
}

constexpr int AL_K = 0, AL_VT = 208 * 144, AL_END = AL_VT + 64 * 432;
static_assert(AL_END <= LDS_BYTES, "attention LDS map");
__device__ __forceinline__ void attn_item(LAS unsigned char* lds, bf16* AQ, const bf16* __restrict__ AKV, const float* __restrict__ sinks, int item, int tid) {
    const int b = item >> 9, kvh = (item >> 8) & 1, qb = item & 255, t0 = qb * 64;
    const size_t tokb = (size_t)b * SEQ;
#pragma unroll
    for (int j = 0; j < 3; ++j) { const int idx = tid + 512 * j, key = idx >> 3, c = idx & 7, s = t0 - 128 + key; u32x4 v = {0u, 0u, 0u, 0u};
        if (s >= 0) v = *(const u32x4*)(AKV + (tokb + s) * 256 + kvh * 64 + c * 8);
        *(LAS u32x4*)(lds + AL_K + (key * 72 + c * 8) * 2) = v; }
    {
        const int d = tid & 63, kseg = tid >> 6; unsigned vv[24];
#pragma unroll
        for (int i = 0; i < 24; ++i) { const int s = t0 - 128 + 24 * kseg + i; vv[i] = s >= 0 ? (unsigned)AKV[(tokb + s) * 256 + 128 + kvh * 64 + d] : 0u; }
#pragma unroll
        for (int j = 0; j < 3; ++j) { u32x4 w; w.x = vv[8 * j] | (vv[8 * j + 1] << 16); w.y = vv[8 * j + 2] | (vv[8 * j + 3] << 16); w.z = vv[8 * j + 4] | (vv[8 * j + 5] << 16); w.w = vv[8 * j + 6] | (vv[8 * j + 7] << 16);
            *(LAS u32x4*)(lds + AL_VT + (d * 216 + 24 * kseg + 8 * j) * 2) = w; }
        if (kseg == 0) { *(LAS u32x4*)(lds + AL_VT + (d * 216 + 192) * 2) = (u32x4){0u, 0u, 0u, 0u}; *(LAS u32x4*)(lds + AL_VT + (d * 216 + 200) * 2) = (u32x4){0u, 0u, 0u, 0u}; }
    }
    __syncthreads();
    const int lane = tid & 63, w = tid >> 6, r = lane & 15, quad = lane >> 4, h = kvh * 8 + w;
    const float slope = exp2f(-0.5f * (float)(h + 1)), sink = sinks[h];
    bf16* qbase = AQ + (tokb + t0) * 1024 + h * 64;
#pragma unroll 1
    for (int qt = 0; qt < 4; ++qt) {
        bf16x8 qf[2];
#pragma unroll
        for (int ks = 0; ks < 2; ++ks) qf[ks] = *(const bf16x8*)(qbase + (size_t)(16 * qt + r) * 1024 + 32 * ks + 8 * quad);
        f32x4 s[10];
#pragma unroll
        for (int a = 0; a < 10; ++a) { s[a] = (f32x4){0.f, 0.f, 0.f, 0.f};
#pragma unroll
            for (int ks = 0; ks < 2; ++ks) { const bf16x8 kf = *(const LAS bf16x8*)(lds + AL_K + ((16 * (qt + a) + r) * 72 + 32 * ks + 8 * quad) * 2); s[a] = MFMA16(kf, qf[ks], s[a]); } }
        const int iq = 16 * qt + r; float mx = sink;
#pragma unroll
        for (int a = 0; a < 10; ++a)
#pragma unroll
            for (int i = 0; i < 4; ++i) { const int j = 16 * (qt + a) + 4 * quad + i, dist = 128 + iq - j; const bool valid = (unsigned)dist < 128u && (t0 - 128 + j) >= 0;
                const float v = valid ? s[a][i] - slope * (float)dist : -INFINITY; s[a][i] = v; mx = fmaxf(mx, v); }
        mx = fmaxf(mx, __shfl_xor(mx, 16)); mx = fmaxf(mx, __shfl_xor(mx, 32));
        float sum = 0.f;
#pragma unroll
        for (int a = 0; a < 10; ++a)
#pragma unroll
            for (int i = 0; i < 4; ++i) { const float p = __expf(s[a][i] - mx); s[a][i] = p; sum += p; }
        sum += __shfl_xor(sum, 16); sum += __shfl_xor(sum, 32); sum += __expf(sink - mx);
        const float inv = 1.f / sum;
        f32x4 o[4];
#pragma unroll
        for (int dt = 0; dt < 4; ++dt) o[dt] = (f32x4){0.f, 0.f, 0.f, 0.f};
#pragma unroll
        for (int kp = 0; kp < 5; ++kp) {
            const u32x4 pw = {pk2(s[2 * kp][0], s[2 * kp][1]), pk2(s[2 * kp][2], s[2 * kp][3]), pk2(s[2 * kp + 1][0], s[2 * kp + 1][1]), pk2(s[2 * kp + 1][2], s[2 * kp + 1][3])};
            const bf16x8 pb = __builtin_bit_cast(bf16x8, pw);
#pragma unroll
            for (int dt = 0; dt < 4; ++dt) {
                const u32x2 lo = *(const LAS u32x2*)(lds + AL_VT + ((16 * dt + r) * 216 + 16 * (qt + 2 * kp) + 4 * quad) * 2), hi = *(const LAS u32x2*)(lds + AL_VT + ((16 * dt + r) * 216 + 16 * (qt + 2 * kp + 1) + 4 * quad) * 2);
                const u32x4 vw = {lo.x, lo.y, hi.x, hi.y};
                o[dt] = MFMA16(__builtin_bit_cast(bf16x8, vw), pb, o[dt]); }
        }
#pragma unroll
        for (int dt = 0; dt < 4; ++dt) { u32x2 wv; wv.x = pk2(o[dt][0] * inv, o[dt][1] * inv); wv.y = pk2(o[dt][2] * inv, o[dt][3] * inv);
            *(u32x2*)(qbase + (size_t)iq * 1024 + 16 * dt + 4 * quad) = wv; }
    }
    __syncthreads();
}

__device__ __forceinline__ void rowstats_pass(const float* __restrict__ part, float* __restrict__ rs, int gtid, int NT) {
    for (int r = gtid; r < MTOK; r += NT) { const f32x4* p = (const f32x4*)(part + (size_t)r * 32); float s = 0.f;
#pragma unroll
        for (int j = 0; j < 8; ++j) { const f32x4 v = p[j]; s += (v[0] + v[1]) + (v[2] + v[3]); }
        rs[r] = rsqrtf(s * (1.f / DM) + EPSF); }
}

#define XB_TMO      128
#define XB_XCNT(j)  (256  + 64 * (j))
#define XB_XSUB(j)  (1280 + 64 * (j))
#define XB_XGEN(j)  (2304 + 64 * (j))
#define XB_TOP      3328
#define XB_TOPGEN   3392
#define XCD_BAR_WORDS 3456
#define XB_SPIN_CAP (1u << 18)

__device__ __forceinline__ unsigned xb_ld(unsigned* p)              { return __hip_atomic_load(p, __ATOMIC_RELAXED, __HIP_MEMORY_SCOPE_AGENT); }
__device__ __forceinline__ unsigned xb_add(unsigned* p, unsigned v) { return __hip_atomic_fetch_add(p, v, __ATOMIC_RELAXED, __HIP_MEMORY_SCOPE_AGENT); }
__device__ __forceinline__ unsigned xb_xcc_id() { return (unsigned)__builtin_amdgcn_s_getreg((3 << 11) | 20) & 0xFu; }
#define XB_SPIN(cond, bar) do { unsigned _sp = 0; while (cond) { __builtin_amdgcn_s_sleep(1); \
    if ((++_sp & 255u) == 0u) { if (xb_ld(&(bar)[XB_TMO])) break; if (_sp > XB_SPIN_CAP) { atomicAdd(&(bar)[XB_TMO], 1u); break; } } } } while (0)

struct XcdBarrier {
    unsigned* bar; unsigned x;
    volatile LAS unsigned* st;
};

__device__ __forceinline__ XcdBarrier xcd_barrier_post(unsigned* bar, volatile LAS unsigned* st) {
    XcdBarrier b; b.bar = bar; b.x = xb_xcc_id(); b.st = st;
    if (threadIdx.x == 0) (void)xb_add(&bar[XB_XCNT(b.x)], 1u);
    return b;
}
__device__ __forceinline__ void xcd_barrier_complete(unsigned* bar, unsigned x, unsigned& nloc, unsigned& nx) {
    const unsigned G = gridDim.x * gridDim.y * gridDim.z;
    unsigned sum, cnt, mine, sp = 0u;
    for (;;) {
        sum = 0u; cnt = 0u; mine = 0u;
#pragma unroll
        for (unsigned j = 0; j < 16; ++j) { const unsigned c = xb_ld(&bar[XB_XCNT(j)]); sum += c; cnt += (c > 0u) ? 1u : 0u; mine = (j == x) ? c : mine; }
        if (sum == G) break;
        __builtin_amdgcn_s_sleep(1);
        if ((++sp & 255u) == 0u) { if (xb_ld(&bar[XB_TMO])) break; if (sp > XB_SPIN_CAP) { atomicAdd(&bar[XB_TMO], 1u); break; } }
    }
    nloc = mine > 0u ? mine : 1u; nx = cnt > 0u ? cnt : 1u;
}

__device__ __forceinline__ void xcd_barrier(const XcdBarrier& b, bool leader) {
    asm volatile("s_waitcnt vmcnt(0)" ::: "memory");
    __syncthreads();
    if (leader) {
        unsigned* bar = b.bar;
        __builtin_amdgcn_s_waitcnt(0);
        unsigned nloc = b.st[0], nx = b.st[1];
        if (nloc == 0u) { xcd_barrier_complete(bar, b.x, nloc, nx); b.st[0] = nloc; b.st[1] = nx; }
        const unsigned old = xb_add(&bar[XB_XSUB(b.x)], 1u);
        const unsigned gen = old / nloc;
        if (old + 1u == (gen + 1u) * nloc) {
            __builtin_amdgcn_fence(__ATOMIC_RELEASE, "agent");
            asm volatile("s_waitcnt vmcnt(0)" ::: "memory");
            const unsigned og = xb_add(&bar[XB_TOP], 1u);
            const unsigned tg = og / nx;
            if (og + 1u == (tg + 1u) * nx) xb_add(&bar[XB_TOPGEN], 1u);
            else XB_SPIN(xb_ld(&bar[XB_TOPGEN]) == tg, bar);
            __builtin_amdgcn_fence(__ATOMIC_ACQUIRE, "agent");
            xb_add(&bar[XB_XGEN(b.x)], 1u);
            asm volatile("s_waitcnt vmcnt(0)" ::: "memory");
        } else {
            XB_SPIN(xb_ld(&bar[XB_XGEN(b.x)]) == gen, bar);
            __builtin_amdgcn_fence(__ATOMIC_ACQUIRE, "agent");
            asm volatile("s_waitcnt vmcnt(0)" ::: "memory");
        }
    }
    __syncthreads();
}

constexpr int MISC_OFF = LDS_BYTES - 256;
static_assert(MISC_OFF >= 141824 && MISC_OFF >= 131072, "LDS control words above every phase's LDS map");
typedef const Args __attribute__((address_space(4)))* KArgsP;
__device__ __forceinline__ KArgsP kargs() { KArgsP p = (KArgsP)__builtin_amdgcn_kernarg_segment_ptr(); asm volatile("" : "+s"(p)); return p; }
#define ZP(off) (ka->ws + WS_Z + (off))
#define WL(off) ((const bf16*)(ka->ws + WS_W + (size_t)l * W_LAYER + (off)))
__global__ void __launch_bounds__(512, 2) fwd_mega(Args a_unused) {
    extern __shared__ __attribute__((aligned(16))) unsigned char lds_raw[];
    LAS unsigned char* lds = (LAS unsigned char*)lds_raw;
    cg::grid_group grid = cg::this_grid();
    const int G = gridDim.x, bx = blockIdx.x;
    const int wave_s = __builtin_amdgcn_readfirstlane((int)threadIdx.x >> 6);
#define MYTID() ((wave_s << 6) | (int)__builtin_amdgcn_mbcnt_hi(~0u, __builtin_amdgcn_mbcnt_lo(~0u, 0u)))
    if (threadIdx.x < 2) ((volatile LAS unsigned*)(lds + MISC_OFF))[threadIdx.x] = 0u;
    __syncthreads();
    { KArgsP ka = kargs(); (void)xcd_barrier_post((unsigned*)(ka->ws + WS_BAR), (volatile LAS unsigned*)(lds + MISC_OFF)); }
#define GSYNC() do { KArgsP ka_ = kargs(); XcdBarrier b_; b_.bar = (unsigned*)(ka_->ws + WS_BAR); b_.x = xb_xcc_id(); b_.st = (volatile LAS unsigned*)(lds + MISC_OFF); xcd_barrier(b_, MYTID() == 0); } while (0)
#define TIDS int tid_ = MYTID(); asm volatile("" : "+v"(tid_)); const int tid = tid_, lane = tid & 63, wave = __builtin_amdgcn_readfirstlane(tid >> 6), gw = bx * 8 + wave, NGW = G * 8, gtid = bx * 512 + tid, NT = G * 512; (void)lane; (void)gw; (void)NGW; (void)gtid; (void)NT;

#if REP_P0 > 1
    int np0 = REP_P0; asm volatile("" : "+s"(np0));
#pragma unroll 1
    for (int rep0 = 0; rep0 < np0; ++rep0)
#endif
    {
        KArgsP ka = kargs(); TIDS
        unsigned char* ws = ka->ws; float* RS = (float*)(ws + WS_RS); float* LB = (float*)(ws + WS_LB); bf16* XB = (bf16*)(ws + WS_XB);
        LAS float* scr = (LAS float*)(lds + wave * 16384);
        constexpr int I_IN = (DM / 64) * (DIN / 32), I_HG = (HGW / 64) * (DM / 32), I_AT = (ATW / 64) * (DM / 32), I_OUT = (DM / 64) * (DM / 32), I_UP = (DM / 64) * (DFF / 32), I_DN = (DFF / 64) * (DM / 32);
        constexpr int I_LAYER = I_IN + I_HG + I_AT + I_OUT + I_UP + I_DN;
        for (int it = gw; it < 2 * I_LAYER; it += NGW) {
            const int l = it >= I_LAYER ? 1 : 0; int r = it - l * I_LAYER; unsigned char* wl = ws + WS_W + (size_t)l * W_LAYER;
            if (r < I_IN) { transpose_item(ka->w_in + (size_t)l * DM * DIN, ka->norm_mix + l * DM, DM, DIN, (bf16*)(wl + W_IN), scr, r, lane); continue; } r -= I_IN;
            if (r < I_HG) { transpose_item(ka->w_hg_out + (size_t)l * HGW * DM, nullptr, HGW, DM, (bf16*)(wl + W_HG), scr, r, lane); continue; } r -= I_HG;
            if (r < I_AT) { transpose_item(ka->w_at_out + (size_t)l * ATW * DM, nullptr, ATW, DM, (bf16*)(wl + W_AT), scr, r, lane); continue; } r -= I_AT;
            if (r < I_OUT) { transpose_item(ka->w_out + (size_t)l * DM * DM, nullptr, DM, DM, (bf16*)(wl + W_OUT), scr, r, lane); continue; } r -= I_OUT;
            if (r < I_UP) { transpose_item(ka->w_up + (size_t)l * DM * DFF, ka->norm_ffn + l * DM, DM, DFF, (bf16*)(wl + W_UP), scr, r, lane); continue; } r -= I_UP;
            transpose_item(ka->w_down + (size_t)l * DFF * DM, nullptr, DFF, DM, (bf16*)(wl + W_DN), scr, r, lane);
        }
        for (int c = gtid; c < 1024; c += NT) { LB[c] = 0.f; LB[1024 + c] = sigm(ka->lb_logits[1024 + c] - ka->lb_logits[c]); }
        const float* x = ka->x;
        for (int m = gw; m < MTOK; m += NGW) {
            const f32x4* xr = (const f32x4*)(x + (size_t)m * DM) + lane; f32x4 v[8]; float s = 0.f;
#pragma unroll
            for (int j = 0; j < 8; ++j) { v[j] = xr[64 * j]; s += (v[j][0] * v[j][0] + v[j][1] * v[j][1]) + (v[j][2] * v[j][2] + v[j][3] * v[j][3]); }
            s = wave_sum(s);
            if (lane == 0) RS[m] = rsqrtf(s * (1.f / DM) + EPSF);
            u32x2* o8 = (u32x2*)(XB + (size_t)m * DM) + lane;
#pragma unroll
            for (int j = 0; j < 8; ++j) { u32x2 w; w.x = pk2(v[j][0], v[j][1]); w.y = pk2(v[j][2], v[j][3]); o8[64 * j] = w; }
        }
    }
    grid.sync();

    for (int l = 0; l < 2; ++l) {
        if (ON(1)) {
            KArgsP ka = kargs();
            pg8::Gemm g{(const bf16*)(ka->ws + WS_XB), WL(W_IN), MTOK, DIN, DM}; pg8::StaticOrder S; S.init(MTOK, DIN, G, bx, REP_G1);
            pg8::EpiIn E{(const float*)(ka->ws + WS_RS), (const float*)(ka->ws + WS_LB) + l * 1024, ka->ws + WS_Z};
            pg8::gemm_phase<pg8::EpiIn, pg8::StaticOrder, true, true>(lds, g, S, E, MYTID());
        }
        GSYNC();
#if XSYNC > 0
        { int nx = XSYNC; asm volatile("" : "+s"(nx));
#pragma unroll 1
          for (int i = 0; i < nx; ++i) GSYNC(); }
#endif
        {
            KArgsP ka = kargs(); TIDS
#if REP_HA > 1
            int nha = REP_HA; asm volatile("" : "+s"(nha));
#pragma unroll 1
            for (int rha = 0; rha < nha; ++rha)
#endif
            if (ON(2)) for (int item = bx; item < 4096; item += G) hgrn_a_item(lds, (const float*)ZP(Z_LOGF), (const bf16*)ZP(Z_VI), (bf16*)(ka->ws + WS_XB), (float*)(ka->ws + WS_PART), item, tid);
            if (ON(3)) qk_norm_pass((bf16*)ZP(Z_AQ), (bf16*)ZP(Z_AKV), ka->q_norm + l * 64, ka->k_norm + l * 64, gtid, NT);
        }
        GSYNC();
        {
            KArgsP ka = kargs(); TIDS
            if (ON(2)) hgrn_scan((bf16*)(ka->ws + WS_XB), (const float*)(ka->ws + WS_PART), gtid, NT);
            if (ON(5)) for (int item = bx; item < 1024; item += G) attn_item(lds, (bf16*)ZP(Z_AQ), (const bf16*)ZP(Z_AKV), ka->sinks + l * 16, item, tid);
        }
        GSYNC();
        {
            KArgsP ka = kargs(); TIDS
            if (ON(4)) for (int item = bx; item < 4096; item += G) hgrn_c_item(lds, (const bf16*)ZP(Z_QF), (const float*)ZP(Z_LOGF), (const bf16*)ZP(Z_VI), (const bf16*)(ka->ws + WS_XB), (bf16*)ZP(Z_HGATE), ka->hg_norm + l * 128, item, tid);
        }
        GSYNC();
        if (ON(6)) {
            KArgsP ka = kargs();
            pg8::Gemm g{(const bf16*)ZP(Z_HGATE), WL(W_HG), MTOK, DM, HGW}; pg8::StaticOrder S; S.init(MTOK, DM, G, bx, REP_G23);
            pg8::EpiGate<0> E{(const bf16*)ZP(Z_GH), nullptr, (bf16*)ZP(Z_T1)};
            pg8::gemm_phase<pg8::EpiGate<0>, pg8::StaticOrder, true, true>(lds, g, S, E, MYTID());
        }
        if (ON(7)) {
            KArgsP ka = kargs();
            pg8::Gemm g{(const bf16*)ZP(Z_AQ), WL(W_AT), MTOK, DM, ATW}; pg8::StaticOrder S; S.init(MTOK, DM, G, bx, REP_G23);
            pg8::EpiGate<1> E{(const bf16*)ZP(Z_GA), (const bf16*)ZP(Z_T1), (bf16*)ZP(Z_MIX)};
            pg8::gemm_phase<pg8::EpiGate<1>, pg8::StaticOrder, true, true>(lds, g, S, E, MYTID());
        }
        GSYNC();
        if (ON(8)) {
            KArgsP ka = kargs();
            pg8::Gemm g{(const bf16*)ZP(Z_MIX), WL(W_OUT), MTOK, DM, DM}; pg8::StaticOrder S; S.init(MTOK, DM, G, bx);
            pg8::EpiRes E{l == 0 ? ka->x : (const float*)ka->out, ka->out, (bf16*)(ka->ws + WS_XB), (float*)(ka->ws + WS_PART)};
            pg8::gemm_phase<pg8::EpiRes, pg8::StaticOrder, true, true>(lds, g, S, E, MYTID());
        }
        GSYNC();
        { KArgsP ka = kargs(); TIDS rowstats_pass((const float*)(ka->ws + WS_PART), (float*)(ka->ws + WS_RS), gtid, NT); }
        GSYNC();
        if (ON(9)) {
            KArgsP ka = kargs();
            pg8::Gemm g{(const bf16*)(ka->ws + WS_XB), WL(W_UP), MTOK, DFF, DM}; pg8::StaticOrder S; S.init(MTOK, DFF, G, bx, REP_G5);
            pg8::EpiUp E{(const float*)(ka->ws + WS_RS), (bf16*)ZP(Z_U)};
            pg8::gemm_phase<pg8::EpiUp, pg8::StaticOrder, true, true>(lds, g, S, E, MYTID());
        }
        GSYNC();
        if (ON(10)) {
            KArgsP ka = kargs();
            pg8::Gemm g{(const bf16*)ZP(Z_U), WL(W_DN), MTOK, DM, DFF}; pg8::StaticOrder S; S.init(MTOK, DM, G, bx);
            pg8::EpiRes E{ka->out, ka->out, l == 0 ? (bf16*)(ka->ws + WS_XB) : nullptr, (float*)(ka->ws + WS_PART)};
            pg8::gemm_phase<pg8::EpiRes, pg8::StaticOrder, true, true>(lds, g, S, E, MYTID());
        }
        if (l == 0) { GSYNC(); { KArgsP ka = kargs(); TIDS rowstats_pass((const float*)(ka->ws + WS_PART), (float*)(ka->ws + WS_RS), gtid, NT); } GSYNC(); }
    }
}

extern "C" void kernel_launch(void* const* d_in, const int* in_sizes, int n_in, void* d_out, int out_size, void* d_ws, size_t ws_size, hipStream_t stream) {
    static int grid = 0;
    if (grid == 0) {
        if (n_in != 14 || out_size != MTOK * DM || ws_size < WS_END) { fprintf(stderr, "kernel_launch: unexpected shapes (n_in %d out %d ws %zu need %zu)\n", n_in, out_size, ws_size, (size_t)WS_END); grid = -1; return; }
        int dev = 0, cus = 0, per_cu = 0;
        (void)hipGetDevice(&dev); (void)hipDeviceGetAttribute(&cus, hipDeviceAttributeMultiprocessorCount, dev);
        if (hipFuncSetAttribute((const void*)fwd_mega, hipFuncAttributeMaxDynamicSharedMemorySize, LDS_BYTES) != hipSuccess) { fprintf(stderr, "hipFuncSetAttribute failed\n"); grid = -1; return; }
        if (hipOccupancyMaxActiveBlocksPerMultiprocessor(&per_cu, (const void*)fwd_mega, 512, LDS_BYTES) != hipSuccess || per_cu < 1) { fprintf(stderr, "occupancy query: %d\n", per_cu); per_cu = 1; }
        (void)hipGetLastError();
        grid = cus * 1;
    }
    if (grid < 0) return;
    (void)hipMemsetAsync((unsigned char*)d_ws + WS_BAR, 0, 16384, stream);
    Args a{};
    a.x = (const float*)d_in[0]; a.norm_mix = (const float*)d_in[1]; a.w_in = (const float*)d_in[2]; a.lb_logits = (const float*)d_in[3]; a.hg_norm = (const float*)d_in[4];
    a.q_norm = (const float*)d_in[5]; a.k_norm = (const float*)d_in[6]; a.sinks = (const float*)d_in[7]; a.w_hg_out = (const float*)d_in[8]; a.w_at_out = (const float*)d_in[9];
    a.w_out = (const float*)d_in[10]; a.norm_ffn = (const float*)d_in[11]; a.w_up = (const float*)d_in[12]; a.w_down = (const float*)d_in[13];
    a.out = (float*)d_out; a.ws = (unsigned char*)d_ws;
    void* args[] = {&a};
    hipError_t e = hipLaunchCooperativeKernel((const void*)fwd_mega, dim3(grid), dim3(512), args, LDS_BYTES, stream);
    if (e != hipSuccess) fprintf(stderr, "cooperative launch failed: %s (grid %d)\n", hipGetErrorString(e), grid);
}
```

```cpp
#include <hip/hip_runtime.h>
#include <hip/hip_cooperative_groups.h>
#include <cstdio>
#include <cstdint>
namespace cg = cooperative_groups;
namespace pg8 {
#define PG8_LAS __attribute__((address_space(3)))
typedef unsigned short bf16_t;
typedef short bf16x8 __attribute__((ext_vector_type(8)));
typedef float f32x4 __attribute__((ext_vector_type(4)));
typedef unsigned u32x4 __attribute__((ext_vector_type(4)));
constexpr int BM = 256, BK = 64, HALF = 128, HTB = HALF * BK * 2  , STAGE_BYTES = 8 * HTB, NXCD = 8, WGM = 8;

__host__ __device__ __forceinline__ int lds_byte(int r, int c) { const int st = (r >> 4) * 2 + (c >> 5), rr = r & 15, cc = c & 31, ob = rr * 64 + cc * 2; return st * 1024 + (ob ^ (((ob >> 9) & 1) << 5)); }
__host__ __device__ __forceinline__ void stage_rc(int b, int& R, int& C) { const int st = b / 1024, sb = b % 1024, swz = sb ^ (((sb >> 9) & 1) << 5); R = (st >> 1) * 16 + swz / 64; C = (st & 1) * 32 + (swz % 64) / 2; }
__host__ __device__ __forceinline__ int perm32(int rho) { const int n = rho >> 4, i = rho & 15; return 8 * (i >> 2) + 4 * n + (i & 3); }

struct Unit { int pm, pn, pass; };
struct Gemm { const bf16_t* A; const bf16_t* Bt; int M, N, K; };

struct StaticOrder {
    int nM, nN, nwg, G, c, rep;
    __host__ __device__ void init(int M, int N, int G_, int c_, int rep_ = 1) { nM = M / BM; nN = N / BM; nwg = nM * nN; G = G_; c = c_; rep = rep_; }
    __host__ __device__ bool next(int i, Unit& u) const {
        int L = i * G + c; if (L >= nwg * rep) return false; u.pass = 0; if (L >= nwg) { L -= nwg; u.pass = 1; }
        int wgid = (int)L; { const int q = nwg / NXCD, r = nwg % NXCD, xcd = wgid % NXCD, off = wgid / NXCD; wgid = (xcd < r ? xcd * (q + 1) : r * (q + 1) + (xcd - r) * q) + off; }
        const int nig = WGM * nN, gid = wgid / nig, fm = gid * WGM, gsz = (nM - fm) < WGM ? (nM - fm) : WGM;
        u.pm = fm + ((wgid % nig) % gsz); u.pn = (wgid % nig) / gsz; return true;
    }
    __device__ __forceinline__ void a_ready(const Unit&) const {}
    __device__ __forceinline__ void done(const Unit&) const {}
};
__device__ __forceinline__ unsigned cvt_pk_bf16(float lo, float hi) { unsigned r; asm volatile("v_cvt_pk_bf16_f32 %0, %1, %2" : "=v"(r) : "v"(lo), "v"(hi)); return r; }
typedef float f32x2 __attribute__((ext_vector_type(2)));
template <class Epi, class Sched, bool ALIGN_EPI = false, bool SP2 = false>
__device__ __forceinline__ void gemm_phase(PG8_LAS unsigned char* lds, const Gemm g, const Sched& S, const Epi& E, int tid_in) {
    int tid_ = tid_in; asm volatile("" : "+v"(tid_));
    const int tid = tid_, wid = __builtin_amdgcn_readfirstlane(tid >> 6), lane = tid & 63, wr = wid >> 2, wc = wid & 3, fr = lane & 15, fq = lane >> 4;
    const int K = g.K, nt = K / BK;
    unsigned voffA[2], voffB[2];
#pragma unroll
    for (int i = 0; i < 2; ++i) { int R, C; stage_rc(tid * 16 + i * 8192, R, C); const int Rb = Epi::PERM ? ((R & ~31) + perm32(R & 31)) : R;
        voffA[i] = (unsigned)(R * K + C) * 2u; voffB[i] = (unsigned)(Rb * K + C) * 2u; }
    const size_t kstep = (size_t)(BK * 2);
    const size_t hstep = (size_t)HALF * K * 2;
    const size_t tstep = 2 * hstep;
    const unsigned ldsw = (unsigned)wid * 1024u;
    const int aoff = lds_byte(wr * 64 + fr, fq * 8), boff = lds_byte(wc * 32 + fr, fq * 8);
#define PG8_SA(b, h) (((b) * 2 + (h)) * HTB)
#define PG8_SB(b, h) ((4 + (b) * 2 + (h)) * HTB)
#define PG8_STAGE(bufoff, gbase, voff) do { _Pragma("unroll") for (int _i = 0; _i < 2; ++_i) \
        __builtin_amdgcn_global_load_lds((const unsigned*)((const char*)(gbase) + (voff)[_i]), (PG8_LAS unsigned*)(lds + (bufoff) + ldsw + _i * 8192), 16, 0, 0); } while (0)
#define PG8_LDA(dst, b, h) do { _Pragma("unroll") for (int m = 0; m < 4; ++m) _Pragma("unroll") for (int k = 0; k < 2; ++k) dst[m][k] = *(const PG8_LAS bf16x8*)(lds + PG8_SA(b, h) + aoff + m * 2048 + k * 1024); } while (0)
#define PG8_LDB(dst, b, h) do { _Pragma("unroll") for (int n = 0; n < 2; ++n) _Pragma("unroll") for (int k = 0; k < 2; ++k) dst[n][k] = *(const PG8_LAS bf16x8*)(lds + PG8_SB(b, h) + boff + n * 2048 + k * 1024); } while (0)
#define PG8_MMA(ai, bj, At, Bt) do { __builtin_amdgcn_s_setprio(1); _Pragma("unroll") for (int m = 0; m < 4; ++m) _Pragma("unroll") for (int n = 0; n < 2; ++n) _Pragma("unroll") for (int k = 0; k < 2; ++k) \
        acc[ai][bj][m][n] = __builtin_amdgcn_mfma_f32_16x16x32_bf16(Bt[n][k], At[m][k], acc[ai][bj][m][n], 0, 0, 0); __builtin_amdgcn_s_setprio(0); } while (0)
#define PG8_WAIT_V(n) asm volatile("s_waitcnt vmcnt(" #n ")" ::: "memory")
#define PG8_WAIT_L(n) asm volatile("s_waitcnt lgkmcnt(" #n ")" ::: "memory")
#define PG8_BAR __builtin_amdgcn_s_barrier()
#define PG8_SCHED __builtin_amdgcn_sched_barrier(0)
    Unit cur, nxt; int ui = 0;
    if (!S.next(0, cur)) return;
    f32x4 acc[2][2][4][2];
#pragma unroll
    for (int a = 0; a < 2; ++a)
#pragma unroll
        for (int b = 0; b < 2; ++b)
#pragma unroll
            for (int m = 0; m < 4; ++m)
#pragma unroll
                for (int n = 0; n < 2; ++n) acc[a][b][m][n] = (f32x4){0.f, 0.f, 0.f, 0.f};
    bf16x8 At[4][2], B0[2][2], B1[2][2];
    const char* cA = (const char*)g.A + (size_t)cur.pm * tstep; const char* cB = (const char*)g.Bt + (size_t)cur.pn * tstep;
    S.a_ready(cur);
    if constexpr (SP2) {
        PG8_STAGE(PG8_SB(0, 0), cB, voffB); PG8_STAGE(PG8_SB(0, 1), cB + hstep, voffB); PG8_STAGE(PG8_SA(0, 0), cA, voffA); PG8_STAGE(PG8_SA(0, 1), cA + hstep, voffA);
        if (wr == 1) PG8_BAR;
        PG8_WAIT_V(2); PG8_BAR;
        PG8_STAGE(PG8_SB(1, 0), cB + kstep, voffB); PG8_STAGE(PG8_SA(1, 0), cA + kstep, voffA); PG8_STAGE(PG8_SB(1, 1), cB + hstep + kstep, voffB);
        PG8_WAIT_V(6); PG8_BAR;
    } else {
        PG8_STAGE(PG8_SB(0, 0), cB, voffB); PG8_STAGE(PG8_SA(0, 0), cA, voffA); PG8_STAGE(PG8_SB(0, 1), cB + hstep, voffB); PG8_STAGE(PG8_SA(0, 1), cA + hstep, voffA);
        if (wr == 1) PG8_BAR;
        PG8_WAIT_V(4); PG8_BAR;
        PG8_STAGE(PG8_SB(1, 0), cB + kstep, voffB); PG8_STAGE(PG8_SA(1, 0), cA + kstep, voffA); PG8_STAGE(PG8_SB(1, 1), cB + hstep + kstep, voffB);
        PG8_WAIT_V(6); PG8_BAR;
    }
    for (;;) {
        const bool has_next = S.next(ui + 1, nxt);
        const char* nA = has_next ? (const char*)g.A + (size_t)nxt.pm * tstep : cA; const char* nB = has_next ? (const char*)g.Bt + (size_t)nxt.pn * tstep : cB;
        for (int t = 0; t < nt; t += 2) {
            const bool last = (t == nt - 2);
            const char* a1 = cA + (size_t)(t + 1) * kstep;
            const char* a2 = last ? nA : cA + (size_t)(t + 2) * kstep; const char* b2 = last ? nB : cB + (size_t)(t + 2) * kstep;
            const char* a3 = a2 + kstep; const char* b3 = b2 + kstep;
            if (last && has_next) S.a_ready(nxt);
            if constexpr (SP2) {
            PG8_LDB(B0, 0, 0); PG8_LDB(B1, 0, 1); PG8_SCHED; PG8_LDA(At, 0, 0); PG8_STAGE(PG8_SA(1, 1), a1 + hstep, voffA);
            PG8_WAIT_V(8); PG8_WAIT_L(0); PG8_BAR; PG8_MMA(0, 0, At, B0); PG8_MMA(0, 1, At, B1); PG8_BAR; PG8_SCHED;
            PG8_LDA(At, 0, 1); PG8_STAGE(PG8_SB(0, 0), b2, voffB); PG8_STAGE(PG8_SB(0, 1), b2 + hstep, voffB); PG8_STAGE(PG8_SA(0, 0), a2, voffA);
            PG8_WAIT_V(8); PG8_WAIT_L(0); PG8_BAR; PG8_MMA(1, 0, At, B0); PG8_MMA(1, 1, At, B1); PG8_BAR; PG8_SCHED;
            PG8_LDB(B0, 1, 0); PG8_LDB(B1, 1, 1); PG8_SCHED; PG8_LDA(At, 1, 0); PG8_STAGE(PG8_SA(0, 1), a2 + hstep, voffA);
            PG8_WAIT_V(8); PG8_WAIT_L(0); PG8_BAR; PG8_MMA(0, 0, At, B0); PG8_MMA(0, 1, At, B1); PG8_BAR; PG8_SCHED;
            PG8_LDA(At, 1, 1); PG8_STAGE(PG8_SB(1, 0), b3, voffB); PG8_STAGE(PG8_SB(1, 1), b3 + hstep, voffB); PG8_STAGE(PG8_SA(1, 0), a3, voffA);
            PG8_WAIT_V(8); PG8_WAIT_L(0); PG8_BAR; PG8_MMA(1, 0, At, B0); PG8_MMA(1, 1, At, B1); PG8_BAR; PG8_SCHED;
            } else {
            PG8_LDB(B0, 0, 0); PG8_SCHED; PG8_LDA(At, 0, 0); PG8_STAGE(PG8_SA(1, 1), a1 + hstep, voffA);
            PG8_WAIT_L(8); PG8_BAR; PG8_WAIT_L(0); PG8_MMA(0, 0, At, B0); PG8_BAR; PG8_SCHED;
            PG8_LDB(B1, 0, 1); PG8_STAGE(PG8_SB(0, 0), b2, voffB);
            PG8_BAR; PG8_WAIT_L(0); PG8_MMA(0, 1, At, B1); PG8_BAR;
            PG8_LDA(At, 0, 1); PG8_STAGE(PG8_SA(0, 0), a2, voffA);
            PG8_BAR; PG8_WAIT_L(0); PG8_MMA(1, 0, At, B0); PG8_BAR; PG8_SCHED;
            PG8_STAGE(PG8_SB(0, 1), b2 + hstep, voffB);
            PG8_WAIT_V(6); PG8_BAR; PG8_MMA(1, 1, At, B1); PG8_BAR;
            PG8_LDB(B0, 1, 0); PG8_SCHED; PG8_LDA(At, 1, 0); PG8_STAGE(PG8_SA(0, 1), a2 + hstep, voffA);
            PG8_WAIT_L(8); PG8_BAR; PG8_WAIT_L(0); PG8_MMA(0, 0, At, B0); PG8_BAR; PG8_SCHED;
            PG8_LDB(B1, 1, 1); PG8_STAGE(PG8_SB(1, 0), b3, voffB);
            PG8_BAR; PG8_WAIT_L(0); PG8_MMA(0, 1, At, B1); PG8_BAR;
            PG8_LDA(At, 1, 1); PG8_STAGE(PG8_SA(1, 0), a3, voffA);
            PG8_BAR; PG8_WAIT_L(0); PG8_MMA(1, 0, At, B0); PG8_BAR; PG8_SCHED;
            PG8_STAGE(PG8_SB(1, 1), b3 + hstep, voffB);
            PG8_WAIT_V(6); PG8_BAR; PG8_MMA(1, 1, At, B1); PG8_BAR;
            }
        }
        if constexpr (ALIGN_EPI) { if (wr == 0) PG8_BAR; }
        if constexpr (!Epi::AFTER_DRAIN) { E(acc, cur, wr, wc, fr, fq); S.done(cur); }
        if (!has_next) break;
#pragma unroll
        for (int a = 0; a < 2; ++a)
#pragma unroll
            for (int b = 0; b < 2; ++b)
#pragma unroll
                for (int m = 0; m < 4; ++m)
#pragma unroll
                    for (int n = 0; n < 2; ++n) acc[a][b][m][n] = (f32x4){0.f, 0.f, 0.f, 0.f};
        cur = nxt; cA = nA; cB = nB; ++ui;
        if constexpr (ALIGN_EPI) { if (wr == 1) PG8_BAR; }
    }
    PG8_WAIT_V(0);
    if constexpr (!ALIGN_EPI) { if (wr == 0) PG8_BAR; }
    PG8_BAR;
    if constexpr (Epi::AFTER_DRAIN) { E.fused(acc, cur, wr, wc, fr, fq, lds, wid, lane); S.done(cur); }
#undef PG8_SA
#undef PG8_SB
#undef PG8_STAGE
#undef PG8_LDA
#undef PG8_LDB
#undef PG8_MMA
#undef PG8_WAIT_V
#undef PG8_WAIT_L
#undef PG8_BAR
#undef PG8_SCHED
}
}

constexpr int BATCH = 2, SEQ = 16384, DM = 2048, MTOK = BATCH * SEQ;
constexpr int HGH = 8, HGD = 128, HGW = 1024;
constexpr int ATH = 16, ATD = 64, ATW = 1024, WIN = 128;
constexpr int DIN = 9472, DFF = 8192;
constexpr float EPSF = 1e-6f;

#define LAS __attribute__((address_space(3)))
typedef unsigned short bf16;
typedef float f32x4 __attribute__((ext_vector_type(4)));
typedef unsigned u32x4 __attribute__((ext_vector_type(4)));
typedef unsigned u32x2 __attribute__((ext_vector_type(2)));

__device__ __forceinline__ float sigm(float x) { return __builtin_amdgcn_rcpf(1.f + __expf(-x)); }
__device__ __forceinline__ float bflo(unsigned w) { return __uint_as_float(w << 16); }
__device__ __forceinline__ float bfhi(unsigned w) { return __uint_as_float(w & 0xffff0000u); }
typedef __bf16 bf16x2_t __attribute__((ext_vector_type(2)));
typedef float f32x2_t __attribute__((ext_vector_type(2)));
__device__ __forceinline__ unsigned pk2(float lo, float hi) { const f32x2_t v = {lo, hi}; const bf16x2_t b = __builtin_convertvector(v, bf16x2_t); return __builtin_bit_cast(unsigned, b); }

constexpr size_t WS_RS = 0;
constexpr size_t WS_LB = 131072;
constexpr size_t WS_BAR = 196608;
constexpr size_t WS_PART = 262144;
constexpr size_t WS_W = WS_PART + (size_t)MTOK * 32 * 4;
constexpr size_t W_IN = 0, W_HG = W_IN + (size_t)DIN * DM * 2, W_AT = W_HG + (size_t)DM * HGW * 2, W_OUT = W_AT + (size_t)DM * ATW * 2,
                 W_UP = W_OUT + (size_t)DM * DM * 2, W_DN = W_UP + (size_t)DFF * DM * 2, W_LAYER = W_DN + (size_t)DM * DFF * 2;
constexpr size_t WS_XB = WS_W + 2 * W_LAYER;
constexpr size_t WS_Z = WS_XB + (size_t)MTOK * DM * 2;
constexpr size_t Z_QF = 0, Z_LOGF = Z_QF + (size_t)MTOK * 1024 * 2, Z_VI = Z_LOGF + (size_t)MTOK * 1024 * 4, Z_HGATE = Z_VI + (size_t)MTOK * 1024 * 2,
                 Z_AQ = Z_HGATE + (size_t)MTOK * 1024 * 2, Z_AKV = Z_AQ + (size_t)MTOK * 1024 * 2, Z_GH = Z_AKV + (size_t)MTOK * 256 * 2,
                 Z_GA = Z_GH + (size_t)MTOK * 2048 * 2, Z_END = Z_GA + (size_t)MTOK * 2048 * 2;
constexpr size_t Z_T1 = 0, Z_MIX = (size_t)MTOK * 2048 * 2;
constexpr size_t Z_U = 0;
constexpr size_t WS_END = WS_Z + Z_END;
static_assert(Z_MIX + (size_t)MTOK * 2048 * 2 <= Z_HGATE, "T1|MIX overlay");
static_assert((size_t)MTOK * DFF * 2 <= Z_END, "U overlay");
static_assert(WS_END <= 1073741824ull, "workspace");

constexpr int LDS_BYTES = 147456;
#ifndef PH
#define PH 0xFFFF
#endif
#define ON(k) ((PH >> (k)) & 1)
#ifndef REP_G1
#define REP_G1 1
#endif
#ifndef REP_G5
#define REP_G5 1
#endif
#ifndef REP_G23
#define REP_G23 1
#endif
#ifndef PG_ALIGN
#define PG_ALIGN true
#endif
#ifndef PG_SP2
#define PG_SP2 true
#endif
#ifndef REP_G46
#define REP_G46 1
#endif
#ifndef REP_MIX
#define REP_MIX 0
#endif
#ifndef REP_P0
#define REP_P0 1
#endif
#ifndef XSYNC
#define XSYNC 0
#endif
#ifndef REP_HA
#define REP_HA 1
#endif

namespace pg8 {
struct EpiIn {
    static constexpr bool PERM = true, AFTER_DRAIN = false;
    const float* rs; const float* lb; unsigned char* Z;
    __device__ __forceinline__ void operator()(const f32x4 (&acc)[2][2][4][2], const Unit& u, int wr, int wc, int fr, int fq) const {
        const int pn = u.pn; int kind, ld, tb; size_t zo;
        if (pn < 4)       { kind = 0; zo = Z_QF;    ld = 1024; tb = pn * 256; }
        else if (pn < 8)  { kind = 1; zo = Z_LOGF;  ld = 1024; tb = (pn - 4) * 256; }
        else if (pn < 12) { kind = 2; zo = Z_VI;    ld = 1024; tb = (pn - 8) * 256; }
        else if (pn < 16) { kind = 0; zo = Z_HGATE; ld = 1024; tb = (pn - 12) * 256; }
        else if (pn < 20) { kind = 2; zo = Z_AQ;    ld = 1024; tb = (pn - 16) * 256; }
        else if (pn == 20){ kind = 2; zo = Z_AKV;   ld = 256;  tb = 0; }
        else if (pn < 29) { kind = 3; zo = Z_GH;    ld = 2048; tb = (pn - 21) * 256; }
        else              { kind = 3; zo = Z_GA;    ld = 2048; tb = (pn - 29) * 256; }
        const int row0 = u.pm * BM + wr * 64 + fr, col0 = tb + wc * 32 + 8 * fq;
        if (kind == 1) {
            float* LOGF = (float*)(Z + zo);
            f32x4 lbv[2][2];
#pragma unroll
            for (int bj = 0; bj < 2; ++bj)
#pragma unroll
                for (int n = 0; n < 2; ++n) lbv[bj][n] = *(const f32x4*)(lb + col0 + bj * HALF + 4 * n);
#pragma unroll
            for (int ai = 0; ai < 2; ++ai)
#pragma unroll
                for (int m = 0; m < 4; ++m) { const int row = row0 + ai * HALF + m * 16; const float s = rs[row]; float* rp = LOGF + (size_t)row * 1024 + col0;
#pragma unroll
                    for (int bj = 0; bj < 2; ++bj)
#pragma unroll
                        for (int n = 0; n < 2; ++n) { const f32x4 v = acc[ai][bj][m][n] * s; f32x4 o;
#pragma unroll
                            for (int e = 0; e < 4; ++e) { const float l = lbv[bj][n][e]; o[e] = __logf(l + (1.f - l) * sigm(v[e])); }
                            *(f32x4*)(rp + bj * HALF + 4 * n) = o; } }
        } else {
            bf16_t* dst = (bf16_t*)(Z + zo);
#pragma unroll
            for (int ai = 0; ai < 2; ++ai)
#pragma unroll
                for (int m = 0; m < 4; ++m) { const int row = row0 + ai * HALF + m * 16; const float s = rs[row]; bf16_t* rp = dst + (size_t)row * ld + col0;
#pragma unroll
                    for (int bj = 0; bj < 2; ++bj) { f32x4 v0 = acc[ai][bj][m][0] * s, v1 = acc[ai][bj][m][1] * s;
                        if (kind == 0) {
#pragma unroll
                            for (int e = 0; e < 4; ++e) { v0[e] = v0[e] * sigm(v0[e]); v1[e] = v1[e] * sigm(v1[e]); }
                        } else if (kind == 3) {
#pragma unroll
                            for (int e = 0; e < 4; ++e) { v0[e] = sigm(v0[e]); v1[e] = sigm(v1[e]); }
                        }
                        u32x4 w; w.x = cvt_pk_bf16(v0[0], v0[1]); w.y = cvt_pk_bf16(v0[2], v0[3]); w.z = cvt_pk_bf16(v1[0], v1[1]); w.w = cvt_pk_bf16(v1[2], v1[3]);
                        *(u32x4*)(rp + bj * HALF) = w; } }
        }
    }
};
template <int MODE> struct EpiGate {
    static constexpr bool PERM = true, AFTER_DRAIN = false;
    const bf16_t* gate; const bf16_t* t1; bf16_t* dst;
    __device__ __forceinline__ void operator()(const f32x4 (&acc)[2][2][4][2], const Unit& u, int wr, int wc, int fr, int fq) const {
        const int row0 = u.pm * BM + wr * 64 + fr, col0 = u.pn * BM + wc * 32 + 8 * fq;
#pragma unroll
        for (int ai = 0; ai < 2; ++ai)
#pragma unroll
            for (int m = 0; m < 4; ++m) { const size_t off = (size_t)(row0 + ai * HALF + m * 16) * 2048 + col0;
#pragma unroll
                for (int bj = 0; bj < 2; ++bj) { const u32x4 g = *(const u32x4*)(gate + off + bj * HALF);
                    f32x4 v0 = acc[ai][bj][m][0], v1 = acc[ai][bj][m][1];
                    v0[0] *= bflo(g.x); v0[1] *= bfhi(g.x); v0[2] *= bflo(g.y); v0[3] *= bfhi(g.y); v1[0] *= bflo(g.z); v1[1] *= bfhi(g.z); v1[2] *= bflo(g.w); v1[3] *= bfhi(g.w);
                    if (MODE == 1) { const u32x4 t = *(const u32x4*)(t1 + off + bj * HALF);
                        v0[0] += bflo(t.x); v0[1] += bfhi(t.x); v0[2] += bflo(t.y); v0[3] += bfhi(t.y); v1[0] += bflo(t.z); v1[1] += bfhi(t.z); v1[2] += bflo(t.w); v1[3] += bfhi(t.w); }
                    u32x4 w; w.x = cvt_pk_bf16(v0[0], v0[1]); w.y = cvt_pk_bf16(v0[2], v0[3]); w.z = cvt_pk_bf16(v1[0], v1[1]); w.w = cvt_pk_bf16(v1[2], v1[3]);
                    *(u32x4*)(dst + off + bj * HALF) = w; } }
    }
};
struct EpiRes {
    static constexpr bool PERM = true, AFTER_DRAIN = false;
    const bf16_t* resid; float* outf; bf16_t* xb; float* part;
    __device__ __forceinline__ void operator()(const f32x4 (&acc)[2][2][4][2], const Unit& u, int wr, int wc, int fr, int fq) const {
        if (REP_G46 > 1 && u.pass == 0) return;
        const int row0 = u.pm * BM + wr * 64 + fr, col0 = u.pn * BM + wc * 32 + 8 * fq;
#pragma unroll
        for (int ai = 0; ai < 2; ++ai)
#pragma unroll
            for (int m = 0; m < 4; ++m) { const int row = row0 + ai * HALF + m * 16; const size_t off = (size_t)row * 2048 + col0; float ss = 0.f;
#pragma unroll
                for (int bj = 0; bj < 2; ++bj) { const u32x4 rw = *(const u32x4*)(resid + off + bj * HALF);
                    f32x4 o0 = acc[ai][bj][m][0], o1 = acc[ai][bj][m][1];
                    o0[0] += bflo(rw.x); o0[1] += bfhi(rw.x); o0[2] += bflo(rw.y); o0[3] += bfhi(rw.y); o1[0] += bflo(rw.z); o1[1] += bfhi(rw.z); o1[2] += bflo(rw.w); o1[3] += bfhi(rw.w);
                    if (outf) { *(f32x4*)(outf + off + bj * HALF) = o0; *(f32x4*)(outf + off + bj * HALF + 4) = o1; }
                    else { ss += (o0[0] * o0[0] + o0[1] * o0[1]) + (o0[2] * o0[2] + o0[3] * o0[3]) + (o1[0] * o1[0] + o1[1] * o1[1]) + (o1[2] * o1[2] + o1[3] * o1[3]);
                        u32x4 w; w.x = cvt_pk_bf16(o0[0], o0[1]); w.y = cvt_pk_bf16(o0[2], o0[3]); w.z = cvt_pk_bf16(o1[0], o1[1]); w.w = cvt_pk_bf16(o1[2], o1[3]);
                        *(u32x4*)(xb + off + bj * HALF) = w; } }
                if (!outf) { ss += __shfl_xor(ss, 16); ss += __shfl_xor(ss, 32); if (fq == 0) part[(size_t)row * 32 + u.pn * 4 + wc] = ss; } }
    }
};
struct EpiUp {
    static constexpr bool PERM = true, AFTER_DRAIN = false;
    const float* rs; bf16_t* dst;
    __device__ __forceinline__ void operator()(const f32x4 (&acc)[2][2][4][2], const Unit& u, int wr, int wc, int fr, int fq) const {
        const int row0 = u.pm * BM + wr * 64 + fr, col0 = u.pn * BM + wc * 32 + 8 * fq;
#pragma unroll
        for (int ai = 0; ai < 2; ++ai)
#pragma unroll
            for (int m = 0; m < 4; ++m) { const int row = row0 + ai * HALF + m * 16; const float s = rs[row]; bf16_t* rp = dst + (size_t)row * DFF + col0;
#pragma unroll
                for (int bj = 0; bj < 2; ++bj) { f32x4 v0 = acc[ai][bj][m][0] * s, v1 = acc[ai][bj][m][1] * s;
#pragma unroll
                    for (int e = 0; e < 4; ++e) { const float a = fmaxf(v0[e], 0.f), b = fmaxf(v1[e], 0.f); v0[e] = a * a; v1[e] = b * b; }
                    u32x4 w; w.x = cvt_pk_bf16(v0[0], v0[1]); w.y = cvt_pk_bf16(v0[2], v0[3]); w.z = cvt_pk_bf16(v1[0], v1[1]); w.w = cvt_pk_bf16(v1[2], v1[3]);
                    *(u32x4*)(rp + bj * HALF) = w; } }
    }
};
}

__device__ __forceinline__ float wave_sum(float v) {
#pragma unroll
    for (int o = 1; o < 64; o <<= 1) v += __shfl_xor(v, o);
    return v;
}
__device__ __forceinline__ void transpose_item(const float* __restrict__ W, const float* __restrict__ gain, int K, int N, bf16* __restrict__ WT, LAS float* scr, int item, int lane) {
    const int nblk = N / 32, kb = item / nblk, nb = item % nblk, k0 = 64 * kb, n0 = 32 * nb;
    float wv[32];
#pragma unroll
    for (int i = 0; i < 32; ++i) { const int kk = 2 * i + (lane >> 5); wv[i] = W[(size_t)(k0 + kk) * N + n0 + (lane & 31)]; }
    const float g0 = gain ? gain[k0 + (lane & 63)] : 1.f;
#pragma unroll
    for (int i = 0; i < 32; ++i) { const int kk = 2 * i + (lane >> 5); const float g = __shfl(g0, kk); scr[kk * 33 + (lane & 31)] = wv[i] * g; }
    asm volatile("s_waitcnt lgkmcnt(0)" ::: "memory");
    const int c = lane & 7;
#pragma unroll
    for (int j = 0; j < 4; ++j) { const int n = (lane >> 3) + 8 * j; const LAS float* s = scr + (8 * c) * 33 + n;
        u32x4 o; o.x = pk2(s[0 * 33], s[1 * 33]); o.y = pk2(s[2 * 33], s[3 * 33]); o.z = pk2(s[4 * 33], s[5 * 33]); o.w = pk2(s[6 * 33], s[7 * 33]);
        *(u32x4*)(WT + (size_t)(n0 + n) * K + k0 + 8 * c) = o; }
    asm volatile("s_waitcnt lgkmcnt(0)" ::: "memory");
}

struct Args {
    const float *x, *norm_mix, *w_in, *lb_logits, *hg_norm, *q_norm, *k_norm, *sinks, *w_hg_out, *w_at_out, *w_out, *norm_ffn, *w_up, *w_down;
    float* out; unsigned char* ws;
};

__device__ __forceinline__ void hgrn2_seq(const bf16* __restrict__ QF, const float* __restrict__ LOGF, const bf16* __restrict__ VI, float* __restrict__ ORAW, int item, int tid) {
    const int bh = item >> 3, vs = item & 7, b = bh >> 3, h = bh & 7;
    const int lane = tid & 63, w = tid >> 6, kg = lane & 31, v = vs * 16 + w * 2 + (lane >> 5);
    const size_t rowbase = (size_t)b * SEQ;
    const int kc = h * 128 + kg * 4, vc = h * 128 + v;
    float S0 = 0.f, S1 = 0.f, S2 = 0.f, S3 = 0.f;
    f32x4 nlf[4]; u32x2 nq[4]; unsigned short nv[4];
#pragma unroll
    for (int j = 0; j < 4; ++j) { const size_t o = (rowbase + j) * 1024; nlf[j] = *(const f32x4*)(LOGF + o + kc); nq[j] = *(const u32x2*)(QF + o + kc); nv[j] = VI[o + vc]; }
    for (int t = 0; t < SEQ; t += 4) {
        f32x4 clf[4]; u32x2 cq[4]; unsigned short cv[4];
#pragma unroll
        for (int j = 0; j < 4; ++j) { clf[j] = nlf[j]; cq[j] = nq[j]; cv[j] = nv[j]; }
        if (t + 4 < SEQ) {
#pragma unroll
            for (int j = 0; j < 4; ++j) { const size_t o = (rowbase + t + 4 + j) * 1024; nlf[j] = *(const f32x4*)(LOGF + o + kc); nq[j] = *(const u32x2*)(QF + o + kc); nv[j] = VI[o + vc]; }
        }
#pragma unroll
        for (int j = 0; j < 4; ++j) {
            const float f0 = __expf(clf[j][0]), f1 = __expf(clf[j][1]), f2 = __expf(clf[j][2]), f3 = __expf(clf[j][3]);
            const float vv = __uint_as_float((unsigned)cv[j] << 16);
            S0 = f0 * S0 + (1.f - f0) * vv; S1 = f1 * S1 + (1.f - f1) * vv; S2 = f2 * S2 + (1.f - f2) * vv; S3 = f3 * S3 + (1.f - f3) * vv;
            float o = (bflo(cq[j].x) * S0 + bfhi(cq[j].x) * S1) + (bflo(cq[j].y) * S2 + bfhi(cq[j].y) * S3);
            o += __shfl_xor(o, 1); o += __shfl_xor(o, 2); o += __shfl_xor(o, 4); o += __shfl_xor(o, 8); o += __shfl_xor(o, 16);
            if (kg == 0) ORAW[(rowbase + t + j) * 1024 + vc] = o;
        }
    }
}

__device__ __forceinline__ void qk_norm_pass(bf16* AQ, bf16* AKV, const float* qn, const float* kn, int gtid, int NT) {
    const int sub = gtid & 7;
    f32x4 g0 = *(const f32x4*)(qn + sub * 8), g1 = *(const f32x4*)(qn + sub * 8 + 4);
    for (size_t c = gtid; c < (size_t)MTOK * 128; c += NT) {
        u32x4 w = *(u32x4*)(AQ + c * 8);
        float v[8] = {bflo(w.x), bfhi(w.x), bflo(w.y), bfhi(w.y), bflo(w.z), bfhi(w.z), bflo(w.w), bfhi(w.w)};
        float ss = 0.f;
#pragma unroll
        for (int e = 0; e < 8; ++e) ss += v[e] * v[e];
        ss += __shfl_xor(ss, 1); ss += __shfl_xor(ss, 2); ss += __shfl_xor(ss, 4);
        const float r = rsqrtf(ss * (1.f / 64.f) + EPSF) * 0.125f;
        u32x4 o; o.x = pk2(v[0] * r * g0[0], v[1] * r * g0[1]); o.y = pk2(v[2] * r * g0[2], v[3] * r * g0[3]); o.z = pk2(v[4] * r * g1[0], v[5] * r * g1[1]); o.w = pk2(v[6] * r * g1[2], v[7] * r * g1[3]);
        *(u32x4*)(AQ + c * 8) = o;
    }
    g0 = *(const f32x4*)(kn + sub * 8); g1 = *(const f32x4*)(kn + sub * 8 + 4);
    for (size_t c = gtid; c < (size_t)MTOK * 16; c += NT) {
        bf16* p = AKV + (c >> 4) * 256 + (c & 15) * 8;
        u32x4 w = *(u32x4*)p;
        float v[8] = {bflo(w.x), bfhi(w.x), bflo(w.y), bfhi(w.y), bflo(w.z), bfhi(w.z), bflo(w.w), bfhi(w.w)};
        float ss = 0.f;
#pragma unroll
        for (int e = 0; e < 8; ++e) ss += v[e] * v[e];
        ss += __shfl_xor(ss, 1); ss += __shfl_xor(ss, 2); ss += __shfl_xor(ss, 4);
        const float r = rsqrtf(ss * (1.f / 64.f) + EPSF);
        u32x4 o; o.x = pk2(v[0] * r * g0[0], v[1] * r * g0[1]); o.y = pk2(v[2] * r * g0[2], v[3] * r * g0[3]); o.z = pk2(v[4] * r * g1[0], v[5] * r * g1[1]); o.w = pk2(v[6] * r * g1[2], v[7] * r * g1[3]);
        *(u32x4*)p = o;
    }
}

__device__ __forceinline__ void hg_norm_pass(const float* __restrict__ ORAW, bf16* HGATE, const float* hn, int gtid, int NT) {
    const int sub = gtid & 15;
    const f32x4 g0 = *(const f32x4*)(hn + sub * 8), g1 = *(const f32x4*)(hn + sub * 8 + 4);
    for (size_t c = gtid; c < (size_t)MTOK * 128; c += NT) {
        const f32x4 a = *(const f32x4*)(ORAW + c * 8), b = *(const f32x4*)(ORAW + c * 8 + 4);
        float ss = (a[0] * a[0] + a[1] * a[1]) + (a[2] * a[2] + a[3] * a[3]) + (b[0] * b[0] + b[1] * b[1]) + (b[2] * b[2] + b[3] * b[3]);
        ss += __shfl_xor(ss, 1); ss += __shfl_xor(ss, 2); ss += __shfl_xor(ss, 4); ss += __shfl_xor(ss, 8);
        const float r = rsqrtf(ss * (1.f / 128.f) + EPSF);
        const u32x4 w = *(u32x4*)(HGATE + c * 8);
        u32x4 o; o.x = pk2(a[0] * r * g0[0] * bflo(w.x), a[1] * r * g0[1] * bfhi(w.x)); o.y = pk2(a[2] * r * g0[2] * bflo(w.y), a[3] * r * g0[3] * bfhi(w.y));
        o.z = pk2(b[0] * r * g1[0] * bflo(w.z), b[1] * r * g1[1] * bfhi(w.z)); o.w = pk2(b[2] * r * g1[2] * bflo(w.w), b[3] * r * g1[3] * bfhi(w.w));
        *(u32x4*)(HGATE + c * 8) = o;
    }
}

__device__ __forceinline__ void attn_simple(bf16* AQ, const bf16* __restrict__ AKV, const float* __restrict__ sinks, int gtid, int NT) {
    for (int i = gtid; i < MTOK * ATH; i += NT) {
        const int token = i >> 4, h = i & 15, t = token & (SEQ - 1), kvh = h >> 3;
        float q[64], o[64];
        bf16* qp = AQ + (size_t)token * 1024 + h * 64;
#pragma unroll
        for (int j = 0; j < 8; ++j) { const u32x4 w = *(const u32x4*)(qp + j * 8);
            q[j * 8 + 0] = bflo(w.x); q[j * 8 + 1] = bfhi(w.x); q[j * 8 + 2] = bflo(w.y); q[j * 8 + 3] = bfhi(w.y); q[j * 8 + 4] = bflo(w.z); q[j * 8 + 5] = bfhi(w.z); q[j * 8 + 6] = bflo(w.w); q[j * 8 + 7] = bfhi(w.w); }
#pragma unroll
        for (int d = 0; d < 64; ++d) o[d] = 0.f;
        const float slope = exp2f(-0.5f * (float)(h + 1));
        float mx = sinks[h], l = 1.f;
        const int nk = t < WIN - 1 ? t + 1 : WIN;
        const bf16* kp = AKV + (size_t)(token - nk + 1) * 256 + kvh * 64;
        for (int s = 0; s < nk; ++s, kp += 256) {
            float d0 = 0.f, d1 = 0.f;
#pragma unroll
            for (int j = 0; j < 8; ++j) { const u32x4 w = *(const u32x4*)(kp + j * 8);
                d0 += q[j * 8 + 0] * bflo(w.x) + q[j * 8 + 2] * bflo(w.y) + q[j * 8 + 4] * bflo(w.z) + q[j * 8 + 6] * bflo(w.w);
                d1 += q[j * 8 + 1] * bfhi(w.x) + q[j * 8 + 3] * bfhi(w.y) + q[j * 8 + 5] * bfhi(w.z) + q[j * 8 + 7] * bfhi(w.w); }
            const float sc = (d0 + d1) - slope * (float)(nk - 1 - s);
            if (sc > mx) { const float al = __expf(mx - sc); l *= al;
#pragma unroll
                for (int d = 0; d < 64; ++d) o[d] *= al;
                mx = sc; }
            const float p = __expf(sc - mx); l += p;
#pragma unroll
            for (int j = 0; j < 8; ++j) { const u32x4 w = *(const u32x4*)(kp + 128 + j * 8);
                o[j * 8 + 0] += p * bflo(w.x); o[j * 8 + 1] += p * bfhi(w.x); o[j * 8 + 2] += p * bflo(w.y); o[j * 8 + 3] += p * bfhi(w.y);
                o[j * 8 + 4] += p * bflo(w.z); o[j * 8 + 5] += p * bfhi(w.z); o[j * 8 + 6] += p * bflo(w.w); o[j * 8 + 7] += p * bfhi(w.w); }
        }
        const float inv = 1.f / l;
#pragma unroll
        for (int j = 0; j < 8; ++j) { u32x4 w; w.x = pk2(o[j * 8 + 0] * inv, o[j * 8 + 1] * inv); w.y = pk2(o[j * 8 + 2] * inv, o[j * 8 + 3] * inv); w.z = pk2(o[j * 8 + 4] * inv, o[j * 8 + 5] * inv); w.w = pk2(o[j * 8 + 6] * inv, o[j * 8 + 7] * inv);
            *(u32x4*)(qp + j * 8) = w; }
    }
}

typedef short bf16x8 __attribute__((ext_vector_type(8)));
typedef float f32x2 __attribute__((ext_vector_type(2)));
#define MFMA16(a, b, c) __builtin_amdgcn_mfma_f32_16x16x32_bf16((a), (b), (c), 0, 0, 0)
constexpr int HL_CUM = 0, HL_ABUF = 0, HL_TOT = 32768, HL_REF = 34816, HL_QT = 35840, HL_KST = HL_QT, HL_KT = HL_QT + 17408, HL_QO = HL_KT + 17408,
              HL_VT = HL_QO + 17408, HL_ST = HL_VT + 18432, HL_SS = HL_ST + 34816, HL_END = HL_SS + 512;
static_assert(HL_END <= LDS_BYTES, "HGRN2 LDS map");
struct Prep { float cum[16]; float lf[16]; float ref, last; };
struct ALoads { float lf[16]; unsigned vv[16]; };
struct CLoads { ALoads a; u32x4 st[4]; f32x4 lfR[4]; u32x4 qR[2]; u32x2 hg[4]; };
__device__ __forceinline__ void hg_issue1(ALoads& L, const float* __restrict__ LOGF, const bf16* __restrict__ VI, int item, int tid) {
    const int h = item & 7, k = tid & 127, seg = tid >> 7; const size_t tok0 = (size_t)(item >> 3) * 64;
    const float* lp = LOGF + (tok0 + 16 * seg) * 1024 + h * 128 + k;
    const bf16* vp = VI + (tok0 + 16 * seg) * 1024 + h * 128 + k;
#pragma unroll
    for (int i = 0; i < 16; ++i) { L.lf[i] = lp[i * 1024]; L.vv[i] = vp[i * 1024]; }
}
__device__ __forceinline__ void hg_step1(LAS unsigned char* lds, const ALoads& L, int tid, Prep& P) {
    const int k = tid & 127, seg = tid >> 7;
    float run = 0.f;
#pragma unroll
    for (int i = 0; i < 16; ++i) { P.lf[i] = L.lf[i]; run += L.lf[i]; P.cum[i] = run; }
    LAS float* TOT = (LAS float*)(lds + HL_TOT);
    TOT[seg * 128 + k] = run;
    u32x4 w0, w1;
    w0.x = L.vv[0] | (L.vv[1] << 16); w0.y = L.vv[2] | (L.vv[3] << 16); w0.z = L.vv[4] | (L.vv[5] << 16); w0.w = L.vv[6] | (L.vv[7] << 16);
    w1.x = L.vv[8] | (L.vv[9] << 16); w1.y = L.vv[10] | (L.vv[11] << 16); w1.z = L.vv[12] | (L.vv[13] << 16); w1.w = L.vv[14] | (L.vv[15] << 16);
    *(LAS u32x4*)(lds + HL_VT + (k * 72 + 16 * seg) * 2) = w0; *(LAS u32x4*)(lds + HL_VT + (k * 72 + 16 * seg) * 2 + 16) = w1;
    __syncthreads();
    const float t0 = TOT[k], t1 = TOT[128 + k], t2 = TOT[256 + k], t3 = TOT[384 + k];
    const float off = seg == 0 ? 0.f : seg == 1 ? t0 : seg == 2 ? t0 + t1 : (t0 + t1) + t2;
#pragma unroll
    for (int i = 0; i < 16; ++i) P.cum[i] += off;
    P.ref = t0 + t1; P.last = (t0 + t1) + (t2 + t3);
}
__device__ __forceinline__ void hgrn_a_item(LAS unsigned char* lds, ALoads& L, const float* __restrict__ LOGF, const bf16* __restrict__ VI, bf16* __restrict__ UT, float* __restrict__ D, int item, int next, int tid) {
    (void)next; hg_issue1(L, LOGF, VI, item, tid);
    Prep P; hg_step1(lds, L, tid, P);
    const int k = tid & 127, seg = tid >> 7;
    unsigned pk[8];
#pragma unroll
    for (int i = 0; i < 8; ++i) { const float a = (1.f - __expf(P.lf[2 * i])) * __expf(P.last - P.cum[2 * i]), b = (1.f - __expf(P.lf[2 * i + 1])) * __expf(P.last - P.cum[2 * i + 1]); pk[i] = pk2(a, b); }
    *(LAS u32x4*)(lds + HL_KST + (k * 72 + 16 * seg) * 2) = (u32x4){pk[0], pk[1], pk[2], pk[3]};
    *(LAS u32x4*)(lds + HL_KST + (k * 72 + 16 * seg) * 2 + 16) = (u32x4){pk[4], pk[5], pk[6], pk[7]};
    if (seg == 0) D[(size_t)item * 128 + k] = __expf(P.last);
    __syncthreads();
    const int lane = tid & 63, w = tid >> 6, r = lane & 15, q = lane >> 4;
    bf16x8 af[2];
#pragma unroll
    for (int ks = 0; ks < 2; ++ks) af[ks] = *(const LAS bf16x8*)(lds + HL_KST + ((16 * w + r) * 72 + 32 * ks + 8 * q) * 2);
    bf16* ut = UT + (size_t)item * 16384;
#pragma unroll
    for (int nt = 0; nt < 8; ++nt) { f32x4 acc = {0.f, 0.f, 0.f, 0.f};
#pragma unroll
        for (int ks = 0; ks < 2; ++ks) { const bf16x8 bfr = *(const LAS bf16x8*)(lds + HL_VT + ((16 * nt + r) * 72 + 32 * ks + 8 * q) * 2); acc = MFMA16(af[ks], bfr, acc); }
        u32x2 o; o.x = pk2(acc[0], acc[1]); o.y = pk2(acc[2], acc[3]);
        *(u32x2*)(ut + (16 * nt + r) * 128 + 16 * w + 4 * q) = o; }
    __syncthreads();
}
__device__ __forceinline__ void hgrn_scan(bf16* UT, bf16* SDST, const float* __restrict__ D, int gtid, int NT) {
    for (int e = gtid; e < 16 * 8192; e += NT) {
        const int bh = e >> 13, off = (e & 8191) * 2, b = bh >> 3, h = bh & 7, k = off & 127;
        unsigned* up = (unsigned*)(UT + ((size_t)(b * 256) * 8 + h) * 16384 + off);
        unsigned* sp = (unsigned*)(SDST + ((size_t)(b * 256) * 8 + h) * 16384 + off);
        const float* dp = D + ((size_t)(b * 256) * 8 + h) * 128 + k;
        float s0 = 0.f, s1 = 0.f;
        for (int n = 0; n < 256; n += 16) {
            unsigned u[16]; f32x2 d[16];
#pragma unroll
            for (int j = 0; j < 16; ++j) { u[j] = up[(size_t)(n + j) * 65536]; d[j] = *(const f32x2*)(dp + (size_t)(n + j) * 1024); }
#pragma unroll
            for (int j = 0; j < 16; ++j) { sp[(size_t)(n + j) * 65536] = pk2(s0, s1); s0 = d[j].x * s0 + bflo(u[j]); s1 = d[j].y * s1 + bfhi(u[j]); }
        }
    }
}
__device__ __forceinline__ void hgc_issue_st(CLoads& L, const bf16* __restrict__ ST, int item, int tid) {
    const u32x4* sg = (const u32x4*)(ST + (size_t)item * 16384);
#pragma unroll
    for (int j = 0; j < 4; ++j) L.st[j] = sg[tid + 512 * j];
}
__device__ __forceinline__ void hgc_issue_r(CLoads& L, const bf16* __restrict__ QF, const float* __restrict__ LOGF, int item, int tid) {
    const int h = item & 7, t = tid >> 3, k0 = 16 * (tid & 7); const size_t go = ((size_t)(item >> 3) * 64 + t) * 1024 + h * 128 + k0;
#pragma unroll
    for (int j = 0; j < 4; ++j) L.lfR[j] = *(const f32x4*)(LOGF + go + 4 * j);
    L.qR[0] = *(const u32x4*)(QF + go); L.qR[1] = *(const u32x4*)(QF + go + 8);
}
__device__ __forceinline__ void hgc_issue_hg(CLoads& L, const bf16* HGATE, int item, int tid) {
    const int h = item & 7, lane = tid & 63, w = tid >> 6, r = lane & 15, q = lane >> 4, nt = w & 3, vh = w >> 2;
    const bf16* hp = HGATE + ((size_t)(item >> 3) * 64 + 16 * nt + r) * 1024 + h * 128;
#pragma unroll
    for (int j = 0; j < 4; ++j) L.hg[j] = *(const u32x2*)(hp + 16 * (4 * vh + j) + 4 * q);
}
__device__ __forceinline__ void hgrn_c_item(LAS unsigned char* lds, CLoads& L, const bf16* __restrict__ QF, const float* __restrict__ LOGF, const bf16* __restrict__ VI, const bf16* __restrict__ ST,
                                            bf16* HGATE, bf16* HDST, const float* __restrict__ hn, int item, int next, int tid) {
    const int h = item & 7; const size_t tok0 = (size_t)(item >> 3) * 64;
    (void)next; hg_issue1(L.a, LOGF, VI, item, tid); hgc_issue_st(L, ST, item, tid); hgc_issue_r(L, QF, LOGF, item, tid); hgc_issue_hg(L, HGATE, item, tid);
    Prep P; hg_step1(lds, L.a, tid, P);
    {
        const int k = tid & 127, seg = tid >> 7;
        LAS float* CUM = (LAS float*)(lds + HL_CUM);
#pragma unroll
        for (int i = 0; i < 16; ++i) CUM[(16 * seg + i) * 128 + k] = P.cum[i];
        if (seg == 0) ((LAS float*)(lds + HL_REF))[k] = P.ref;
#pragma unroll
        for (int j = 0; j < 4; ++j) { const int idx = tid + 512 * j, v = idx >> 4, c = idx & 15; *(LAS u32x4*)(lds + HL_ST + (v * 136 + c * 8) * 2) = L.st[j]; }
    }
    __syncthreads();
    {
        const int t = tid >> 3, k0 = 16 * (tid & 7);
        f32x4 cm[4], rf[4];
#pragma unroll
        for (int j = 0; j < 4; ++j) { cm[j] = *(const LAS f32x4*)(lds + HL_CUM + (t * 128 + k0 + 4 * j) * 4); rf[j] = *(const LAS f32x4*)(lds + HL_REF + (k0 + 4 * j) * 4); }
        unsigned pq[8], pkk[8], po[8];
#pragma unroll
        for (int j = 0; j < 8; ++j) {
            const unsigned qw = L.qR[j >> 2][j & 3]; const float q0 = bflo(qw), q1 = bfhi(qw);
            const int e0 = 2 * j, e1 = 2 * j + 1;
            const float c0 = cm[e0 >> 2][e0 & 3], c1 = cm[e1 >> 2][e1 & 3], r0 = rf[e0 >> 2][e0 & 3], r1 = rf[e1 >> 2][e1 & 3];
            const float kf0 = 1.f - __expf(L.lfR[e0 >> 2][e0 & 3]), kf1 = 1.f - __expf(L.lfR[e1 >> 2][e1 & 3]);
            pq[j] = pk2(q0 * __expf(c0 - r0), q1 * __expf(c1 - r1));
            pkk[j] = pk2(kf0 * __expf(r0 - c0), kf1 * __expf(r1 - c1));
            po[j] = pk2(q0 * __expf(c0), q1 * __expf(c1));
        }
        const int lo = (t * 136 + k0) * 2;
        *(LAS u32x4*)(lds + HL_QT + lo) = (u32x4){pq[0], pq[1], pq[2], pq[3]}; *(LAS u32x4*)(lds + HL_QT + lo + 16) = (u32x4){pq[4], pq[5], pq[6], pq[7]};
        *(LAS u32x4*)(lds + HL_KT + lo) = (u32x4){pkk[0], pkk[1], pkk[2], pkk[3]}; *(LAS u32x4*)(lds + HL_KT + lo + 16) = (u32x4){pkk[4], pkk[5], pkk[6], pkk[7]};
        *(LAS u32x4*)(lds + HL_QO + lo) = (u32x4){po[0], po[1], po[2], po[3]}; *(LAS u32x4*)(lds + HL_QO + lo + 16) = (u32x4){po[4], po[5], po[6], po[7]};
    }
    __syncthreads();
    const int lane = tid & 63, w = tid >> 6, r = lane & 15, q = lane >> 4, nt = w & 3, vh = w >> 2;
    {
#pragma unroll
        for (int mm = 0; mm < 2; ++mm) { const int mt = vh * 2 + mm; f32x4 acc = {0.f, 0.f, 0.f, 0.f};
            if (mt <= nt) {
#pragma unroll
                for (int ks = 0; ks < 4; ++ks) { const bf16x8 a = *(const LAS bf16x8*)(lds + HL_KT + ((16 * mt + r) * 136 + 32 * ks + 8 * q) * 2), b = *(const LAS bf16x8*)(lds + HL_QT + ((16 * nt + r) * 136 + 32 * ks + 8 * q) * 2);
                    acc = MFMA16(a, b, acc); } }
            const int c = 16 * nt + r, s0 = 16 * mt + 4 * q;
            const float a0 = (mt <= nt && s0 + 0 <= c) ? acc[0] : 0.f, a1 = (mt <= nt && s0 + 1 <= c) ? acc[1] : 0.f, a2 = (mt <= nt && s0 + 2 <= c) ? acc[2] : 0.f, a3 = (mt <= nt && s0 + 3 <= c) ? acc[3] : 0.f;
            u32x2 o; o.x = pk2(a0, a1); o.y = pk2(a2, a3);
            *(LAS u32x2*)(lds + HL_ABUF + (c * 72 + s0) * 2) = o; }
    }
    __syncthreads();
    {
        bf16x8 bA[2], bQ[4];
#pragma unroll
        for (int ks = 0; ks < 2; ++ks) bA[ks] = *(const LAS bf16x8*)(lds + HL_ABUF + ((16 * nt + r) * 72 + 32 * ks + 8 * q) * 2);
#pragma unroll
        for (int ks = 0; ks < 4; ++ks) bQ[ks] = *(const LAS bf16x8*)(lds + HL_QO + ((16 * nt + r) * 136 + 32 * ks + 8 * q) * 2);
        f32x4 acc[4]; float ss = 0.f;
#pragma unroll
        for (int j = 0; j < 4; ++j) { const int vt = 4 * vh + j; acc[j] = (f32x4){0.f, 0.f, 0.f, 0.f};
#pragma unroll
            for (int ks = 0; ks < 2; ++ks) { const bf16x8 a = *(const LAS bf16x8*)(lds + HL_VT + ((16 * vt + r) * 72 + 32 * ks + 8 * q) * 2); acc[j] = MFMA16(a, bA[ks], acc[j]); }
#pragma unroll
            for (int ks = 0; ks < 4; ++ks) { const bf16x8 a = *(const LAS bf16x8*)(lds + HL_ST + ((16 * vt + r) * 136 + 32 * ks + 8 * q) * 2); acc[j] = MFMA16(a, bQ[ks], acc[j]); }
            ss += (acc[j][0] * acc[j][0] + acc[j][1] * acc[j][1]) + (acc[j][2] * acc[j][2] + acc[j][3] * acc[j][3]); }
        ss += __shfl_xor(ss, 16); ss += __shfl_xor(ss, 32);
        LAS float* SS = (LAS float*)(lds + HL_SS);
        if (q == 0) SS[vh * 64 + 16 * nt + r] = ss;
        __syncthreads();
        const float rr = rsqrtf((SS[16 * nt + r] + SS[64 + 16 * nt + r]) * (1.f / 128.f) + EPSF);
        bf16* hp = HGATE + (tok0 + 16 * nt + r) * 1024 + h * 128;
#pragma unroll
        for (int j = 0; j < 4; ++j) { const int vb = 16 * (4 * vh + j) + 4 * q; const f32x4 g = *(const f32x4*)(hn + vb); const u32x2 hg = L.hg[j];
            u32x2 o; o.x = pk2(acc[j][0] * rr * g[0] * bflo(hg.x), acc[j][1] * rr * g[1] * bfhi(hg.x)); o.y = pk2(acc[j][2] * rr * g[2] * bflo(hg.y), acc[j][3] * rr * g[3] * bfhi(hg.y));
            *(u32x2*)(HDST + (hp - HGATE) + vb) = o; }
    }
    __syncthreads();
}

constexpr int AL_K = 0, AL_VT = 208 * 144, AL_END = AL_VT + 64 * 432;
static_assert(AL_END <= LDS_BYTES, "attention LDS map");
__device__ __forceinline__ void attn_item(LAS unsigned char* lds, bf16* AQ, bf16* ODST, const bf16* __restrict__ AKV, const float* __restrict__ sinks, int item, int tid) {
    const int b = item >> 9, kvh = (item >> 8) & 1, qb = item & 255, t0 = qb * 64;
    const size_t tokb = (size_t)b * SEQ;
#pragma unroll
    for (int j = 0; j < 3; ++j) { const int idx = tid + 512 * j, key = idx >> 3, c = idx & 7, s = t0 - 128 + key; u32x4 v = {0u, 0u, 0u, 0u};
        if (s >= 0) v = *(const u32x4*)(AKV + (tokb + s) * 256 + kvh * 64 + c * 8);
        *(LAS u32x4*)(lds + AL_K + (key * 72 + c * 8) * 2) = v; }
    {
        const int d = tid & 63, kseg = tid >> 6; unsigned vv[24];
#pragma unroll
        for (int i = 0; i < 24; ++i) { const int s = t0 - 128 + 24 * kseg + i; vv[i] = s >= 0 ? (unsigned)AKV[(tokb + s) * 256 + 128 + kvh * 64 + d] : 0u; }
#pragma unroll
        for (int j = 0; j < 3; ++j) { u32x4 w; w.x = vv[8 * j] | (vv[8 * j + 1] << 16); w.y = vv[8 * j + 2] | (vv[8 * j + 3] << 16); w.z = vv[8 * j + 4] | (vv[8 * j + 5] << 16); w.w = vv[8 * j + 6] | (vv[8 * j + 7] << 16);
            *(LAS u32x4*)(lds + AL_VT + (d * 216 + 24 * kseg + 8 * j) * 2) = w; }
        if (kseg == 0) { *(LAS u32x4*)(lds + AL_VT + (d * 216 + 192) * 2) = (u32x4){0u, 0u, 0u, 0u}; *(LAS u32x4*)(lds + AL_VT + (d * 216 + 200) * 2) = (u32x4){0u, 0u, 0u, 0u}; }
    }
    __syncthreads();
    const int lane = tid & 63, w = tid >> 6, r = lane & 15, quad = lane >> 4, h = kvh * 8 + w;
    const float slope = exp2f(-0.5f * (float)(h + 1)), sink = sinks[h];
    bf16* qbase = AQ + (tokb + t0) * 1024 + h * 64;
#pragma unroll 1
    for (int qt = 0; qt < 4; ++qt) {
        bf16x8 qf[2];
#pragma unroll
        for (int ks = 0; ks < 2; ++ks) qf[ks] = *(const bf16x8*)(qbase + (size_t)(16 * qt + r) * 1024 + 32 * ks + 8 * quad);
        f32x4 s[10];
#pragma unroll
        for (int a = 0; a < 10; ++a) { s[a] = (f32x4){0.f, 0.f, 0.f, 0.f};
#pragma unroll
            for (int ks = 0; ks < 2; ++ks) { const bf16x8 kf = *(const LAS bf16x8*)(lds + AL_K + ((16 * (qt + a) + r) * 72 + 32 * ks + 8 * quad) * 2); s[a] = MFMA16(kf, qf[ks], s[a]); } }
        const int iq = 16 * qt + r; float mx = sink;
#pragma unroll
        for (int a = 0; a < 10; ++a)
#pragma unroll
            for (int i = 0; i < 4; ++i) { const int j = 16 * (qt + a) + 4 * quad + i, dist = 128 + iq - j; const bool valid = (unsigned)dist < 128u && (t0 - 128 + j) >= 0;
                const float v = valid ? s[a][i] - slope * (float)dist : -INFINITY; s[a][i] = v; mx = fmaxf(mx, v); }
        mx = fmaxf(mx, __shfl_xor(mx, 16)); mx = fmaxf(mx, __shfl_xor(mx, 32));
        float sum = 0.f;
#pragma unroll
        for (int a = 0; a < 10; ++a)
#pragma unroll
            for (int i = 0; i < 4; ++i) { const float p = __expf(s[a][i] - mx); s[a][i] = p; sum += p; }
        sum += __shfl_xor(sum, 16); sum += __shfl_xor(sum, 32); sum += __expf(sink - mx);
        const float inv = 1.f / sum;
        f32x4 o[4];
#pragma unroll
        for (int dt = 0; dt < 4; ++dt) o[dt] = (f32x4){0.f, 0.f, 0.f, 0.f};
#pragma unroll
        for (int kp = 0; kp < 5; ++kp) {
            const u32x4 pw = {pk2(s[2 * kp][0], s[2 * kp][1]), pk2(s[2 * kp][2], s[2 * kp][3]), pk2(s[2 * kp + 1][0], s[2 * kp + 1][1]), pk2(s[2 * kp + 1][2], s[2 * kp + 1][3])};
            const bf16x8 pb = __builtin_bit_cast(bf16x8, pw);
#pragma unroll
            for (int dt = 0; dt < 4; ++dt) {
                const u32x2 lo = *(const LAS u32x2*)(lds + AL_VT + ((16 * dt + r) * 216 + 16 * (qt + 2 * kp) + 4 * quad) * 2), hi = *(const LAS u32x2*)(lds + AL_VT + ((16 * dt + r) * 216 + 16 * (qt + 2 * kp + 1) + 4 * quad) * 2);
                const u32x4 vw = {lo.x, lo.y, hi.x, hi.y};
                o[dt] = MFMA16(__builtin_bit_cast(bf16x8, vw), pb, o[dt]); }
        }
#pragma unroll
        for (int dt = 0; dt < 4; ++dt) { u32x2 wv; wv.x = pk2(o[dt][0] * inv, o[dt][1] * inv); wv.y = pk2(o[dt][2] * inv, o[dt][3] * inv);
            *(u32x2*)(ODST + (qbase - AQ) + (size_t)iq * 1024 + 16 * dt + 4 * quad) = wv; }
    }
    __syncthreads();
}

__device__ __forceinline__ void rowstats_pass(const float* __restrict__ part, float* __restrict__ rs, int gtid, int NT) {
    for (int r = gtid; r < MTOK; r += NT) { const f32x4* p = (const f32x4*)(part + (size_t)r * 32); float s = 0.f;
#pragma unroll
        for (int j = 0; j < 8; ++j) { const f32x4 v = p[j]; s += (v[0] + v[1]) + (v[2] + v[3]); }
        rs[r] = rsqrtf(s * (1.f / DM) + EPSF); }
}

#define XB_TMO      128
#define XB_XCNT(j)  (256  + 64 * (j))
#define XB_XSUB(j)  (1280 + 64 * (j))
#define XB_XGEN(j)  (2304 + 64 * (j))
#define XB_TOP      3328
#define XB_TOPGEN   3392
#define XCD_BAR_WORDS 3456
#define XB_SPIN_CAP (1u << 18)

__device__ __forceinline__ unsigned xb_ld(unsigned* p)              { return __hip_atomic_load(p, __ATOMIC_RELAXED, __HIP_MEMORY_SCOPE_AGENT); }
__device__ __forceinline__ unsigned xb_add(unsigned* p, unsigned v) { return __hip_atomic_fetch_add(p, v, __ATOMIC_RELAXED, __HIP_MEMORY_SCOPE_AGENT); }
__device__ __forceinline__ unsigned xb_xcc_id() { return (unsigned)__builtin_amdgcn_s_getreg((3 << 11) | 20) & 0xFu; }
#define XB_SPIN(cond, bar) do { unsigned _sp = 0; while (cond) { __builtin_amdgcn_s_sleep(1); \
    if ((++_sp & 255u) == 0u) { if (xb_ld(&(bar)[XB_TMO])) break; if (_sp > XB_SPIN_CAP) { atomicAdd(&(bar)[XB_TMO], 1u); break; } } } } while (0)

struct XcdBarrier {
    unsigned* bar; unsigned x;
    volatile LAS unsigned* st;
};

__device__ __forceinline__ XcdBarrier xcd_barrier_post(unsigned* bar, volatile LAS unsigned* st) {
    XcdBarrier b; b.bar = bar; b.x = xb_xcc_id(); b.st = st;
    if (threadIdx.x == 0) (void)xb_add(&bar[XB_XCNT(b.x)], 1u);
    return b;
}
__device__ __forceinline__ void xcd_barrier_complete(unsigned* bar, unsigned x, unsigned& nloc, unsigned& nx) {
    const unsigned G = gridDim.x * gridDim.y * gridDim.z;
    unsigned sum, cnt, mine, sp = 0u;
    for (;;) {
        sum = 0u; cnt = 0u; mine = 0u;
#pragma unroll
        for (unsigned j = 0; j < 16; ++j) { const unsigned c = xb_ld(&bar[XB_XCNT(j)]); sum += c; cnt += (c > 0u) ? 1u : 0u; mine = (j == x) ? c : mine; }
        if (sum == G) break;
        __builtin_amdgcn_s_sleep(1);
        if ((++sp & 255u) == 0u) { if (xb_ld(&bar[XB_TMO])) break; if (sp > XB_SPIN_CAP) { atomicAdd(&bar[XB_TMO], 1u); break; } }
    }
    nloc = mine > 0u ? mine : 1u; nx = cnt > 0u ? cnt : 1u;
}

__device__ __forceinline__ void xcd_barrier(const XcdBarrier& b, bool leader) {
    asm volatile("s_waitcnt vmcnt(0)" ::: "memory");
    __syncthreads();
    if (leader) {
        unsigned* bar = b.bar;
        __builtin_amdgcn_s_waitcnt(0);
        unsigned nloc = b.st[0], nx = b.st[1];
        if (nloc == 0u) { xcd_barrier_complete(bar, b.x, nloc, nx); b.st[0] = nloc; b.st[1] = nx; }
        const unsigned old = xb_add(&bar[XB_XSUB(b.x)], 1u);
        const unsigned gen = old / nloc;
        if (old + 1u == (gen + 1u) * nloc) {
            __builtin_amdgcn_fence(__ATOMIC_RELEASE, "agent");
            asm volatile("s_waitcnt vmcnt(0)" ::: "memory");
            const unsigned og = xb_add(&bar[XB_TOP], 1u);
            const unsigned tg = og / nx;
            if (og + 1u == (tg + 1u) * nx) xb_add(&bar[XB_TOPGEN], 1u);
            else XB_SPIN(xb_ld(&bar[XB_TOPGEN]) == tg, bar);
            __builtin_amdgcn_fence(__ATOMIC_ACQUIRE, "agent");
            xb_add(&bar[XB_XGEN(b.x)], 1u);
            asm volatile("s_waitcnt vmcnt(0)" ::: "memory");
        } else {
            XB_SPIN(xb_ld(&bar[XB_XGEN(b.x)]) == gen, bar);
            __builtin_amdgcn_fence(__ATOMIC_ACQUIRE, "agent");
            asm volatile("s_waitcnt vmcnt(0)" ::: "memory");
        }
    }
    __syncthreads();
}

constexpr int MISC_OFF = LDS_BYTES - 256;
static_assert(MISC_OFF >= 141824 && MISC_OFF >= 131072, "LDS control words above every phase's LDS map");
typedef const Args __attribute__((address_space(4)))* KArgsP;
__device__ __forceinline__ KArgsP kargs() { KArgsP p = (KArgsP)__builtin_amdgcn_kernarg_segment_ptr(); asm volatile("" : "+s"(p)); return p; }
#define ZP(off) (ka->ws + WS_Z + (off))
#define WL(off) ((const bf16*)(ka->ws + WS_W + (size_t)l * W_LAYER + (off)))
__global__ void __launch_bounds__(512, 2) fwd_mega(Args a_unused) {
    extern __shared__ __attribute__((aligned(16))) unsigned char lds_raw[];
    LAS unsigned char* lds = (LAS unsigned char*)lds_raw;
    cg::grid_group grid = cg::this_grid();
    const int G = gridDim.x, bx = blockIdx.x;
    const int wave_s = __builtin_amdgcn_readfirstlane((int)threadIdx.x >> 6);
#define MYTID() ((wave_s << 6) | (int)__builtin_amdgcn_mbcnt_hi(~0u, __builtin_amdgcn_mbcnt_lo(~0u, 0u)))
    if (threadIdx.x < 2) ((volatile LAS unsigned*)(lds + MISC_OFF))[threadIdx.x] = 0u;
    __syncthreads();
    { KArgsP ka = kargs(); (void)xcd_barrier_post((unsigned*)(ka->ws + WS_BAR), (volatile LAS unsigned*)(lds + MISC_OFF)); }
#define GSYNC() do { KArgsP ka_ = kargs(); XcdBarrier b_; b_.bar = (unsigned*)(ka_->ws + WS_BAR); b_.x = xb_xcc_id(); b_.st = (volatile LAS unsigned*)(lds + MISC_OFF); xcd_barrier(b_, MYTID() == 0); } while (0)
#define TIDS int tid_ = MYTID(); asm volatile("" : "+v"(tid_)); const int tid = tid_, lane = tid & 63, wave = __builtin_amdgcn_readfirstlane(tid >> 6), gw = bx * 8 + wave, NGW = G * 8, gtid = bx * 512 + tid, NT = G * 512; (void)lane; (void)gw; (void)NGW; (void)gtid; (void)NT;

#if REP_P0 > 1
    int np0 = REP_P0; asm volatile("" : "+s"(np0));
#pragma unroll 1
    for (int rep0 = 0; rep0 < np0; ++rep0)
#endif
    {
        KArgsP ka = kargs(); TIDS
        unsigned char* ws = ka->ws; float* RS = (float*)(ws + WS_RS); float* LB = (float*)(ws + WS_LB); bf16* XB = (bf16*)(ws + WS_XB);
        LAS float* scr = (LAS float*)(lds + wave * 16384);
        constexpr int I_IN = (DM / 64) * (DIN / 32), I_HG = (HGW / 64) * (DM / 32), I_AT = (ATW / 64) * (DM / 32), I_OUT = (DM / 64) * (DM / 32), I_UP = (DM / 64) * (DFF / 32), I_DN = (DFF / 64) * (DM / 32);
        constexpr int I_LAYER = I_IN + I_HG + I_AT + I_OUT + I_UP + I_DN;
        for (int it = gw; it < 2 * I_LAYER; it += NGW) {
            const int l = it >= I_LAYER ? 1 : 0; int r = it - l * I_LAYER; unsigned char* wl = ws + WS_W + (size_t)l * W_LAYER;
            if (r < I_IN) { transpose_item(ka->w_in + (size_t)l * DM * DIN, ka->norm_mix + l * DM, DM, DIN, (bf16*)(wl + W_IN), scr, r, lane); continue; } r -= I_IN;
            if (r < I_HG) { transpose_item(ka->w_hg_out + (size_t)l * HGW * DM, nullptr, HGW, DM, (bf16*)(wl + W_HG), scr, r, lane); continue; } r -= I_HG;
            if (r < I_AT) { transpose_item(ka->w_at_out + (size_t)l * ATW * DM, nullptr, ATW, DM, (bf16*)(wl + W_AT), scr, r, lane); continue; } r -= I_AT;
            if (r < I_OUT) { transpose_item(ka->w_out + (size_t)l * DM * DM, nullptr, DM, DM, (bf16*)(wl + W_OUT), scr, r, lane); continue; } r -= I_OUT;
            if (r < I_UP) { transpose_item(ka->w_up + (size_t)l * DM * DFF, ka->norm_ffn + l * DM, DM, DFF, (bf16*)(wl + W_UP), scr, r, lane); continue; } r -= I_UP;
            transpose_item(ka->w_down + (size_t)l * DFF * DM, nullptr, DFF, DM, (bf16*)(wl + W_DN), scr, r, lane);
        }
        for (int c = gtid; c < 1024; c += NT) { LB[c] = 0.f; LB[1024 + c] = sigm(ka->lb_logits[1024 + c] - ka->lb_logits[c]); }
        const float* x = ka->x;
        for (int m = gw; m < MTOK; m += NGW) {
            const f32x4* xr = (const f32x4*)(x + (size_t)m * DM) + lane; f32x4 v[8]; float s = 0.f;
#pragma unroll
            for (int j = 0; j < 8; ++j) { v[j] = xr[64 * j]; s += (v[j][0] * v[j][0] + v[j][1] * v[j][1]) + (v[j][2] * v[j][2] + v[j][3] * v[j][3]); }
            s = wave_sum(s);
            if (lane == 0) RS[m] = rsqrtf(s * (1.f / DM) + EPSF);
            u32x2* o8 = (u32x2*)(XB + (size_t)m * DM) + lane;
#pragma unroll
            for (int j = 0; j < 8; ++j) { u32x2 w; w.x = pk2(v[j][0], v[j][1]); w.y = pk2(v[j][2], v[j][3]); o8[64 * j] = w; }
        }
    }
    grid.sync();

    for (int l = 0; l < 2; ++l) {
        if (ON(1)) {
            KArgsP ka = kargs();
            pg8::Gemm g{(const bf16*)(ka->ws + WS_XB), WL(W_IN), MTOK, DIN, DM}; pg8::StaticOrder S; S.init(MTOK, DIN, G, bx, REP_G1);
            pg8::EpiIn E{(const float*)(ka->ws + WS_RS), (const float*)(ka->ws + WS_LB) + l * 1024, ka->ws + WS_Z};
            pg8::gemm_phase<pg8::EpiIn, pg8::StaticOrder, PG_ALIGN, PG_SP2>(lds, g, S, E, MYTID());
        }
        GSYNC();
#if XSYNC > 0
        { int nx = XSYNC; asm volatile("" : "+s"(nx));
#pragma unroll 1
          for (int i = 0; i < nx; ++i) GSYNC(); }
#endif
        {
            KArgsP ka = kargs(); TIDS
#if REP_HA > 1
            int nha = REP_HA; asm volatile("" : "+s"(nha));
#pragma unroll 1
            for (int rha = 0; rha < nha; ++rha)
#endif
            if (ON(2)) { ALoads L;
                for (int item = bx; item < 4096; item += G) hgrn_a_item(lds, L, (const float*)ZP(Z_LOGF), (const bf16*)ZP(Z_VI), (bf16*)ka->out, (float*)(ka->ws + WS_PART), item, item + G < 4096 ? item + G : -1, tid); }
            if (ON(3)) qk_norm_pass((bf16*)ZP(Z_AQ), (bf16*)ZP(Z_AKV), ka->q_norm + l * 64, ka->k_norm + l * 64, gtid, NT);
        }
        GSYNC();
        {
            KArgsP ka = kargs(); TIDS
            if (ON(2)) hgrn_scan((bf16*)ka->out, (bf16*)ka->out, (const float*)(ka->ws + WS_PART), gtid, NT);
            if (ON(5)) for (int item = bx; item < 1024; item += G) attn_item(lds, (bf16*)ZP(Z_AQ), (bf16*)ZP(Z_AQ), (const bf16*)ZP(Z_AKV), ka->sinks + l * 16, item, tid);
        }
        GSYNC();
        {
            KArgsP ka = kargs(); TIDS
            if (ON(4)) { CLoads L;
                for (int item = bx; item < 4096; item += G) hgrn_c_item(lds, L, (const bf16*)ZP(Z_QF), (const float*)ZP(Z_LOGF), (const bf16*)ZP(Z_VI), (const bf16*)ka->out, (bf16*)ZP(Z_HGATE), (bf16*)ZP(Z_HGATE), ka->hg_norm + l * 128, item, item + G < 4096 ? item + G : -1, tid); }
        }
        GSYNC();
        if (ON(6)) {
            KArgsP ka = kargs();
            pg8::Gemm g{(const bf16*)ZP(Z_HGATE), WL(W_HG), MTOK, DM, HGW}; pg8::StaticOrder S; S.init(MTOK, DM, G, bx, REP_G23);
            pg8::EpiGate<0> E{(const bf16*)ZP(Z_GH), nullptr, (bf16*)ZP(Z_T1)};
            pg8::gemm_phase<pg8::EpiGate<0>, pg8::StaticOrder, PG_ALIGN, PG_SP2>(lds, g, S, E, MYTID());
        }
        if (ON(7)) {
            KArgsP ka = kargs();
            pg8::Gemm g{(const bf16*)ZP(Z_AQ), WL(W_AT), MTOK, DM, ATW}; pg8::StaticOrder S; S.init(MTOK, DM, G, bx, REP_G23);
            pg8::EpiGate<1> E{(const bf16*)ZP(Z_GA), (const bf16*)ZP(Z_T1), (bf16*)ZP(Z_MIX)};
            pg8::gemm_phase<pg8::EpiGate<1>, pg8::StaticOrder, PG_ALIGN, PG_SP2>(lds, g, S, E, MYTID());
        }
        GSYNC();
        if (ON(8)) {
            KArgsP ka = kargs();
            pg8::Gemm g{(const bf16*)ZP(Z_MIX), WL(W_OUT), MTOK, DM, DM}; pg8::StaticOrder S; S.init(MTOK, DM, G, bx, REP_G46);
            pg8::EpiRes E{(const bf16*)(ka->ws + WS_XB), nullptr, (bf16*)(ka->ws + WS_XB), (float*)(ka->ws + WS_PART)};
            pg8::gemm_phase<pg8::EpiRes, pg8::StaticOrder, PG_ALIGN, PG_SP2>(lds, g, S, E, MYTID());
        }
        GSYNC();
        { KArgsP ka = kargs(); TIDS rowstats_pass((const float*)(ka->ws + WS_PART), (float*)(ka->ws + WS_RS), gtid, NT); }
        GSYNC();
        if (ON(9)) {
            KArgsP ka = kargs();
            pg8::Gemm g{(const bf16*)(ka->ws + WS_XB), WL(W_UP), MTOK, DFF, DM}; pg8::StaticOrder S; S.init(MTOK, DFF, G, bx, REP_G5);
            pg8::EpiUp E{(const float*)(ka->ws + WS_RS), (bf16*)ZP(Z_U)};
            pg8::gemm_phase<pg8::EpiUp, pg8::StaticOrder, PG_ALIGN, PG_SP2>(lds, g, S, E, MYTID());
        }
        GSYNC();
        if (ON(10)) {
            KArgsP ka = kargs();
            pg8::Gemm g{(const bf16*)ZP(Z_U), WL(W_DN), MTOK, DM, DFF}; pg8::StaticOrder S; S.init(MTOK, DM, G, bx, REP_G46);
            pg8::EpiRes E{(const bf16*)(ka->ws + WS_XB), l == 0 ? nullptr : ka->out, (bf16*)(ka->ws + WS_XB), (float*)(ka->ws + WS_PART)};
            pg8::gemm_phase<pg8::EpiRes, pg8::StaticOrder, PG_ALIGN, PG_SP2>(lds, g, S, E, MYTID());
        }
        if (l == 0) { GSYNC(); { KArgsP ka = kargs(); TIDS rowstats_pass((const float*)(ka->ws + WS_PART), (float*)(ka->ws + WS_RS), gtid, NT); } GSYNC(); }
    }
}

extern "C" void kernel_launch(void* const* d_in, const int* in_sizes, int n_in, void* d_out, int out_size, void* d_ws, size_t ws_size, hipStream_t stream) {
    static int grid = 0;
    if (grid == 0) {
        if (n_in != 14 || out_size != MTOK * DM || ws_size < WS_END) { fprintf(stderr, "kernel_launch: unexpected shapes (n_in %d out %d ws %zu need %zu)\n", n_in, out_size, ws_size, (size_t)WS_END); grid = -1; return; }
        int dev = 0, cus = 0, per_cu = 0;
        (void)hipGetDevice(&dev); (void)hipDeviceGetAttribute(&cus, hipDeviceAttributeMultiprocessorCount, dev);
        if (hipFuncSetAttribute((const void*)fwd_mega, hipFuncAttributeMaxDynamicSharedMemorySize, LDS_BYTES) != hipSuccess) { fprintf(stderr, "hipFuncSetAttribute failed\n"); grid = -1; return; }
        if (hipOccupancyMaxActiveBlocksPerMultiprocessor(&per_cu, (const void*)fwd_mega, 512, LDS_BYTES) != hipSuccess || per_cu < 1) { fprintf(stderr, "occupancy query: %d\n", per_cu); per_cu = 1; }
        (void)hipGetLastError();
        grid = cus * 1;
    }
    if (grid < 0) return;
    (void)hipMemsetAsync((unsigned char*)d_ws + WS_BAR, 0, 16384, stream);
    Args a{};
    a.x = (const float*)d_in[0]; a.norm_mix = (const float*)d_in[1]; a.w_in = (const float*)d_in[2]; a.lb_logits = (const float*)d_in[3]; a.hg_norm = (const float*)d_in[4];
    a.q_norm = (const float*)d_in[5]; a.k_norm = (const float*)d_in[6]; a.sinks = (const float*)d_in[7]; a.w_hg_out = (const float*)d_in[8]; a.w_at_out = (const float*)d_in[9];
    a.w_out = (const float*)d_in[10]; a.norm_ffn = (const float*)d_in[11]; a.w_up = (const float*)d_in[12]; a.w_down = (const float*)d_in[13];
    a.out = (float*)d_out; a.ws = (unsigned char*)d_ws;
    void* args[] = {&a};
    hipError_t e = hipLaunchCooperativeKernel((const void*)fwd_mega, dim3(grid), dim3(512), args, LDS_BYTES, stream);
    if (e != hipSuccess) fprintf(stderr, "cooperative launch failed: %s (grid %d)\n", hipGetErrorString(e), grid);
}
```

```cpp
#include <hip/hip_runtime.h>
#include <hip/hip_cooperative_groups.h>
#include <cstdio>
#include <cstdint>
namespace cg = cooperative_groups;
namespace pg8 {
#define PG8_LAS __attribute__((address_space(3)))
typedef unsigned short bf16_t;
typedef short bf16x8 __attribute__((ext_vector_type(8)));
typedef float f32x4 __attribute__((ext_vector_type(4)));
typedef unsigned u32x4 __attribute__((ext_vector_type(4)));
constexpr int BM = 256, BK = 64, HALF = 128, HTB = HALF * BK * 2  , STAGE_BYTES = 8 * HTB, NXCD = 8;
#ifndef PG_WGM
#define PG_WGM 4
#endif
constexpr int WGM = PG_WGM;

__host__ __device__ __forceinline__ int lds_byte(int r, int c) { const int st = (r >> 4) * 2 + (c >> 5), rr = r & 15, cc = c & 31, ob = rr * 64 + cc * 2; return st * 1024 + (ob ^ (((ob >> 9) & 1) << 5)); }
__host__ __device__ __forceinline__ void stage_rc(int b, int& R, int& C) { const int st = b / 1024, sb = b % 1024, swz = sb ^ (((sb >> 9) & 1) << 5); R = (st >> 1) * 16 + swz / 64; C = (st & 1) * 32 + (swz % 64) / 2; }
__host__ __device__ __forceinline__ int perm32(int rho) { const int n = rho >> 4, i = rho & 15; return 8 * (i >> 2) + 4 * n + (i & 3); }

struct Unit { int pm, pn, pass, slot; };
struct Gemm { const bf16_t* A; const bf16_t* Bt; int M, N, K; const bf16_t* A2; const bf16_t* Bt2; };

struct StaticOrder {
    int nM, nN, nwg, G, c, rep;
    __host__ __device__ void init(int M, int N, int G_, int c_, int rep_ = 1) { nM = M / BM; nN = N / BM; nwg = nM * nN; G = G_; c = c_; rep = rep_; }
    __host__ __device__ bool next(int i, Unit& u) const {
        int L = i * G + c; if (L >= nwg * rep) return false; u.pass = 0; if (L >= nwg) { L -= nwg; u.pass = 1; }
        int wgid = (int)L; { const int q = nwg / NXCD, r = nwg % NXCD, xcd = wgid % NXCD, off = wgid / NXCD; wgid = (xcd < r ? xcd * (q + 1) : r * (q + 1) + (xcd - r) * q) + off; }
        const int nig = WGM * nN, gid = wgid / nig, fm = gid * WGM, gsz = (nM - fm) < WGM ? (nM - fm) : WGM;
        u.slot = gid - ((L % NXCD) * (nwg / NXCD)) / nig;
        u.pm = fm + ((wgid % nig) % gsz); u.pn = (wgid % nig) / gsz; return true;
    }
    __device__ __forceinline__ void a_ready(const Unit&) const {}
    __device__ __forceinline__ void done(const Unit&) const {}
};
struct OneOrder {
    int pm, pn;
    __host__ __device__ bool next(int i, Unit& u) const { if (i != 0) return false; u.pm = pm; u.pn = pn; u.pass = 0; u.slot = 0; return true; }
    __device__ __forceinline__ void a_ready(const Unit&) const {}
    __device__ __forceinline__ void done(const Unit&) const {}
};
struct DualOrder {
    StaticOrder b;
    __host__ __device__ bool next(int i, Unit& u) const { if (!b.next(i >> 1, u)) return false; u.pass = i & 1; return true; }
    __device__ __forceinline__ void a_ready(const Unit&) const {}
    __device__ __forceinline__ void done(const Unit&) const {}
};
__device__ __forceinline__ unsigned cvt_pk_bf16(float lo, float hi) { unsigned r; asm volatile("v_cvt_pk_bf16_f32 %0, %1, %2" : "=v"(r) : "v"(lo), "v"(hi)); return r; }
typedef float f32x2 __attribute__((ext_vector_type(2)));
template <class Epi, class Sched, bool ALIGN_EPI = false, bool SP2 = false, bool DUAL = false>
__device__ __forceinline__ void gemm_phase(PG8_LAS unsigned char* lds, const Gemm g, const Sched& S, const Epi& E, int tid_in) {
    int tid_ = tid_in; asm volatile("" : "+v"(tid_));
    const int tid = tid_, wid = __builtin_amdgcn_readfirstlane(tid >> 6), lane = tid & 63, wr = wid >> 2, wc = wid & 3, fr = lane & 15, fq = lane >> 4;
    const int K = g.K, nt = K / BK;
    unsigned voffA[2], voffB[2];
#pragma unroll
    for (int i = 0; i < 2; ++i) { int R, C; stage_rc(tid * 16 + i * 8192, R, C); const int Rb = Epi::PERM ? ((R & ~31) + perm32(R & 31)) : R;
        voffA[i] = (unsigned)(R * K + C) * 2u; voffB[i] = (unsigned)(Rb * K + C) * 2u; }
    const size_t kstep = (size_t)(BK * 2);
    const size_t hstep = (size_t)HALF * K * 2;
    const size_t tstep = 2 * hstep;
    const unsigned ldsw = (unsigned)wid * 1024u;
    const int aoff = lds_byte(wr * 64 + fr, fq * 8), boff = lds_byte(wc * 32 + fr, fq * 8);
#define PG8_SA(b, h) (((b) * 2 + (h)) * HTB)
#define PG8_SB(b, h) ((4 + (b) * 2 + (h)) * HTB)
#define PG8_STAGE(bufoff, gbase, voff) do { _Pragma("unroll") for (int _i = 0; _i < 2; ++_i) \
        __builtin_amdgcn_global_load_lds((const unsigned*)((const char*)(gbase) + (voff)[_i]), (PG8_LAS unsigned*)(lds + (bufoff) + ldsw + _i * 8192), 16, 0, 0); } while (0)
#define PG8_LDA(dst, b, h) do { _Pragma("unroll") for (int m = 0; m < 4; ++m) _Pragma("unroll") for (int k = 0; k < 2; ++k) dst[m][k] = *(const PG8_LAS bf16x8*)(lds + PG8_SA(b, h) + aoff + m * 2048 + k * 1024); } while (0)
#define PG8_LDB(dst, b, h) do { _Pragma("unroll") for (int n = 0; n < 2; ++n) _Pragma("unroll") for (int k = 0; k < 2; ++k) dst[n][k] = *(const PG8_LAS bf16x8*)(lds + PG8_SB(b, h) + boff + n * 2048 + k * 1024); } while (0)
#define PG8_MMA(ai, bj, At, Bt) do { __builtin_amdgcn_s_setprio(1); _Pragma("unroll") for (int m = 0; m < 4; ++m) _Pragma("unroll") for (int n = 0; n < 2; ++n) _Pragma("unroll") for (int k = 0; k < 2; ++k) \
        acc[ai][bj][m][n] = __builtin_amdgcn_mfma_f32_16x16x32_bf16(Bt[n][k], At[m][k], acc[ai][bj][m][n], 0, 0, 0); __builtin_amdgcn_s_setprio(0); } while (0)
#define PG8_WAIT_V(n) asm volatile("s_waitcnt vmcnt(" #n ")" ::: "memory")
#define PG8_WAIT_L(n) asm volatile("s_waitcnt lgkmcnt(" #n ")" ::: "memory")
#define PG8_BAR __builtin_amdgcn_s_barrier()
#define PG8_SCHED __builtin_amdgcn_sched_barrier(0)
    Unit cur, nxt; int ui = 0;
    if (!S.next(0, cur)) return;
    f32x4 acc[2][2][4][2];
#pragma unroll
    for (int a = 0; a < 2; ++a)
#pragma unroll
        for (int b = 0; b < 2; ++b)
#pragma unroll
            for (int m = 0; m < 4; ++m)
#pragma unroll
                for (int n = 0; n < 2; ++n) acc[a][b][m][n] = (f32x4){0.f, 0.f, 0.f, 0.f};
    bf16x8 At[4][2], B0[2][2], B1[2][2];
    const char* cA = (const char*)((DUAL && cur.pass) ? g.A2 : g.A) + (size_t)cur.pm * tstep; const char* cB = (const char*)((DUAL && cur.pass) ? g.Bt2 : g.Bt) + (size_t)cur.pn * tstep;
    S.a_ready(cur);
    if constexpr (SP2) {
        PG8_STAGE(PG8_SB(0, 0), cB, voffB); PG8_STAGE(PG8_SB(0, 1), cB + hstep, voffB); PG8_STAGE(PG8_SA(0, 0), cA, voffA); PG8_STAGE(PG8_SA(0, 1), cA + hstep, voffA);
        if (wr == 1) PG8_BAR;
        PG8_WAIT_V(2); PG8_BAR;
        PG8_STAGE(PG8_SB(1, 0), cB + kstep, voffB); PG8_STAGE(PG8_SA(1, 0), cA + kstep, voffA); PG8_STAGE(PG8_SB(1, 1), cB + hstep + kstep, voffB);
        PG8_WAIT_V(6); PG8_BAR;
    } else {
        PG8_STAGE(PG8_SB(0, 0), cB, voffB); PG8_STAGE(PG8_SA(0, 0), cA, voffA); PG8_STAGE(PG8_SB(0, 1), cB + hstep, voffB); PG8_STAGE(PG8_SA(0, 1), cA + hstep, voffA);
        if (wr == 1) PG8_BAR;
        PG8_WAIT_V(4); PG8_BAR;
        PG8_STAGE(PG8_SB(1, 0), cB + kstep, voffB); PG8_STAGE(PG8_SA(1, 0), cA + kstep, voffA); PG8_STAGE(PG8_SB(1, 1), cB + hstep + kstep, voffB);
        PG8_WAIT_V(6); PG8_BAR;
    }
    for (;;) {
        const bool has_next = S.next(ui + 1, nxt);
        const char* nA = has_next ? (const char*)((DUAL && nxt.pass) ? g.A2 : g.A) + (size_t)nxt.pm * tstep : cA; const char* nB = has_next ? (const char*)((DUAL && nxt.pass) ? g.Bt2 : g.Bt) + (size_t)nxt.pn * tstep : cB;
        for (int t = 0; t < nt; t += 2) {
            const bool last = (t == nt - 2);
            const char* a1 = cA + (size_t)(t + 1) * kstep;
            const char* a2 = last ? nA : cA + (size_t)(t + 2) * kstep; const char* b2 = last ? nB : cB + (size_t)(t + 2) * kstep;
            const char* a3 = a2 + kstep; const char* b3 = b2 + kstep;
            if (last && has_next) S.a_ready(nxt);
            if constexpr (SP2) {
            PG8_LDB(B0, 0, 0); PG8_LDB(B1, 0, 1); PG8_SCHED; PG8_LDA(At, 0, 0); PG8_STAGE(PG8_SA(1, 1), a1 + hstep, voffA);
            PG8_WAIT_V(8); PG8_WAIT_L(0); PG8_BAR; PG8_MMA(0, 0, At, B0); PG8_MMA(0, 1, At, B1); PG8_BAR; PG8_SCHED;
            PG8_LDA(At, 0, 1); PG8_STAGE(PG8_SB(0, 0), b2, voffB); PG8_STAGE(PG8_SB(0, 1), b2 + hstep, voffB); PG8_STAGE(PG8_SA(0, 0), a2, voffA);
            PG8_WAIT_V(8); PG8_WAIT_L(0); PG8_BAR; PG8_MMA(1, 0, At, B0); PG8_MMA(1, 1, At, B1); PG8_BAR; PG8_SCHED;
            PG8_LDB(B0, 1, 0); PG8_LDB(B1, 1, 1); PG8_SCHED; PG8_LDA(At, 1, 0); PG8_STAGE(PG8_SA(0, 1), a2 + hstep, voffA);
            PG8_WAIT_V(8); PG8_WAIT_L(0); PG8_BAR; PG8_MMA(0, 0, At, B0); PG8_MMA(0, 1, At, B1); PG8_BAR; PG8_SCHED;
            PG8_LDA(At, 1, 1); PG8_STAGE(PG8_SB(1, 0), b3, voffB); PG8_STAGE(PG8_SB(1, 1), b3 + hstep, voffB); PG8_STAGE(PG8_SA(1, 0), a3, voffA);
            PG8_WAIT_V(8); PG8_WAIT_L(0); PG8_BAR; PG8_MMA(1, 0, At, B0); PG8_MMA(1, 1, At, B1); PG8_BAR; PG8_SCHED;
            } else {
            PG8_LDB(B0, 0, 0); PG8_SCHED; PG8_LDA(At, 0, 0); PG8_STAGE(PG8_SA(1, 1), a1 + hstep, voffA);
            PG8_WAIT_L(8); PG8_BAR; PG8_WAIT_L(0); PG8_MMA(0, 0, At, B0); PG8_BAR; PG8_SCHED;
            PG8_LDB(B1, 0, 1); PG8_STAGE(PG8_SB(0, 0), b2, voffB);
            PG8_BAR; PG8_WAIT_L(0); PG8_MMA(0, 1, At, B1); PG8_BAR;
            PG8_LDA(At, 0, 1); PG8_STAGE(PG8_SA(0, 0), a2, voffA);
            PG8_BAR; PG8_WAIT_L(0); PG8_MMA(1, 0, At, B0); PG8_BAR; PG8_SCHED;
            PG8_STAGE(PG8_SB(0, 1), b2 + hstep, voffB);
            PG8_WAIT_V(6); PG8_BAR; PG8_MMA(1, 1, At, B1); PG8_BAR;
            PG8_LDB(B0, 1, 0); PG8_SCHED; PG8_LDA(At, 1, 0); PG8_STAGE(PG8_SA(0, 1), a2 + hstep, voffA);
            PG8_WAIT_L(8); PG8_BAR; PG8_WAIT_L(0); PG8_MMA(0, 0, At, B0); PG8_BAR; PG8_SCHED;
            PG8_LDB(B1, 1, 1); PG8_STAGE(PG8_SB(1, 0), b3, voffB);
            PG8_BAR; PG8_WAIT_L(0); PG8_MMA(0, 1, At, B1); PG8_BAR;
            PG8_LDA(At, 1, 1); PG8_STAGE(PG8_SA(1, 0), a3, voffA);
            PG8_BAR; PG8_WAIT_L(0); PG8_MMA(1, 0, At, B0); PG8_BAR; PG8_SCHED;
            PG8_STAGE(PG8_SB(1, 1), b3 + hstep, voffB);
            PG8_WAIT_V(6); PG8_BAR; PG8_MMA(1, 1, At, B1); PG8_BAR;
            }
        }
        if constexpr (ALIGN_EPI) { if (wr == 0) PG8_BAR; }
        if constexpr (DUAL) { if (cur.pass == 0) E.mid(acc, cur, wr, wc, fr, fq); else E(acc, cur, wr, wc, fr, fq); }
        else if constexpr (!Epi::AFTER_DRAIN) { E(acc, cur, wr, wc, fr, fq); S.done(cur); }
        if (!has_next) break;
        if (!(DUAL && cur.pass == 0))
#pragma unroll
        for (int a = 0; a < 2; ++a)
#pragma unroll
            for (int b = 0; b < 2; ++b)
#pragma unroll
                for (int m = 0; m < 4; ++m)
#pragma unroll
                    for (int n = 0; n < 2; ++n) acc[a][b][m][n] = (f32x4){0.f, 0.f, 0.f, 0.f};
        cur = nxt; cA = nA; cB = nB; ++ui;
        if constexpr (ALIGN_EPI) { if (wr == 1) PG8_BAR; }
    }
    PG8_WAIT_V(0);
    if constexpr (!ALIGN_EPI) { if (wr == 0) PG8_BAR; }
    PG8_BAR;
    if constexpr (Epi::AFTER_DRAIN) { E.fused(acc, cur, wr, wc, fr, fq, lds, wid, lane); S.done(cur); }
#undef PG8_SA
#undef PG8_SB
#undef PG8_STAGE
#undef PG8_LDA
#undef PG8_LDB
#undef PG8_MMA
#undef PG8_WAIT_V
#undef PG8_WAIT_L
#undef PG8_BAR
#undef PG8_SCHED
}
}

constexpr int BATCH = 2, SEQ = 16384, DM = 2048, MTOK = BATCH * SEQ;
constexpr int HGH = 8, HGD = 128, HGW = 1024;
constexpr int ATH = 16, ATD = 64, ATW = 1024, WIN = 128;
constexpr int DIN = 9472, DFF = 8192;
constexpr float EPSF = 1e-6f;

#define LAS __attribute__((address_space(3)))
typedef unsigned short bf16;
typedef float f32x4 __attribute__((ext_vector_type(4)));
typedef unsigned u32x4 __attribute__((ext_vector_type(4)));
typedef unsigned u32x2 __attribute__((ext_vector_type(2)));

__device__ __forceinline__ float sigm(float x) { return __builtin_amdgcn_rcpf(1.f + __expf(-x)); }
__device__ __forceinline__ float bflo(unsigned w) { return __uint_as_float(w << 16); }
__device__ __forceinline__ float bfhi(unsigned w) { return __uint_as_float(w & 0xffff0000u); }
typedef __bf16 bf16x2_t __attribute__((ext_vector_type(2)));
typedef float f32x2_t __attribute__((ext_vector_type(2)));
__device__ __forceinline__ unsigned pk2(float lo, float hi) { const f32x2_t v = {lo, hi}; const bf16x2_t b = __builtin_convertvector(v, bf16x2_t); return __builtin_bit_cast(unsigned, b); }

constexpr size_t WS_RS = 0;
constexpr size_t WS_LB = 131072;
constexpr size_t WS_BAR = 196608;
constexpr size_t WS_PART = 262144;
constexpr size_t WS_W = WS_PART + (size_t)MTOK * 32 * 4;
constexpr size_t W_IN = 0, W_HG = W_IN + (size_t)DIN * DM * 2, W_AT = W_HG + (size_t)DM * HGW * 2, W_OUT = W_AT + (size_t)DM * ATW * 2,
                 W_UP = W_OUT + (size_t)DM * DM * 2, W_DN = W_UP + (size_t)DFF * DM * 2, W_LAYER = W_DN + (size_t)DM * DFF * 2;
constexpr size_t WS_XB = WS_W + 2 * W_LAYER;
constexpr size_t WS_Z = WS_XB + (size_t)MTOK * DM * 2;
constexpr size_t Z_QF = 0, Z_LOGF = Z_QF + (size_t)MTOK * 1024 * 2, Z_VI = Z_LOGF + (size_t)MTOK * 1024 * 4, Z_HGATE = Z_VI + (size_t)MTOK * 1024 * 2,
                 Z_AQ = Z_HGATE + (size_t)MTOK * 1024 * 2, Z_AKV = Z_AQ + (size_t)MTOK * 1024 * 2, Z_GH = Z_AKV + (size_t)MTOK * 256 * 2,
                 Z_GA = Z_GH + (size_t)MTOK * 2048 * 2, Z_END = Z_GA + (size_t)MTOK * 2048 * 2;
constexpr size_t Z_T1 = 0, Z_MIX = (size_t)MTOK * 2048 * 2;
constexpr size_t Z_U = 0;
constexpr size_t WS_D = WS_Z + Z_LOGF + (size_t)MTOK * 1024 * 2;
constexpr size_t WS_END = WS_Z + Z_END;
static_assert(Z_MIX + (size_t)MTOK * 2048 * 2 <= Z_HGATE, "T1|MIX overlay");
static_assert((size_t)MTOK * DFF * 2 <= Z_END, "U overlay");
static_assert(WS_END <= 1073741824ull, "workspace");

constexpr int LDS_BYTES = 147456;
#ifndef PH
#define PH 0xFFFF
#endif
#define ON(k) ((PH >> (k)) & 1)
#ifndef REP_G1
#define REP_G1 1
#endif
#ifndef REP_G5
#define REP_G5 1
#endif
#ifndef REP_G23
#define REP_G23 1
#endif
#ifndef PG_ALIGN
#define PG_ALIGN true
#endif
#ifndef PG_SP2
#define PG_SP2 true
#endif
#ifndef REP_G46
#define REP_G46 1
#endif
#ifndef REP_MIX
#define REP_MIX 0
#endif
#ifndef SKEW_G1
#define SKEW_G1 0
#endif
#ifndef SKEW_G5
#define SKEW_G5 0
#endif
#ifndef NT_ST
#define NT_ST 0
#endif
#ifndef REP_P0
#define REP_P0 1
#endif
#ifndef XSYNC
#define XSYNC 0
#endif
#ifndef REP_HA
#define REP_HA 1
#endif

namespace pg8 {
__device__ __forceinline__ void st16(u32x4* p, u32x4 v) { if (NT_ST) __builtin_nontemporal_store(v, p); else *p = v; }
struct EpiIn {
    static constexpr bool PERM = true, AFTER_DRAIN = false;
    const PG8_LAS float* rsl; const float* lb; unsigned char* Z;
    __device__ __forceinline__ void operator()(const f32x4 (&acc)[2][2][4][2], const Unit& u, int wr, int wc, int fr, int fq) const {
        const int pn = u.pn; int kind, ld, tb; size_t zo;
        if (pn < 4)       { kind = 0; zo = Z_QF;    ld = 1024; tb = pn * 256; }
        else if (pn < 8)  { kind = 1; zo = Z_LOGF;  ld = 1024; tb = (pn - 4) * 256; }
        else if (pn < 12) { kind = 2; zo = Z_VI;    ld = 1024; tb = (pn - 8) * 256; }
        else if (pn < 16) { kind = 0; zo = Z_HGATE; ld = 1024; tb = (pn - 12) * 256; }
        else if (pn < 20) { kind = 2; zo = Z_AQ;    ld = 1024; tb = (pn - 16) * 256; }
        else if (pn == 20){ kind = 2; zo = Z_AKV;   ld = 256;  tb = 0; }
        else              { kind = 4; zo = Z_GH;    ld = 2048; tb = (pn - 21) * 128; }
        const int row0 = u.pm * BM + wr * 64 + fr, col0 = tb + wc * 32 + 8 * fq;
        if (kind == 4) {
            bf16_t* Rb = (bf16_t*)(Z + Z_GH); bf16_t* Ab = (bf16_t*)(Z + Z_GA);
#pragma unroll
            for (int ai = 0; ai < 2; ++ai)
#pragma unroll
                for (int m = 0; m < 4; ++m) { const int row = row0 + ai * HALF + m * 16; const float s = rsl[u.slot * 256 + (row - u.pm * BM)]; const size_t off = (size_t)row * 2048 + col0;
                    float rr[8], gg[8];
#pragma unroll
                    for (int n = 0; n < 2; ++n) { const f32x4 zh = acc[ai][0][m][n] * s, za = acc[ai][1][m][n] * s;
#pragma unroll
                        for (int e = 0; e < 4; ++e) { const float ea1 = 1.f + __expf(-fmaxf(za[e], -80.f)), sh = __builtin_amdgcn_rcpf(1.f + __expf(-zh[e])); rr[4 * n + e] = ea1 * sh; gg[4 * n + e] = __builtin_amdgcn_rcpf(ea1); } }
                    u32x4 w; w.x = cvt_pk_bf16(rr[0], rr[1]); w.y = cvt_pk_bf16(rr[2], rr[3]); w.z = cvt_pk_bf16(rr[4], rr[5]); w.w = cvt_pk_bf16(rr[6], rr[7]);
                    *(u32x4*)(Rb + off) = w;
                    w.x = cvt_pk_bf16(gg[0], gg[1]); w.y = cvt_pk_bf16(gg[2], gg[3]); w.z = cvt_pk_bf16(gg[4], gg[5]); w.w = cvt_pk_bf16(gg[6], gg[7]);
                    *(u32x4*)(Ab + off) = w; }
        } else if (kind == 1) {
            bf16_t* LOGF = (bf16_t*)(Z + zo);
            f32x4 lbv[2][2];
#pragma unroll
            for (int bj = 0; bj < 2; ++bj)
#pragma unroll
                for (int n = 0; n < 2; ++n) lbv[bj][n] = *(const f32x4*)(lb + col0 + bj * HALF + 4 * n);
#pragma unroll
            for (int ai = 0; ai < 2; ++ai)
#pragma unroll
                for (int m = 0; m < 4; ++m) { const int row = row0 + ai * HALF + m * 16; const float s = rsl[u.slot * 256 + (row - u.pm * BM)]; bf16_t* rp = LOGF + (size_t)row * 1024 + col0;
#pragma unroll
                    for (int bj = 0; bj < 2; ++bj) { f32x4 o[2];
#pragma unroll
                        for (int n = 0; n < 2; ++n) { const f32x4 v = acc[ai][bj][m][n] * s;
#pragma unroll
                            for (int e = 0; e < 4; ++e) { const float l = lbv[bj][n][e]; o[n][e] = __logf(fmaxf(l + (1.f - l) * sigm(v[e]), 1e-30f)); } }
                        u32x4 w; w.x = cvt_pk_bf16(o[0][0], o[0][1]); w.y = cvt_pk_bf16(o[0][2], o[0][3]); w.z = cvt_pk_bf16(o[1][0], o[1][1]); w.w = cvt_pk_bf16(o[1][2], o[1][3]);
                        st16((u32x4*)(rp + bj * HALF), w); } }
        } else {
            bf16_t* dst = (bf16_t*)(Z + zo);
#pragma unroll
            for (int ai = 0; ai < 2; ++ai)
#pragma unroll
                for (int m = 0; m < 4; ++m) { const int row = row0 + ai * HALF + m * 16; const float s = rsl[u.slot * 256 + (row - u.pm * BM)]; bf16_t* rp = dst + (size_t)row * ld + col0;
#pragma unroll
                    for (int bj = 0; bj < 2; ++bj) { f32x4 v0 = acc[ai][bj][m][0] * s, v1 = acc[ai][bj][m][1] * s;
                        if (kind == 0) {
#pragma unroll
                            for (int e = 0; e < 4; ++e) { v0[e] = v0[e] * sigm(v0[e]); v1[e] = v1[e] * sigm(v1[e]); }
                        }
                        u32x4 w; w.x = cvt_pk_bf16(v0[0], v0[1]); w.y = cvt_pk_bf16(v0[2], v0[3]); w.z = cvt_pk_bf16(v1[0], v1[1]); w.w = cvt_pk_bf16(v1[2], v1[3]);
                        st16((u32x4*)(rp + bj * HALF), w); } }
        }
    }
};
struct EpiMix {
    static constexpr bool PERM = true, AFTER_DRAIN = false;
    const bf16_t* gh; const bf16_t* ga; bf16_t* dst;
    __device__ __forceinline__ void mid(f32x4 (&acc)[2][2][4][2], const Unit& u, int wr, int wc, int fr, int fq) const {
        const int row0 = u.pm * BM + wr * 64 + fr, col0 = u.pn * BM + wc * 32 + 8 * fq;
#pragma unroll
        for (int ai = 0; ai < 2; ++ai)
#pragma unroll
            for (int m = 0; m < 4; ++m) { const size_t off = (size_t)(row0 + ai * HALF + m * 16) * 2048 + col0;
#pragma unroll
                for (int bj = 0; bj < 2; ++bj) { const u32x4 g = *(const u32x4*)(gh + off + bj * HALF);
                    acc[ai][bj][m][0][0] *= bflo(g.x); acc[ai][bj][m][0][1] *= bfhi(g.x); acc[ai][bj][m][0][2] *= bflo(g.y); acc[ai][bj][m][0][3] *= bfhi(g.y);
                    acc[ai][bj][m][1][0] *= bflo(g.z); acc[ai][bj][m][1][1] *= bfhi(g.z); acc[ai][bj][m][1][2] *= bflo(g.w); acc[ai][bj][m][1][3] *= bfhi(g.w); } }
    }
    __device__ __forceinline__ void operator()(const f32x4 (&acc)[2][2][4][2], const Unit& u, int wr, int wc, int fr, int fq) const {
        const int row0 = u.pm * BM + wr * 64 + fr, col0 = u.pn * BM + wc * 32 + 8 * fq;
#pragma unroll
        for (int ai = 0; ai < 2; ++ai)
#pragma unroll
            for (int m = 0; m < 4; ++m) { const size_t off = (size_t)(row0 + ai * HALF + m * 16) * 2048 + col0;
#pragma unroll
                for (int bj = 0; bj < 2; ++bj) { const u32x4 a = *(const u32x4*)(ga + off + bj * HALF);
                    f32x4 v0 = acc[ai][bj][m][0], v1 = acc[ai][bj][m][1];
                    v0[0] *= bflo(a.x); v0[1] *= bfhi(a.x); v0[2] *= bflo(a.y); v0[3] *= bfhi(a.y); v1[0] *= bflo(a.z); v1[1] *= bfhi(a.z); v1[2] *= bflo(a.w); v1[3] *= bfhi(a.w);
                    u32x4 w; w.x = cvt_pk_bf16(v0[0], v0[1]); w.y = cvt_pk_bf16(v0[2], v0[3]); w.z = cvt_pk_bf16(v1[0], v1[1]); w.w = cvt_pk_bf16(v1[2], v1[3]);
                    *(u32x4*)(dst + off + bj * HALF) = w; } }
    }
};
struct EpiRes {
    static constexpr bool PERM = true, AFTER_DRAIN = false;
    const bf16_t* resid; float* outf; bf16_t* xb; float* part;
    __device__ __forceinline__ void operator()(const f32x4 (&acc)[2][2][4][2], const Unit& u, int wr, int wc, int fr, int fq) const {
        if (REP_G46 > 1 && u.pass == 0) return;
        const int row0 = u.pm * BM + wr * 64 + fr, col0 = u.pn * BM + wc * 32 + 8 * fq;
#pragma unroll
        for (int ai = 0; ai < 2; ++ai)
#pragma unroll
            for (int m = 0; m < 4; ++m) { const int row = row0 + ai * HALF + m * 16; const size_t off = (size_t)row * 2048 + col0; float ss = 0.f;
#pragma unroll
                for (int bj = 0; bj < 2; ++bj) { const u32x4 rw = *(const u32x4*)(resid + off + bj * HALF);
                    f32x4 o0 = acc[ai][bj][m][0], o1 = acc[ai][bj][m][1];
                    o0[0] += bflo(rw.x); o0[1] += bfhi(rw.x); o0[2] += bflo(rw.y); o0[3] += bfhi(rw.y); o1[0] += bflo(rw.z); o1[1] += bfhi(rw.z); o1[2] += bflo(rw.w); o1[3] += bfhi(rw.w);
                    if (outf) { *(f32x4*)(outf + off + bj * HALF) = o0; *(f32x4*)(outf + off + bj * HALF + 4) = o1; }
                    else { ss += (o0[0] * o0[0] + o0[1] * o0[1]) + (o0[2] * o0[2] + o0[3] * o0[3]) + (o1[0] * o1[0] + o1[1] * o1[1]) + (o1[2] * o1[2] + o1[3] * o1[3]);
                        u32x4 w; w.x = cvt_pk_bf16(o0[0], o0[1]); w.y = cvt_pk_bf16(o0[2], o0[3]); w.z = cvt_pk_bf16(o1[0], o1[1]); w.w = cvt_pk_bf16(o1[2], o1[3]);
                        *(u32x4*)(xb + off + bj * HALF) = w; } }
                if (!outf) { ss += __shfl_xor(ss, 16); ss += __shfl_xor(ss, 32); if (fq == 0) part[(size_t)row * 32 + u.pn * 4 + wc] = ss; } }
    }
};
struct EpiUp {
    static constexpr bool PERM = true, AFTER_DRAIN = false;
    const PG8_LAS float* rsl; bf16_t* dst;
    __device__ __forceinline__ void operator()(const f32x4 (&acc)[2][2][4][2], const Unit& u, int wr, int wc, int fr, int fq) const {
        const int row0 = u.pm * BM + wr * 64 + fr, col0 = u.pn * BM + wc * 32 + 8 * fq;
#pragma unroll
        for (int ai = 0; ai < 2; ++ai)
#pragma unroll
            for (int m = 0; m < 4; ++m) { const int row = row0 + ai * HALF + m * 16; const float s = rsl[u.slot * 256 + (row - u.pm * BM)]; bf16_t* rp = dst + (size_t)row * DFF + col0;
#pragma unroll
                for (int bj = 0; bj < 2; ++bj) { f32x4 v0 = acc[ai][bj][m][0] * s, v1 = acc[ai][bj][m][1] * s;
#pragma unroll
                    for (int e = 0; e < 4; ++e) { const float a = fmaxf(v0[e], 0.f), b = fmaxf(v1[e], 0.f); v0[e] = a * a; v1[e] = b * b; }
                    u32x4 w; w.x = cvt_pk_bf16(v0[0], v0[1]); w.y = cvt_pk_bf16(v0[2], v0[3]); w.z = cvt_pk_bf16(v1[0], v1[1]); w.w = cvt_pk_bf16(v1[2], v1[3]);
                    st16((u32x4*)(rp + bj * HALF), w); } }
    }
};
}

__device__ __forceinline__ float wave_sum(float v) {
#pragma unroll
    for (int o = 1; o < 64; o <<= 1) v += __shfl_xor(v, o);
    return v;
}
__device__ __forceinline__ int gate_row_remap(int n0) {
    constexpr int G0 = 5376, G1 = 7424;
    if (n0 < G0) return n0;
    if (n0 < G1) { const int q = n0 - G0; return G0 + 256 * (q / 128) + (q % 128); }
    const int q = n0 - G1; return G0 + 256 * (q / 128) + 128 + (q % 128);
}
__device__ __forceinline__ void transpose_item(const float* __restrict__ W, const float* __restrict__ gain, int K, int N, bf16* __restrict__ WT, LAS float* scr, int item, int lane, bool remap = false) {
    const int nblk = N / 32, kb = item / nblk, nb = item % nblk, k0 = 64 * kb, n0 = 32 * nb, nd0 = remap ? gate_row_remap(n0) : n0;
    float wv[32];
#pragma unroll
    for (int i = 0; i < 32; ++i) { const int kk = 2 * i + (lane >> 5); wv[i] = W[(size_t)(k0 + kk) * N + n0 + (lane & 31)]; }
    const float g0 = gain ? gain[k0 + (lane & 63)] : 1.f;
#pragma unroll
    for (int i = 0; i < 32; ++i) { const int kk = 2 * i + (lane >> 5); const float g = __shfl(g0, kk); scr[kk * 33 + (lane & 31)] = wv[i] * g; }
    asm volatile("s_waitcnt lgkmcnt(0)" ::: "memory");
    const int c = lane & 7;
#pragma unroll
    for (int j = 0; j < 4; ++j) { const int n = (lane >> 3) + 8 * j; const LAS float* s = scr + (8 * c) * 33 + n;
        u32x4 o; o.x = pk2(s[0 * 33], s[1 * 33]); o.y = pk2(s[2 * 33], s[3 * 33]); o.z = pk2(s[4 * 33], s[5 * 33]); o.w = pk2(s[6 * 33], s[7 * 33]);
        *(u32x4*)(WT + (size_t)(nd0 + n) * K + k0 + 8 * c) = o; }
    asm volatile("s_waitcnt lgkmcnt(0)" ::: "memory");
}

struct Args {
    const float *x, *norm_mix, *w_in, *lb_logits, *hg_norm, *q_norm, *k_norm, *sinks, *w_hg_out, *w_at_out, *w_out, *norm_ffn, *w_up, *w_down;
    float* out; unsigned char* ws;
};

__device__ __forceinline__ u32x4 headnorm8(u32x4 w, f32x4 g0, f32x4 g1, float scale) {
    float v[8] = {bflo(w.x), bfhi(w.x), bflo(w.y), bfhi(w.y), bflo(w.z), bfhi(w.z), bflo(w.w), bfhi(w.w)};
    float ss = 0.f;
#pragma unroll
    for (int e = 0; e < 8; ++e) ss += v[e] * v[e];
    ss += __shfl_xor(ss, 1); ss += __shfl_xor(ss, 2); ss += __shfl_xor(ss, 4);
    const float r = rsqrtf(ss * (1.f / 64.f) + EPSF) * scale;
    u32x4 o; o.x = pk2(v[0] * r * g0[0], v[1] * r * g0[1]); o.y = pk2(v[2] * r * g0[2], v[3] * r * g0[3]); o.z = pk2(v[4] * r * g1[0], v[5] * r * g1[1]); o.w = pk2(v[6] * r * g1[2], v[7] * r * g1[3]);
    return o;
}
typedef short bf16x8 __attribute__((ext_vector_type(8)));
typedef float f32x2 __attribute__((ext_vector_type(2)));
#define MFMA16(a, b, c) __builtin_amdgcn_mfma_f32_16x16x32_bf16((a), (b), (c), 0, 0, 0)
constexpr int HL_CUM = 0, HL_ABUF = 0, HL_TOT = 32768, HL_REF = 34816, HL_QT = 35840, HL_KST = HL_QT, HL_KT = HL_QT + 17408, HL_QO = HL_KT + 17408,
              HL_VT = HL_QO + 17408, HL_ST = HL_VT + 18432, HL_SS = HL_ST + 34816, HL_END = HL_SS + 512;
static_assert(HL_END <= LDS_BYTES, "HGRN2 LDS map");
struct Prep { float cum[16]; float lf[16]; float ref, last; };
struct ALoads { float lf[16]; unsigned vv[16]; };
struct CLoads { ALoads a; u32x4 st[4]; u32x4 lfR[2]; u32x4 qR[2]; u32x2 hg[4]; f32x4 hnv[4]; };
__device__ __forceinline__ void hg_issue1(ALoads& L, const bf16* __restrict__ LOGF, const bf16* __restrict__ VI, int item, int tid) {
    const int h = item & 7, k = tid & 127, seg = tid >> 7; const size_t tok0 = (size_t)(item >> 3) * 64;
    const bf16* lp = LOGF + (tok0 + 16 * seg) * 1024 + h * 128 + k;
    const bf16* vp = VI + (tok0 + 16 * seg) * 1024 + h * 128 + k;
#pragma unroll
    for (int i = 0; i < 16; ++i) { L.lf[i] = __uint_as_float((unsigned)lp[i * 1024] << 16); L.vv[i] = vp[i * 1024]; }
}
__device__ __forceinline__ void hg_step1(LAS unsigned char* lds, const ALoads& L, int tid, Prep& P) {
    const int k = tid & 127, seg = tid >> 7;
    float run = 0.f;
#pragma unroll
    for (int i = 0; i < 16; ++i) { P.lf[i] = L.lf[i]; run += L.lf[i]; P.cum[i] = run; }
    LAS float* TOT = (LAS float*)(lds + HL_TOT);
    TOT[seg * 128 + k] = run;
    u32x4 w0, w1;
    w0.x = L.vv[0] | (L.vv[1] << 16); w0.y = L.vv[2] | (L.vv[3] << 16); w0.z = L.vv[4] | (L.vv[5] << 16); w0.w = L.vv[6] | (L.vv[7] << 16);
    w1.x = L.vv[8] | (L.vv[9] << 16); w1.y = L.vv[10] | (L.vv[11] << 16); w1.z = L.vv[12] | (L.vv[13] << 16); w1.w = L.vv[14] | (L.vv[15] << 16);
    *(LAS u32x4*)(lds + HL_VT + (k * 72 + 16 * seg) * 2) = w0; *(LAS u32x4*)(lds + HL_VT + (k * 72 + 16 * seg) * 2 + 16) = w1;
    __syncthreads();
    const float t0 = TOT[k], t1 = TOT[128 + k], t2 = TOT[256 + k], t3 = TOT[384 + k];
    const float off = seg == 0 ? 0.f : seg == 1 ? t0 : seg == 2 ? t0 + t1 : (t0 + t1) + t2;
#pragma unroll
    for (int i = 0; i < 16; ++i) P.cum[i] += off;
    P.ref = t0 + t1; P.last = (t0 + t1) + (t2 + t3);
}
__device__ __forceinline__ void hgrn_a_item(LAS unsigned char* lds, ALoads& L, const bf16* __restrict__ LOGF, const bf16* __restrict__ VI, bf16* __restrict__ UT, float* __restrict__ D, int item, int next, int tid) {
    (void)next; hg_issue1(L, LOGF, VI, item, tid);
    Prep P; hg_step1(lds, L, tid, P);
    const int k = tid & 127, seg = tid >> 7;
    unsigned pk[8];
#pragma unroll
    for (int i = 0; i < 8; ++i) { const float a = (1.f - __expf(P.lf[2 * i])) * __expf(P.last - P.cum[2 * i]), b = (1.f - __expf(P.lf[2 * i + 1])) * __expf(P.last - P.cum[2 * i + 1]); pk[i] = pk2(a, b); }
    *(LAS u32x4*)(lds + HL_KST + (k * 72 + 16 * seg) * 2) = (u32x4){pk[0], pk[1], pk[2], pk[3]};
    *(LAS u32x4*)(lds + HL_KST + (k * 72 + 16 * seg) * 2 + 16) = (u32x4){pk[4], pk[5], pk[6], pk[7]};
    if (seg == 0) D[(size_t)item * 128 + k] = __expf(P.last);
    __syncthreads();
    const int lane = tid & 63, w = tid >> 6, r = lane & 15, q = lane >> 4;
    bf16x8 af[2];
#pragma unroll
    for (int ks = 0; ks < 2; ++ks) af[ks] = *(const LAS bf16x8*)(lds + HL_KST + ((16 * w + r) * 72 + 32 * ks + 8 * q) * 2);
    bf16* ut = UT + (size_t)item * 16384;
#pragma unroll
    for (int nt = 0; nt < 8; ++nt) { f32x4 acc = {0.f, 0.f, 0.f, 0.f};
#pragma unroll
        for (int ks = 0; ks < 2; ++ks) { const bf16x8 bfr = *(const LAS bf16x8*)(lds + HL_VT + ((16 * nt + r) * 72 + 32 * ks + 8 * q) * 2); acc = MFMA16(af[ks], bfr, acc); }
        u32x2 o; o.x = pk2(acc[0], acc[1]); o.y = pk2(acc[2], acc[3]);
        *(u32x2*)(ut + (16 * nt + r) * 128 + 16 * w + 4 * q) = o; }
    __syncthreads();
}
__device__ __forceinline__ void hgrn_scan(bf16* UT, bf16* SDST, const float* __restrict__ D, int gtid, int NT) {
    for (int e = gtid; e < 16 * 8192; e += NT) {
        const int bh = e >> 13, off = (e & 8191) * 2, b = bh >> 3, h = bh & 7, k = off & 127;
        unsigned* up = (unsigned*)(UT + ((size_t)(b * 256) * 8 + h) * 16384 + off);
        unsigned* sp = (unsigned*)(SDST + ((size_t)(b * 256) * 8 + h) * 16384 + off);
        const float* dp = D + ((size_t)(b * 256) * 8 + h) * 128 + k;
        float s0 = 0.f, s1 = 0.f;
        for (int n = 0; n < 256; n += 16) {
            unsigned u[16]; f32x2 d[16];
#pragma unroll
            for (int j = 0; j < 16; ++j) { u[j] = up[(size_t)(n + j) * 65536]; d[j] = *(const f32x2*)(dp + (size_t)(n + j) * 1024); }
#pragma unroll
            for (int j = 0; j < 16; ++j) { sp[(size_t)(n + j) * 65536] = pk2(s0, s1); s0 = d[j].x * s0 + bflo(u[j]); s1 = d[j].y * s1 + bfhi(u[j]); }
        }
    }
}
__device__ __forceinline__ void hgc_issue_st(CLoads& L, const bf16* __restrict__ ST, int item, int tid) {
    const u32x4* sg = (const u32x4*)(ST + (size_t)item * 16384);
#pragma unroll
    for (int j = 0; j < 4; ++j) L.st[j] = sg[tid + 512 * j];
}
__device__ __forceinline__ void hgc_issue_r(CLoads& L, const bf16* __restrict__ QF, const bf16* __restrict__ LOGF, int item, int tid) {
    const int h = item & 7, t = tid >> 3, k0 = 16 * (tid & 7); const size_t go = ((size_t)(item >> 3) * 64 + t) * 1024 + h * 128 + k0;
    L.lfR[0] = *(const u32x4*)(LOGF + go); L.lfR[1] = *(const u32x4*)(LOGF + go + 8);
    L.qR[0] = *(const u32x4*)(QF + go); L.qR[1] = *(const u32x4*)(QF + go + 8);
}
__device__ __forceinline__ void hgc_issue_hg(CLoads& L, const bf16* HGATE, const float* __restrict__ hn, int item, int tid) {
    const int h = item & 7, lane = tid & 63, w = tid >> 6, r = lane & 15, q = lane >> 4, nt = w & 3, vh = w >> 2;
    const bf16* hp = HGATE + ((size_t)(item >> 3) * 64 + 16 * nt + r) * 1024 + h * 128;
#pragma unroll
    for (int j = 0; j < 4; ++j) { L.hg[j] = *(const u32x2*)(hp + 16 * (4 * vh + j) + 4 * q); L.hnv[j] = *(const f32x4*)(hn + 16 * (4 * vh + j) + 4 * q); }
}
__device__ __forceinline__ void hgrn_c_item(LAS unsigned char* lds, CLoads& L, const bf16* __restrict__ QF, const bf16* __restrict__ LOGF, const bf16* __restrict__ VI, const bf16* __restrict__ ST,
                                            bf16* HGATE, bf16* HDST, const float* __restrict__ hn, int item, int next, int tid) {
    const int h = item & 7; const size_t tok0 = (size_t)(item >> 3) * 64;
    hgc_issue_hg(L, HGATE, hn, item, tid);
    Prep P; hg_step1(lds, L.a, tid, P);
    if (next >= 0) hg_issue1(L.a, LOGF, VI, next, tid);
    {
        const int k = tid & 127, seg = tid >> 7;
        LAS float* CUM = (LAS float*)(lds + HL_CUM);
#pragma unroll
        for (int i = 0; i < 16; ++i) CUM[(16 * seg + i) * 128 + k] = P.cum[i];
        if (seg == 0) ((LAS float*)(lds + HL_REF))[k] = P.ref;
#pragma unroll
        for (int j = 0; j < 4; ++j) { const int idx = tid + 512 * j, v = idx >> 4, c = idx & 15; *(LAS u32x4*)(lds + HL_ST + (v * 136 + c * 8) * 2) = L.st[j]; }
        if (next >= 0) hgc_issue_st(L, ST, next, tid);
    }
    __syncthreads();
    {
        const int t = tid >> 3, k0 = 16 * (tid & 7);
        f32x4 cm[4], rf[4];
#pragma unroll
        for (int j = 0; j < 4; ++j) { cm[j] = *(const LAS f32x4*)(lds + HL_CUM + (t * 128 + k0 + 4 * j) * 4); rf[j] = *(const LAS f32x4*)(lds + HL_REF + (k0 + 4 * j) * 4); }
        unsigned pq[8], pkk[8], po[8];
#pragma unroll
        for (int j = 0; j < 8; ++j) {
            const unsigned qw = L.qR[j >> 2][j & 3]; const float q0 = bflo(qw), q1 = bfhi(qw);
            const int e0 = 2 * j, e1 = 2 * j + 1;
            const float c0 = cm[e0 >> 2][e0 & 3], c1 = cm[e1 >> 2][e1 & 3], r0 = rf[e0 >> 2][e0 & 3], r1 = rf[e1 >> 2][e1 & 3];
            const unsigned lw = L.lfR[j >> 2][j & 3]; const float kf0 = 1.f - __expf(bflo(lw)), kf1 = 1.f - __expf(bfhi(lw));
            pq[j] = pk2(q0 * __expf(c0 - r0), q1 * __expf(c1 - r1));
            pkk[j] = pk2(kf0 * __expf(r0 - c0), kf1 * __expf(r1 - c1));
            po[j] = pk2(q0 * __expf(c0), q1 * __expf(c1));
        }
        if (next >= 0) hgc_issue_r(L, QF, LOGF, next, tid);
        const int lo = (t * 136 + k0) * 2;
        *(LAS u32x4*)(lds + HL_QT + lo) = (u32x4){pq[0], pq[1], pq[2], pq[3]}; *(LAS u32x4*)(lds + HL_QT + lo + 16) = (u32x4){pq[4], pq[5], pq[6], pq[7]};
        *(LAS u32x4*)(lds + HL_KT + lo) = (u32x4){pkk[0], pkk[1], pkk[2], pkk[3]}; *(LAS u32x4*)(lds + HL_KT + lo + 16) = (u32x4){pkk[4], pkk[5], pkk[6], pkk[7]};
        *(LAS u32x4*)(lds + HL_QO + lo) = (u32x4){po[0], po[1], po[2], po[3]}; *(LAS u32x4*)(lds + HL_QO + lo + 16) = (u32x4){po[4], po[5], po[6], po[7]};
    }
    __syncthreads();
    const int lane = tid & 63, w = tid >> 6, r = lane & 15, q = lane >> 4, nt = w & 3, vh = w >> 2;
    {
#pragma unroll
        for (int mm = 0; mm < 2; ++mm) { const int mt = vh * 2 + mm; f32x4 acc = {0.f, 0.f, 0.f, 0.f};
            if (mt <= nt) {
#pragma unroll
                for (int ks = 0; ks < 4; ++ks) { const bf16x8 a = *(const LAS bf16x8*)(lds + HL_KT + ((16 * mt + r) * 136 + 32 * ks + 8 * q) * 2), b = *(const LAS bf16x8*)(lds + HL_QT + ((16 * nt + r) * 136 + 32 * ks + 8 * q) * 2);
                    acc = MFMA16(a, b, acc); } }
            const int c = 16 * nt + r, s0 = 16 * mt + 4 * q;
            const float a0 = (mt <= nt && s0 + 0 <= c) ? acc[0] : 0.f, a1 = (mt <= nt && s0 + 1 <= c) ? acc[1] : 0.f, a2 = (mt <= nt && s0 + 2 <= c) ? acc[2] : 0.f, a3 = (mt <= nt && s0 + 3 <= c) ? acc[3] : 0.f;
            u32x2 o; o.x = pk2(a0, a1); o.y = pk2(a2, a3);
            *(LAS u32x2*)(lds + HL_ABUF + (c * 72 + s0) * 2) = o; }
    }
    __syncthreads();
    {
        bf16x8 bA[2], bQ[4];
#pragma unroll
        for (int ks = 0; ks < 2; ++ks) bA[ks] = *(const LAS bf16x8*)(lds + HL_ABUF + ((16 * nt + r) * 72 + 32 * ks + 8 * q) * 2);
#pragma unroll
        for (int ks = 0; ks < 4; ++ks) bQ[ks] = *(const LAS bf16x8*)(lds + HL_QO + ((16 * nt + r) * 136 + 32 * ks + 8 * q) * 2);
        f32x4 acc[4]; float ss = 0.f;
#pragma unroll
        for (int j = 0; j < 4; ++j) { const int vt = 4 * vh + j; acc[j] = (f32x4){0.f, 0.f, 0.f, 0.f};
#pragma unroll
            for (int ks = 0; ks < 2; ++ks) { const bf16x8 a = *(const LAS bf16x8*)(lds + HL_VT + ((16 * vt + r) * 72 + 32 * ks + 8 * q) * 2); acc[j] = MFMA16(a, bA[ks], acc[j]); }
#pragma unroll
            for (int ks = 0; ks < 4; ++ks) { const bf16x8 a = *(const LAS bf16x8*)(lds + HL_ST + ((16 * vt + r) * 136 + 32 * ks + 8 * q) * 2); acc[j] = MFMA16(a, bQ[ks], acc[j]); }
            ss += (acc[j][0] * acc[j][0] + acc[j][1] * acc[j][1]) + (acc[j][2] * acc[j][2] + acc[j][3] * acc[j][3]); }
        ss += __shfl_xor(ss, 16); ss += __shfl_xor(ss, 32);
        LAS float* SS = (LAS float*)(lds + HL_SS);
        if (q == 0) SS[vh * 64 + 16 * nt + r] = ss;
        __syncthreads();
        const float rr = rsqrtf((SS[16 * nt + r] + SS[64 + 16 * nt + r]) * (1.f / 128.f) + EPSF);
        bf16* hp = HGATE + (tok0 + 16 * nt + r) * 1024 + h * 128;
#pragma unroll
        for (int j = 0; j < 4; ++j) { const int vb = 16 * (4 * vh + j) + 4 * q; const f32x4 g = L.hnv[j]; const u32x2 hg = L.hg[j];
            u32x2 o; o.x = pk2(acc[j][0] * rr * g[0] * bflo(hg.x), acc[j][1] * rr * g[1] * bfhi(hg.x)); o.y = pk2(acc[j][2] * rr * g[2] * bflo(hg.y), acc[j][3] * rr * g[3] * bfhi(hg.y));
            *(u32x2*)(HDST + (hp - HGATE) + vb) = o; }
    }
    __syncthreads();
}

constexpr int AL_K = 0, AL_VT = 208 * 144, AL_END = AL_VT + 64 * 432;
static_assert(AL_END <= LDS_BYTES, "attention LDS map");
__device__ __forceinline__ void attn_item(LAS unsigned char* lds, bf16* AQ, bf16* ODST, const bf16* __restrict__ AKV, const float* __restrict__ sinks, const float* __restrict__ qn, const float* __restrict__ kn, int item, int tid) {
    const int b = item >> 9, kvh = (item >> 8) & 1, qb = item & 255, t0 = qb * 64;
    const size_t tokb = (size_t)b * SEQ;
    const int lane = tid & 63, w = tid >> 6, r = lane & 15, quad = lane >> 4, h = kvh * 8 + w;
    bf16* qbase = AQ + (tokb + t0) * 1024 + h * 64;
    u32x4 qnx[2];
#pragma unroll
    for (int ks = 0; ks < 2; ++ks) qnx[ks] = *(const u32x4*)(qbase + (size_t)r * 1024 + 32 * ks + 8 * quad);
    {
        const f32x4 kg0 = *(const f32x4*)(kn + (tid & 7) * 8), kg1 = *(const f32x4*)(kn + (tid & 7) * 8 + 4);
        u32x4 kv[3];
#pragma unroll
        for (int j = 0; j < 3; ++j) { const int idx = tid + 512 * j, key = idx >> 3, c = idx & 7, s = t0 - 128 + key; kv[j] = (u32x4){0u, 0u, 0u, 0u};
            if (s >= 0) kv[j] = *(const u32x4*)(AKV + (tokb + s) * 256 + kvh * 64 + c * 8); }
#pragma unroll
        for (int j = 0; j < 3; ++j) { const int idx = tid + 512 * j, key = idx >> 3, c = idx & 7;
            *(LAS u32x4*)(lds + AL_K + (key * 72 + c * 8) * 2) = headnorm8(kv[j], kg0, kg1, 1.f); }
    }
    {
        const int d = tid & 63, kseg = tid >> 6; unsigned vv[24];
#pragma unroll
        for (int i = 0; i < 24; ++i) { const int s = t0 - 128 + 24 * kseg + i; vv[i] = s >= 0 ? (unsigned)AKV[(tokb + s) * 256 + 128 + kvh * 64 + d] : 0u; }
#pragma unroll
        for (int j = 0; j < 3; ++j) { u32x4 w; w.x = vv[8 * j] | (vv[8 * j + 1] << 16); w.y = vv[8 * j + 2] | (vv[8 * j + 3] << 16); w.z = vv[8 * j + 4] | (vv[8 * j + 5] << 16); w.w = vv[8 * j + 6] | (vv[8 * j + 7] << 16);
            *(LAS u32x4*)(lds + AL_VT + (d * 216 + 24 * kseg + 8 * j) * 2) = w; }
        if (kseg == 0) { *(LAS u32x4*)(lds + AL_VT + (d * 216 + 192) * 2) = (u32x4){0u, 0u, 0u, 0u}; *(LAS u32x4*)(lds + AL_VT + (d * 216 + 200) * 2) = (u32x4){0u, 0u, 0u, 0u}; }
    }
    __syncthreads();
    const float L2E = 1.44269504f, slope2 = exp2f(-0.5f * (float)(h + 1)) * L2E, sink2 = sinks[h] * L2E;
    const int m0 = r - 4 * quad;
    const float nb = -slope2 * (float)(128 + m0);
    float bias[9][4];
#pragma unroll
    for (int a = 0; a < 9; ++a)
#pragma unroll
        for (int i = 0; i < 4; ++i) bias[a][i] = fmaf(slope2, (float)(16 * a + i), nb);
#pragma unroll
    for (int i = 0; i < 4; ++i) { if (!(i > m0)) bias[0][i] = -INFINITY; if (!(i <= m0)) bias[8][i] = -INFINITY; }
    f32x4 qg[2][2];
#pragma unroll
    for (int ks = 0; ks < 2; ++ks) { qg[ks][0] = *(const f32x4*)(qn + 32 * ks + 8 * quad); qg[ks][1] = *(const f32x4*)(qn + 32 * ks + 8 * quad + 4); }
#pragma unroll 1
    for (int qt = 0; qt < 4; ++qt) {
        bf16x8 qf[2];
        {
            u32x4 qw[2]; float qv[2][8]; float ss = 0.f;
#pragma unroll
            for (int ks = 0; ks < 2; ++ks) qw[ks] = qnx[ks];
            if (qt < 3) {
#pragma unroll
                for (int ks = 0; ks < 2; ++ks) qnx[ks] = *(const u32x4*)(qbase + (size_t)(16 * (qt + 1) + r) * 1024 + 32 * ks + 8 * quad); }
#pragma unroll
            for (int ks = 0; ks < 2; ++ks) {
                qv[ks][0] = bflo(qw[ks].x); qv[ks][1] = bfhi(qw[ks].x); qv[ks][2] = bflo(qw[ks].y); qv[ks][3] = bfhi(qw[ks].y); qv[ks][4] = bflo(qw[ks].z); qv[ks][5] = bfhi(qw[ks].z); qv[ks][6] = bflo(qw[ks].w); qv[ks][7] = bfhi(qw[ks].w);
#pragma unroll
                for (int e = 0; e < 8; ++e) ss += qv[ks][e] * qv[ks][e]; }
            ss += __shfl_xor(ss, 16); ss += __shfl_xor(ss, 32);
            const float rq = rsqrtf(ss * (1.f / 64.f) + EPSF) * (0.125f * L2E);
#pragma unroll
            for (int ks = 0; ks < 2; ++ks) { const f32x4 g0 = qg[ks][0], g1 = qg[ks][1];
                const u32x4 pw = {pk2(qv[ks][0] * rq * g0[0], qv[ks][1] * rq * g0[1]), pk2(qv[ks][2] * rq * g0[2], qv[ks][3] * rq * g0[3]), pk2(qv[ks][4] * rq * g1[0], qv[ks][5] * rq * g1[1]), pk2(qv[ks][6] * rq * g1[2], qv[ks][7] * rq * g1[3])};
                qf[ks] = __builtin_bit_cast(bf16x8, pw); }
        }
        f32x4 s[9];
#pragma unroll
        for (int a = 0; a < 9; ++a) { s[a] = (f32x4){0.f, 0.f, 0.f, 0.f};
#pragma unroll
            for (int ks = 0; ks < 2; ++ks) { const bf16x8 kf = *(const LAS bf16x8*)(lds + AL_K + ((16 * (qt + a) + r) * 72 + 32 * ks + 8 * quad) * 2); s[a] = MFMA16(kf, qf[ks], s[a]); } }
        const int iq = 16 * qt + r;
#pragma unroll
        for (int a = 0; a < 9; ++a)
#pragma unroll
            for (int i = 0; i < 4; ++i) s[a][i] += bias[a][i];
        if (t0 < 128) {
            const int jmin = 128 - t0;
#pragma unroll
            for (int a = 0; a < 9; ++a)
#pragma unroll
                for (int i = 0; i < 4; ++i) if (16 * (qt + a) + 4 * quad + i < jmin) s[a][i] = -INFINITY;
        }
        float mx = sink2;
#pragma unroll
        for (int a = 0; a < 9; ++a) mx = fmaxf(fmaxf(mx, fmaxf(s[a][0], s[a][1])), fmaxf(s[a][2], s[a][3]));
        mx = fmaxf(mx, __shfl_xor(mx, 16)); mx = fmaxf(mx, __shfl_xor(mx, 32));
        float sum = 0.f;
#pragma unroll
        for (int a = 0; a < 9; ++a)
#pragma unroll
            for (int i = 0; i < 4; ++i) { const float p = __builtin_amdgcn_exp2f(s[a][i] - mx); s[a][i] = p; sum += p; }
        sum += __shfl_xor(sum, 16); sum += __shfl_xor(sum, 32); sum += __builtin_amdgcn_exp2f(sink2 - mx);
        const float inv = 1.f / sum;
        f32x4 o[4];
#pragma unroll
        for (int dt = 0; dt < 4; ++dt) o[dt] = (f32x4){0.f, 0.f, 0.f, 0.f};
#pragma unroll
        for (int kp = 0; kp < 5; ++kp) {
            u32x4 pw = {pk2(s[2 * kp][0], s[2 * kp][1]), pk2(s[2 * kp][2], s[2 * kp][3]), 0u, 0u};
            if (kp < 4) { pw.z = pk2(s[(2 * kp + 1) % 9][0], s[(2 * kp + 1) % 9][1]); pw.w = pk2(s[(2 * kp + 1) % 9][2], s[(2 * kp + 1) % 9][3]); }
            const bf16x8 pb = __builtin_bit_cast(bf16x8, pw);
#pragma unroll
            for (int dt = 0; dt < 4; ++dt) {
                const u32x2 lo = *(const LAS u32x2*)(lds + AL_VT + ((16 * dt + r) * 216 + 16 * (qt + 2 * kp) + 4 * quad) * 2);
                u32x4 vw = {lo.x, lo.y, 0u, 0u};
                if (kp < 4) { const u32x2 hi = *(const LAS u32x2*)(lds + AL_VT + ((16 * dt + r) * 216 + 16 * (qt + 2 * kp + 1) + 4 * quad) * 2); vw.z = hi.x; vw.w = hi.y; }
                o[dt] = MFMA16(__builtin_bit_cast(bf16x8, vw), pb, o[dt]); }
        }
#pragma unroll
        for (int dt = 0; dt < 4; ++dt) { u32x2 wv; wv.x = pk2(o[dt][0] * inv, o[dt][1] * inv); wv.y = pk2(o[dt][2] * inv, o[dt][3] * inv);
            *(u32x2*)(ODST + (qbase - AQ) + (size_t)iq * 1024 + 16 * dt + 4 * quad) = wv; }
    }
    __syncthreads();
}

constexpr int RSL_OFF = 132096;
template <bool FROM_PART>
__device__ __forceinline__ void fill_rs_table(LAS unsigned char* lds, const pg8::StaticOrder& S, const float* __restrict__ src, int tid) {
    int p0 = 0, p1 = 0, p2 = 0, p3 = 0;
    if (S.G == 256 && (S.nwg % (8 * pg8::WGM * S.nN)) == 0) {
        const int xcd = S.c % 8, j = S.c / 8, nig = pg8::WGM * S.nN, gid0 = (xcd * (S.nwg / 8)) / nig, b = j % pg8::WGM;
        p0 = gid0 * pg8::WGM + b; p1 = p0 + pg8::WGM; p2 = p1 + pg8::WGM; p3 = p2 + pg8::WGM;
    } else { pg8::Unit u; for (int i = 0; S.next(i, u); ++i) { if (u.slot == 0) p0 = u.pm; else if (u.slot == 1) p1 = u.pm; else if (u.slot == 2) p2 = u.pm; else p3 = u.pm; } }
    LAS float* T = (LAS float*)(lds + RSL_OFF);
    for (int e = tid; e < 1024; e += 512) { const int slot = e >> 8, t = e & 255; int pm = slot == 0 ? p0 : slot == 1 ? p1 : slot == 2 ? p2 : p3; pm = pm < MTOK / 256 ? pm : 0; const int row = pm * 256 + t;
        float v;
        if (FROM_PART) { const f32x4* p = (const f32x4*)(src + (size_t)row * 32); float s = 0.f;
#pragma unroll
            for (int jj = 0; jj < 8; ++jj) { const f32x4 w = p[jj]; s += (w[0] + w[1]) + (w[2] + w[3]); }
            v = rsqrtf(s * (1.f / DM) + EPSF); }
        else v = src[row];
        T[e] = v; }
    __syncthreads();
}

template <bool FROM_PART>
__device__ __forceinline__ void fill_rs_one(LAS unsigned char* lds, int pm, const float* __restrict__ src, int tid) {
    LAS float* T = (LAS float*)(lds + RSL_OFF);
    if (tid < 256) { const int row = pm * 256 + tid; float v;
        if (FROM_PART) { const f32x4* p = (const f32x4*)(src + (size_t)row * 32); float s = 0.f;
#pragma unroll
            for (int jj = 0; jj < 8; ++jj) { const f32x4 w = p[jj]; s += (w[0] + w[1]) + (w[2] + w[3]); }
            v = rsqrtf(s * (1.f / DM) + EPSF); }
        else v = src[row];
        T[tid] = v; }
    __syncthreads();
}
#define XB_TMO      128
#define XB_XCNT(j)  (256  + 64 * (j))
#define XB_XSUB(j)  (1280 + 64 * (j))
#define XB_XGEN(j)  (2304 + 64 * (j))
#define XB_TOP      3328
#define XB_TOPGEN   3392
#define XCD_BAR_WORDS 3456
#define XB_SPIN_CAP (1u << 18)

__device__ __forceinline__ unsigned xb_ld(unsigned* p)              { return __hip_atomic_load(p, __ATOMIC_RELAXED, __HIP_MEMORY_SCOPE_AGENT); }
__device__ __forceinline__ unsigned xb_add(unsigned* p, unsigned v) { return __hip_atomic_fetch_add(p, v, __ATOMIC_RELAXED, __HIP_MEMORY_SCOPE_AGENT); }
__device__ __forceinline__ unsigned xb_xcc_id() { return (unsigned)__builtin_amdgcn_s_getreg((3 << 11) | 20) & 0xFu; }
#define XB_SPIN(cond, bar) do { unsigned _sp = 0; while (cond) { __builtin_amdgcn_s_sleep(1); \
    if ((++_sp & 255u) == 0u) { if (xb_ld(&(bar)[XB_TMO])) break; if (_sp > XB_SPIN_CAP) { atomicAdd(&(bar)[XB_TMO], 1u); break; } } } } while (0)

struct XcdBarrier {
    unsigned* bar; unsigned x;
    volatile LAS unsigned* st;
};

__device__ __forceinline__ XcdBarrier xcd_barrier_post(unsigned* bar, volatile LAS unsigned* st) {
    XcdBarrier b; b.bar = bar; b.x = xb_xcc_id(); b.st = st;
    if (threadIdx.x == 0) (void)xb_add(&bar[XB_XCNT(b.x)], 1u);
    return b;
}
__device__ __forceinline__ void xcd_barrier_complete(unsigned* bar, unsigned x, unsigned& nloc, unsigned& nx) {
    const unsigned G = gridDim.x * gridDim.y * gridDim.z;
    unsigned sum, cnt, mine, sp = 0u;
    for (;;) {
        sum = 0u; cnt = 0u; mine = 0u;
#pragma unroll
        for (unsigned j = 0; j < 16; ++j) { const unsigned c = xb_ld(&bar[XB_XCNT(j)]); sum += c; cnt += (c > 0u) ? 1u : 0u; mine = (j == x) ? c : mine; }
        if (sum == G) break;
        __builtin_amdgcn_s_sleep(1);
        if ((++sp & 255u) == 0u) { if (xb_ld(&bar[XB_TMO])) break; if (sp > XB_SPIN_CAP) { atomicAdd(&bar[XB_TMO], 1u); break; } }
    }
    nloc = mine > 0u ? mine : 1u; nx = cnt > 0u ? cnt : 1u;
}

__device__ __forceinline__ void xcd_barrier(const XcdBarrier& b, bool leader) {
    asm volatile("s_waitcnt vmcnt(0)" ::: "memory");
    __syncthreads();
    if (leader) {
        unsigned* bar = b.bar;
        __builtin_amdgcn_s_waitcnt(0);
        unsigned nloc = b.st[0], nx = b.st[1];
        if (nloc == 0u) { xcd_barrier_complete(bar, b.x, nloc, nx); b.st[0] = nloc; b.st[1] = nx; }
        const unsigned old = xb_add(&bar[XB_XSUB(b.x)], 1u);
        const unsigned gen = old / nloc;
        if (old + 1u == (gen + 1u) * nloc) {
            __builtin_amdgcn_fence(__ATOMIC_RELEASE, "agent");
            asm volatile("s_waitcnt vmcnt(0)" ::: "memory");
            const unsigned og = xb_add(&bar[XB_TOP], 1u);
            const unsigned tg = og / nx;
            if (og + 1u == (tg + 1u) * nx) xb_add(&bar[XB_TOPGEN], 1u);
            else XB_SPIN(xb_ld(&bar[XB_TOPGEN]) == tg, bar);
            __builtin_amdgcn_fence(__ATOMIC_ACQUIRE, "agent");
            xb_add(&bar[XB_XGEN(b.x)], 1u);
            asm volatile("s_waitcnt vmcnt(0)" ::: "memory");
        } else {
            XB_SPIN(xb_ld(&bar[XB_XGEN(b.x)]) == gen, bar);
            __builtin_amdgcn_fence(__ATOMIC_ACQUIRE, "agent");
            asm volatile("s_waitcnt vmcnt(0)" ::: "memory");
        }
    }
    __syncthreads();
}

constexpr int MISC_OFF = LDS_BYTES - 256;
static_assert(MISC_OFF >= 141824 && MISC_OFF >= 131072, "LDS control words above every phase's LDS map");
typedef const Args __attribute__((address_space(4)))* KArgsP;
__device__ __forceinline__ KArgsP kargs() { KArgsP p = (KArgsP)__builtin_amdgcn_kernarg_segment_ptr(); asm volatile("" : "+s"(p)); return p; }
#define ZP(off) (ka->ws + WS_Z + (off))
#define WL(off) ((const bf16*)(ka->ws + WS_W + (size_t)l * W_LAYER + (off)))
__global__ void __launch_bounds__(512, 2) fwd_mega(Args a_unused) {
    extern __shared__ __attribute__((aligned(16))) unsigned char lds_raw[];
    LAS unsigned char* lds = (LAS unsigned char*)lds_raw;
    cg::grid_group grid = cg::this_grid();
    const int G = gridDim.x, bx = blockIdx.x;
    const int wave_s = __builtin_amdgcn_readfirstlane((int)threadIdx.x >> 6);
#define MYTID() ((wave_s << 6) | (int)__builtin_amdgcn_mbcnt_hi(~0u, __builtin_amdgcn_mbcnt_lo(~0u, 0u)))
    if (threadIdx.x < 2) ((volatile LAS unsigned*)(lds + MISC_OFF))[threadIdx.x] = 0u;
    __syncthreads();
    { KArgsP ka = kargs(); (void)xcd_barrier_post((unsigned*)(ka->ws + WS_BAR), (volatile LAS unsigned*)(lds + MISC_OFF)); }
#define GSYNC() do { KArgsP ka_ = kargs(); XcdBarrier b_; b_.bar = (unsigned*)(ka_->ws + WS_BAR); b_.x = xb_xcc_id(); b_.st = (volatile LAS unsigned*)(lds + MISC_OFF); xcd_barrier(b_, MYTID() == 0); } while (0)
#define TIDS int tid_ = MYTID(); asm volatile("" : "+v"(tid_)); const int tid = tid_, lane = tid & 63, wave = __builtin_amdgcn_readfirstlane(tid >> 6), gw = bx * 8 + wave, NGW = G * 8, gtid = bx * 512 + tid, NT = G * 512; (void)lane; (void)gw; (void)NGW; (void)gtid; (void)NT;

#if REP_P0 > 1
    int np0 = REP_P0; asm volatile("" : "+s"(np0));
#pragma unroll 1
    for (int rep0 = 0; rep0 < np0; ++rep0)
#endif
    {
        KArgsP ka = kargs(); TIDS
        unsigned char* ws = ka->ws; float* RS = (float*)(ws + WS_RS); float* LB = (float*)(ws + WS_LB); bf16* XB = (bf16*)(ws + WS_XB);
        LAS float* scr = (LAS float*)(lds + wave * 16384);
        constexpr int I_IN = (DM / 64) * (DIN / 32), I_HG = (HGW / 64) * (DM / 32), I_AT = (ATW / 64) * (DM / 32), I_OUT = (DM / 64) * (DM / 32), I_UP = (DM / 64) * (DFF / 32), I_DN = (DFF / 64) * (DM / 32);
        constexpr int I_LAYER = I_IN + I_HG + I_AT + I_OUT + I_UP + I_DN;
        for (int it = gw; it < 2 * I_LAYER; it += NGW) {
            const int l = it >= I_LAYER ? 1 : 0; int r = it - l * I_LAYER; unsigned char* wl = ws + WS_W + (size_t)l * W_LAYER;
            if (r < I_IN) { transpose_item(ka->w_in + (size_t)l * DM * DIN, ka->norm_mix + l * DM, DM, DIN, (bf16*)(wl + W_IN), scr, r, lane, true); continue; } r -= I_IN;
            if (r < I_HG) { transpose_item(ka->w_hg_out + (size_t)l * HGW * DM, nullptr, HGW, DM, (bf16*)(wl + W_HG), scr, r, lane); continue; } r -= I_HG;
            if (r < I_AT) { transpose_item(ka->w_at_out + (size_t)l * ATW * DM, nullptr, ATW, DM, (bf16*)(wl + W_AT), scr, r, lane); continue; } r -= I_AT;
            if (r < I_OUT) { transpose_item(ka->w_out + (size_t)l * DM * DM, nullptr, DM, DM, (bf16*)(wl + W_OUT), scr, r, lane); continue; } r -= I_OUT;
            if (r < I_UP) { transpose_item(ka->w_up + (size_t)l * DM * DFF, ka->norm_ffn + l * DM, DM, DFF, (bf16*)(wl + W_UP), scr, r, lane); continue; } r -= I_UP;
            transpose_item(ka->w_down + (size_t)l * DFF * DM, nullptr, DFF, DM, (bf16*)(wl + W_DN), scr, r, lane);
        }
        for (int c = gtid; c < 1024; c += NT) { LB[c] = 0.f; LB[1024 + c] = sigm(ka->lb_logits[1024 + c] - ka->lb_logits[c]); }
        const float* x = ka->x;
        for (int m = gw; m < MTOK; m += NGW) {
            const f32x4* xr = (const f32x4*)(x + (size_t)m * DM) + lane; f32x4 v[8]; float s = 0.f;
#pragma unroll
            for (int j = 0; j < 8; ++j) { v[j] = xr[64 * j]; s += (v[j][0] * v[j][0] + v[j][1] * v[j][1]) + (v[j][2] * v[j][2] + v[j][3] * v[j][3]); }
            s = wave_sum(s);
            if (lane == 0) RS[m] = rsqrtf(s * (1.f / DM) + EPSF);
            u32x2* o8 = (u32x2*)(XB + (size_t)m * DM) + lane;
#pragma unroll
            for (int j = 0; j < 8; ++j) { u32x2 w; w.x = pk2(v[j][0], v[j][1]); w.y = pk2(v[j][2], v[j][3]); o8[64 * j] = w; }
        }
    }
    { KArgsP ka = kargs(); if (ka->ws == nullptr) grid.sync(); }
    GSYNC();

    for (int l = 0; l < 2; ++l) {
        if (ON(1)) {
            KArgsP ka = kargs();
            pg8::Gemm g{(const bf16*)(ka->ws + WS_XB), WL(W_IN), MTOK, DIN, DM}; pg8::StaticOrder S; S.init(MTOK, DIN - 256, G, bx, REP_G1);
            { TIDS if (l == 0) fill_rs_table<false>(lds, S, (const float*)(ka->ws + WS_RS), tid); else fill_rs_table<true>(lds, S, (const float*)(ka->ws + WS_PART), tid); }
            pg8::EpiIn E{(const LAS float*)(lds + RSL_OFF), (const float*)(ka->ws + WS_LB) + l * 1024, ka->ws + WS_Z};
            if (SKEW_G1 > 0 && bx >= G / 2) { const unsigned long long t0 = __builtin_amdgcn_s_memrealtime(); while (__builtin_amdgcn_s_memrealtime() - t0 < (unsigned long long)SKEW_G1) __builtin_amdgcn_s_sleep(32); }
            pg8::gemm_phase<pg8::EpiIn, pg8::StaticOrder, PG_ALIGN, PG_SP2>(lds, g, S, E, MYTID());
        }
        GSYNC();
#if XSYNC > 0
        { int nx = XSYNC; asm volatile("" : "+s"(nx));
#pragma unroll 1
          for (int i = 0; i < nx; ++i) GSYNC(); }
#endif
        {
            KArgsP ka = kargs(); TIDS
#if REP_HA > 1
            int nha = REP_HA; asm volatile("" : "+s"(nha));
#pragma unroll 1
            for (int rha = 0; rha < nha; ++rha)
#endif
            if (ON(2)) { ALoads L;
                for (int item = bx; item < 4096; item += G) hgrn_a_item(lds, L, (const bf16*)ZP(Z_LOGF), (const bf16*)ZP(Z_VI), (bf16*)ka->out, (float*)(ka->ws + WS_D), item, item + G < 4096 ? item + G : -1, tid); }
        }
        GSYNC();
        if (ON(2)) { KArgsP ka = kargs(); TIDS hgrn_scan((bf16*)ka->out, (bf16*)ka->out, (const float*)(ka->ws + WS_D), gtid, NT); }
        if (ON(5)) {
            KArgsP ka = kargs();
#define G1_LAST_PANEL(PM) do { pg8::Gemm g{(const bf16*)(ka->ws + WS_XB), WL(W_IN), MTOK, DIN, DM}; pg8::OneOrder S1{(PM), DIN / 256 - 1}; \
                if (l == 0) fill_rs_one<false>(lds, (PM), (const float*)(ka->ws + WS_RS), MYTID()); else fill_rs_one<true>(lds, (PM), (const float*)(ka->ws + WS_PART), MYTID()); \
                pg8::EpiIn E{(const LAS float*)(lds + RSL_OFF), (const float*)(ka->ws + WS_LB) + l * 1024, ka->ws + WS_Z}; \
                pg8::gemm_phase<pg8::EpiIn, pg8::OneOrder, PG_ALIGN, PG_SP2>(lds, g, S1, E, MYTID()); __syncthreads(); } while (0)
            if (G == 256) { if (bx >= 128) G1_LAST_PANEL(bx - 128); }
            else for (int pmx = bx; pmx < MTOK / 256; pmx += G) G1_LAST_PANEL(pmx);
        }
        {
            KArgsP ka = kargs(); TIDS
#define ATT(ITEM) attn_item(lds, (bf16*)ZP(Z_AQ), (bf16*)ZP(Z_AQ), (const bf16*)ZP(Z_AKV), ka->sinks + l * 16, ka->q_norm + l * 64, ka->k_norm + l * 64, (ITEM), tid)
            if (ON(5)) {
                if (G == 256) {
                    if (bx >= 128) {
#pragma unroll 1
                        for (int k = 0; k < 2; ++k) ATT(768 + 128 * k + (bx - 128)); }
                    else {
#pragma unroll 1
                        for (int k = 0; k < 6; ++k) ATT(bx + 128 * k); }
                } else for (int item = bx; item < 1024; item += G) ATT(item);
            }
        }
        GSYNC();
        {
            KArgsP ka = kargs(); TIDS
            if (ON(4)) { CLoads L;
#define HGC_RUN(DST) do { { const int it0 = bx & 4095; hg_issue1(L.a, (const bf16*)ZP(Z_LOGF), (const bf16*)ZP(Z_VI), it0, tid); hgc_issue_st(L, (const bf16*)ka->out, it0, tid); hgc_issue_r(L, (const bf16*)ZP(Z_QF), (const bf16*)ZP(Z_LOGF), it0, tid); } \
                for (int item = bx; item < 4096; item += G) hgrn_c_item(lds, L, (const bf16*)ZP(Z_QF), (const bf16*)ZP(Z_LOGF), (const bf16*)ZP(Z_VI), (const bf16*)ka->out, (bf16*)ZP(Z_HGATE), (DST), ka->hg_norm + l * 128, item, item + G < 4096 ? item + G : -1, tid); } while (0)
#if REP_MIX & 4
                for (int rr_ = 0; rr_ < 4; ++rr_) if (l == 0) HGC_RUN((bf16*)ka->out + (size_t)MTOK * 2048);
#endif
                HGC_RUN((bf16*)ZP(Z_HGATE)); }
        }
        GSYNC();
        if (ON(6)) {
            KArgsP ka = kargs();
            pg8::Gemm g{(const bf16*)ZP(Z_HGATE), WL(W_HG), MTOK, DM, HGW, (const bf16*)ZP(Z_AQ), WL(W_AT)}; pg8::DualOrder S; S.b.init(MTOK, DM, G, bx, 1);
            pg8::EpiMix E{(const bf16*)ZP(Z_GH), (const bf16*)ZP(Z_GA), (bf16*)ZP(Z_MIX)};
            pg8::gemm_phase<pg8::EpiMix, pg8::DualOrder, PG_ALIGN, PG_SP2, true>(lds, g, S, E, MYTID());
        }
        GSYNC();
        if (ON(8)) {
            KArgsP ka = kargs();
            pg8::Gemm g{(const bf16*)ZP(Z_MIX), WL(W_OUT), MTOK, DM, DM}; pg8::StaticOrder S; S.init(MTOK, DM, G, bx, REP_G46);
            pg8::EpiRes E{(const bf16*)(ka->ws + WS_XB), nullptr, (bf16*)(ka->ws + WS_XB), (float*)(ka->ws + WS_PART)};
            pg8::gemm_phase<pg8::EpiRes, pg8::StaticOrder, PG_ALIGN, PG_SP2>(lds, g, S, E, MYTID());
        }
        GSYNC();
        if (ON(9)) {
            KArgsP ka = kargs();
            pg8::Gemm g{(const bf16*)(ka->ws + WS_XB), WL(W_UP), MTOK, DFF, DM}; pg8::StaticOrder S; S.init(MTOK, DFF, G, bx, REP_G5);
            { TIDS fill_rs_table<true>(lds, S, (const float*)(ka->ws + WS_PART), tid); }
            pg8::EpiUp E{(const LAS float*)(lds + RSL_OFF), (bf16*)ZP(Z_U)};
            if (SKEW_G5 > 0 && bx >= G / 2) { const unsigned long long t0 = __builtin_amdgcn_s_memrealtime(); while (__builtin_amdgcn_s_memrealtime() - t0 < (unsigned long long)SKEW_G5) __builtin_amdgcn_s_sleep(32); }
            pg8::gemm_phase<pg8::EpiUp, pg8::StaticOrder, PG_ALIGN, PG_SP2>(lds, g, S, E, MYTID());
        }
        GSYNC();
        if (ON(10)) {
            KArgsP ka = kargs();
            pg8::Gemm g{(const bf16*)ZP(Z_U), WL(W_DN), MTOK, DM, DFF}; pg8::StaticOrder S; S.init(MTOK, DM, G, bx, REP_G46);
            pg8::EpiRes E{(const bf16*)(ka->ws + WS_XB), l == 0 ? nullptr : ka->out, (bf16*)(ka->ws + WS_XB), (float*)(ka->ws + WS_PART)};
            pg8::gemm_phase<pg8::EpiRes, pg8::StaticOrder, PG_ALIGN, PG_SP2>(lds, g, S, E, MYTID());
        }
        if (l == 0) GSYNC();
    }
}

extern "C" void kernel_launch(void* const* d_in, const int* in_sizes, int n_in, void* d_out, int out_size, void* d_ws, size_t ws_size, hipStream_t stream) {
    static int grid = 0;
    if (grid == 0) {
        if (n_in != 14 || out_size != MTOK * DM || ws_size < WS_END) { fprintf(stderr, "kernel_launch: unexpected shapes (n_in %d out %d ws %zu need %zu)\n", n_in, out_size, ws_size, (size_t)WS_END); grid = -1; return; }
        int dev = 0, cus = 0, per_cu = 0;
        (void)hipGetDevice(&dev); (void)hipDeviceGetAttribute(&cus, hipDeviceAttributeMultiprocessorCount, dev);
        if (hipFuncSetAttribute((const void*)fwd_mega, hipFuncAttributeMaxDynamicSharedMemorySize, LDS_BYTES) != hipSuccess) { fprintf(stderr, "hipFuncSetAttribute failed\n"); grid = -1; return; }
        if (hipOccupancyMaxActiveBlocksPerMultiprocessor(&per_cu, (const void*)fwd_mega, 512, LDS_BYTES) != hipSuccess || per_cu < 1) { fprintf(stderr, "occupancy query: %d\n", per_cu); per_cu = 1; }
        (void)hipGetLastError();
        grid = cus * 1;
    }
    if (grid < 0) return;
    (void)hipMemsetAsync((unsigned char*)d_ws + WS_BAR, 0, 16384, stream);
    Args a{};
    a.x = (const float*)d_in[0]; a.norm_mix = (const float*)d_in[1]; a.w_in = (const float*)d_in[2]; a.lb_logits = (const float*)d_in[3]; a.hg_norm = (const float*)d_in[4];
    a.q_norm = (const float*)d_in[5]; a.k_norm = (const float*)d_in[6]; a.sinks = (const float*)d_in[7]; a.w_hg_out = (const float*)d_in[8]; a.w_at_out = (const float*)d_in[9];
    a.w_out = (const float*)d_in[10]; a.norm_ffn = (const float*)d_in[11]; a.w_up = (const float*)d_in[12]; a.w_down = (const float*)d_in[13];
    a.out = (float*)d_out; a.ws = (unsigned char*)d_ws;
    void* args[] = {&a};
    hipError_t e = hipLaunchCooperativeKernel((const void*)fwd_mega, dim3(grid), dim3(512), args, LDS_BYTES, stream);
    if (e != hipSuccess) fprintf(stderr, "cooperative launch failed: %s (grid %d)\n", hipGetErrorString(e), grid);
}
```

```cpp
#include <hip/hip_runtime.h>
#include <hip/hip_cooperative_groups.h>
#include <cstdio>
#include <cstdint>
namespace cg = cooperative_groups;
namespace pg8 {
#define PG8_LAS __attribute__((address_space(3)))
typedef unsigned short bf16_t;
typedef short bf16x8 __attribute__((ext_vector_type(8)));
typedef float f32x4 __attribute__((ext_vector_type(4)));
typedef unsigned u32x4 __attribute__((ext_vector_type(4)));
constexpr int BM = 256, BK = 64, HALF = 128, HTB = HALF * BK * 2  , STAGE_BYTES = 8 * HTB, NXCD = 8;
#ifndef PG_WGM
#define PG_WGM 4
#endif
constexpr int WGM = PG_WGM;

__host__ __device__ __forceinline__ int lds_byte(int r, int c) { const int st = (r >> 4) * 2 + (c >> 5), rr = r & 15, cc = c & 31, ob = rr * 64 + cc * 2; return st * 1024 + (ob ^ (((ob >> 9) & 1) << 5)); }
__host__ __device__ __forceinline__ void stage_rc(int b, int& R, int& C) { const int st = b / 1024, sb = b % 1024, swz = sb ^ (((sb >> 9) & 1) << 5); R = (st >> 1) * 16 + swz / 64; C = (st & 1) * 32 + (swz % 64) / 2; }
__host__ __device__ __forceinline__ int perm32(int rho) { const int n = rho >> 4, i = rho & 15; return 8 * (i >> 2) + 4 * n + (i & 3); }

struct Unit { int pm, pn, pass, slot; };
struct Gemm { const bf16_t* A; const bf16_t* Bt; int M, N, K; const bf16_t* A2; const bf16_t* Bt2; };

struct StaticOrder {
    int nM, nN, nwg, G, c, rep;
    __host__ __device__ void init(int M, int N, int G_, int c_, int rep_ = 1) { nM = M / BM; nN = N / BM; nwg = nM * nN; G = G_; c = c_; rep = rep_; }
    __host__ __device__ bool next(int i, Unit& u) const {
        int L = i * G + c; if (L >= nwg * rep) return false; u.pass = 0; if (L >= nwg) { L -= nwg; u.pass = 1; }
        int wgid = (int)L; { const int q = nwg / NXCD, r = nwg % NXCD, xcd = wgid % NXCD, off = wgid / NXCD; wgid = (xcd < r ? xcd * (q + 1) : r * (q + 1) + (xcd - r) * q) + off; }
        const int nig = WGM * nN, gid = wgid / nig, fm = gid * WGM, gsz = (nM - fm) < WGM ? (nM - fm) : WGM;
        u.slot = gid - ((L % NXCD) * (nwg / NXCD)) / nig;
        u.pm = fm + ((wgid % nig) % gsz); u.pn = (wgid % nig) / gsz; return true;
    }
    __device__ __forceinline__ void a_ready(const Unit&) const {}
    __device__ __forceinline__ void done(const Unit&) const {}
};
struct OneOrder {
    int pm, pn;
    __host__ __device__ bool next(int i, Unit& u) const { if (i != 0) return false; u.pm = pm; u.pn = pn; u.pass = 0; u.slot = 0; return true; }
    __device__ __forceinline__ void a_ready(const Unit&) const {}
    __device__ __forceinline__ void done(const Unit&) const {}
};
struct DualOrder {
    StaticOrder b;
    __host__ __device__ bool next(int i, Unit& u) const { if (!b.next(i >> 1, u)) return false; u.pass = i & 1; return true; }
    __device__ __forceinline__ void a_ready(const Unit&) const {}
    __device__ __forceinline__ void done(const Unit&) const {}
};
__device__ __forceinline__ unsigned cvt_pk_bf16(float lo, float hi) { unsigned r; asm volatile("v_cvt_pk_bf16_f32 %0, %1, %2" : "=v"(r) : "v"(lo), "v"(hi)); return r; }
typedef float f32x2 __attribute__((ext_vector_type(2)));
template <class Epi, class Sched, bool ALIGN_EPI = false, bool SP2 = false, bool DUAL = false>
__device__ __forceinline__ void gemm_phase(PG8_LAS unsigned char* lds, const Gemm g, const Sched& S, const Epi& E, int tid_in) {
    int tid_ = tid_in; asm volatile("" : "+v"(tid_));
    const int tid = tid_, wid = __builtin_amdgcn_readfirstlane(tid >> 6), lane = tid & 63, wr = wid >> 2, wc = wid & 3, fr = lane & 15, fq = lane >> 4;
    const int K = g.K, nt = K / BK;
    unsigned voffA[2], voffB[2];
#pragma unroll
    for (int i = 0; i < 2; ++i) { int R, C; stage_rc(tid * 16 + i * 8192, R, C); const int Rb = Epi::PERM ? ((R & ~31) + perm32(R & 31)) : R;
        voffA[i] = (unsigned)(R * K + C) * 2u; voffB[i] = (unsigned)(Rb * K + C) * 2u; }
    const size_t kstep = (size_t)(BK * 2);
    const size_t hstep = (size_t)HALF * K * 2;
    const size_t tstep = 2 * hstep;
    const unsigned ldsw = (unsigned)wid * 1024u;
    const int aoff = lds_byte(wr * 64 + fr, fq * 8), boff = lds_byte(wc * 32 + fr, fq * 8);
#define PG8_SA(b, h) (((b) * 2 + (h)) * HTB)
#define PG8_SB(b, h) ((4 + (b) * 2 + (h)) * HTB)
#define PG8_STAGE(bufoff, gbase, voff) do { _Pragma("unroll") for (int _i = 0; _i < 2; ++_i) \
        __builtin_amdgcn_global_load_lds((const unsigned*)((const char*)(gbase) + (voff)[_i]), (PG8_LAS unsigned*)(lds + (bufoff) + ldsw + _i * 8192), 16, 0, 0); } while (0)
#define PG8_LDA(dst, b, h) do { _Pragma("unroll") for (int m = 0; m < 4; ++m) _Pragma("unroll") for (int k = 0; k < 2; ++k) dst[m][k] = *(const PG8_LAS bf16x8*)(lds + PG8_SA(b, h) + aoff + m * 2048 + k * 1024); } while (0)
#define PG8_LDB(dst, b, h) do { _Pragma("unroll") for (int n = 0; n < 2; ++n) _Pragma("unroll") for (int k = 0; k < 2; ++k) dst[n][k] = *(const PG8_LAS bf16x8*)(lds + PG8_SB(b, h) + boff + n * 2048 + k * 1024); } while (0)
#define PG8_MMA(ai, bj, At, Bt) do { __builtin_amdgcn_s_setprio(1); _Pragma("unroll") for (int m = 0; m < 4; ++m) _Pragma("unroll") for (int n = 0; n < 2; ++n) _Pragma("unroll") for (int k = 0; k < 2; ++k) \
        acc[ai][bj][m][n] = __builtin_amdgcn_mfma_f32_16x16x32_bf16(Bt[n][k], At[m][k], acc[ai][bj][m][n], 0, 0, 0); __builtin_amdgcn_s_setprio(0); } while (0)
#define PG8_WAIT_V(n) asm volatile("s_waitcnt vmcnt(" #n ")" ::: "memory")
#define PG8_WAIT_L(n) asm volatile("s_waitcnt lgkmcnt(" #n ")" ::: "memory")
#define PG8_BAR __builtin_amdgcn_s_barrier()
#define PG8_SCHED __builtin_amdgcn_sched_barrier(0)
    Unit cur, nxt; int ui = 0;
    if (!S.next(0, cur)) return;
    f32x4 acc[2][2][4][2];
#pragma unroll
    for (int a = 0; a < 2; ++a)
#pragma unroll
        for (int b = 0; b < 2; ++b)
#pragma unroll
            for (int m = 0; m < 4; ++m)
#pragma unroll
                for (int n = 0; n < 2; ++n) acc[a][b][m][n] = (f32x4){0.f, 0.f, 0.f, 0.f};
    bf16x8 At[4][2], B0[2][2], B1[2][2];
    const char* cA = (const char*)((DUAL && cur.pass) ? g.A2 : g.A) + (size_t)cur.pm * tstep; const char* cB = (const char*)((DUAL && cur.pass) ? g.Bt2 : g.Bt) + (size_t)cur.pn * tstep;
    S.a_ready(cur);
    if constexpr (SP2) {
        PG8_STAGE(PG8_SB(0, 0), cB, voffB); PG8_STAGE(PG8_SB(0, 1), cB + hstep, voffB); PG8_STAGE(PG8_SA(0, 0), cA, voffA); PG8_STAGE(PG8_SA(0, 1), cA + hstep, voffA);
        if (wr == 1) PG8_BAR;
        PG8_WAIT_V(2); PG8_BAR;
        PG8_STAGE(PG8_SB(1, 0), cB + kstep, voffB); PG8_STAGE(PG8_SA(1, 0), cA + kstep, voffA); PG8_STAGE(PG8_SB(1, 1), cB + hstep + kstep, voffB);
        PG8_WAIT_V(6); PG8_BAR;
    } else {
        PG8_STAGE(PG8_SB(0, 0), cB, voffB); PG8_STAGE(PG8_SA(0, 0), cA, voffA); PG8_STAGE(PG8_SB(0, 1), cB + hstep, voffB); PG8_STAGE(PG8_SA(0, 1), cA + hstep, voffA);
        if (wr == 1) PG8_BAR;
        PG8_WAIT_V(4); PG8_BAR;
        PG8_STAGE(PG8_SB(1, 0), cB + kstep, voffB); PG8_STAGE(PG8_SA(1, 0), cA + kstep, voffA); PG8_STAGE(PG8_SB(1, 1), cB + hstep + kstep, voffB);
        PG8_WAIT_V(6); PG8_BAR;
    }
    for (;;) {
        const bool has_next = S.next(ui + 1, nxt);
        const char* nA = has_next ? (const char*)((DUAL && nxt.pass) ? g.A2 : g.A) + (size_t)nxt.pm * tstep : cA; const char* nB = has_next ? (const char*)((DUAL && nxt.pass) ? g.Bt2 : g.Bt) + (size_t)nxt.pn * tstep : cB;
        for (int t = 0; t < nt; t += 2) {
            const bool last = (t == nt - 2);
            const char* a1 = cA + (size_t)(t + 1) * kstep;
            const char* a2 = last ? nA : cA + (size_t)(t + 2) * kstep; const char* b2 = last ? nB : cB + (size_t)(t + 2) * kstep;
            const char* a3 = a2 + kstep; const char* b3 = b2 + kstep;
            if (last && has_next) S.a_ready(nxt);
            if constexpr (SP2) {
            PG8_LDB(B0, 0, 0); PG8_LDB(B1, 0, 1); PG8_SCHED; PG8_LDA(At, 0, 0); PG8_STAGE(PG8_SA(1, 1), a1 + hstep, voffA);
            PG8_WAIT_V(8); PG8_WAIT_L(0); PG8_BAR; PG8_MMA(0, 0, At, B0); PG8_MMA(0, 1, At, B1); PG8_BAR; PG8_SCHED;
            PG8_LDA(At, 0, 1); PG8_STAGE(PG8_SB(0, 0), b2, voffB); PG8_STAGE(PG8_SB(0, 1), b2 + hstep, voffB); PG8_STAGE(PG8_SA(0, 0), a2, voffA);
            PG8_WAIT_V(8); PG8_WAIT_L(0); PG8_BAR; PG8_MMA(1, 0, At, B0); PG8_MMA(1, 1, At, B1); PG8_BAR; PG8_SCHED;
            PG8_LDB(B0, 1, 0); PG8_LDB(B1, 1, 1); PG8_SCHED; PG8_LDA(At, 1, 0); PG8_STAGE(PG8_SA(0, 1), a2 + hstep, voffA);
            PG8_WAIT_V(8); PG8_WAIT_L(0); PG8_BAR; PG8_MMA(0, 0, At, B0); PG8_MMA(0, 1, At, B1); PG8_BAR; PG8_SCHED;
            PG8_LDA(At, 1, 1); PG8_STAGE(PG8_SB(1, 0), b3, voffB); PG8_STAGE(PG8_SB(1, 1), b3 + hstep, voffB); PG8_STAGE(PG8_SA(1, 0), a3, voffA);
            PG8_WAIT_V(8); PG8_WAIT_L(0); PG8_BAR; PG8_MMA(1, 0, At, B0); PG8_MMA(1, 1, At, B1); PG8_BAR; PG8_SCHED;
            } else {
            PG8_LDB(B0, 0, 0); PG8_SCHED; PG8_LDA(At, 0, 0); PG8_STAGE(PG8_SA(1, 1), a1 + hstep, voffA);
            PG8_WAIT_L(8); PG8_BAR; PG8_WAIT_L(0); PG8_MMA(0, 0, At, B0); PG8_BAR; PG8_SCHED;
            PG8_LDB(B1, 0, 1); PG8_STAGE(PG8_SB(0, 0), b2, voffB);
            PG8_BAR; PG8_WAIT_L(0); PG8_MMA(0, 1, At, B1); PG8_BAR;
            PG8_LDA(At, 0, 1); PG8_STAGE(PG8_SA(0, 0), a2, voffA);
            PG8_BAR; PG8_WAIT_L(0); PG8_MMA(1, 0, At, B0); PG8_BAR; PG8_SCHED;
            PG8_STAGE(PG8_SB(0, 1), b2 + hstep, voffB);
            PG8_WAIT_V(6); PG8_BAR; PG8_MMA(1, 1, At, B1); PG8_BAR;
            PG8_LDB(B0, 1, 0); PG8_SCHED; PG8_LDA(At, 1, 0); PG8_STAGE(PG8_SA(0, 1), a2 + hstep, voffA);
            PG8_WAIT_L(8); PG8_BAR; PG8_WAIT_L(0); PG8_MMA(0, 0, At, B0); PG8_BAR; PG8_SCHED;
            PG8_LDB(B1, 1, 1); PG8_STAGE(PG8_SB(1, 0), b3, voffB);
            PG8_BAR; PG8_WAIT_L(0); PG8_MMA(0, 1, At, B1); PG8_BAR;
            PG8_LDA(At, 1, 1); PG8_STAGE(PG8_SA(1, 0), a3, voffA);
            PG8_BAR; PG8_WAIT_L(0); PG8_MMA(1, 0, At, B0); PG8_BAR; PG8_SCHED;
            PG8_STAGE(PG8_SB(1, 1), b3 + hstep, voffB);
            PG8_WAIT_V(6); PG8_BAR; PG8_MMA(1, 1, At, B1); PG8_BAR;
            }
        }
        if constexpr (ALIGN_EPI) { if (wr == 0) PG8_BAR; }
        if constexpr (DUAL) { if (cur.pass == 0) E.mid(acc, cur, wr, wc, fr, fq); else E(acc, cur, wr, wc, fr, fq); }
        else if constexpr (!Epi::AFTER_DRAIN) { E(acc, cur, wr, wc, fr, fq); S.done(cur); }
        if (!has_next) break;
        if (!(DUAL && cur.pass == 0))
#pragma unroll
        for (int a = 0; a < 2; ++a)
#pragma unroll
            for (int b = 0; b < 2; ++b)
#pragma unroll
                for (int m = 0; m < 4; ++m)
#pragma unroll
                    for (int n = 0; n < 2; ++n) acc[a][b][m][n] = (f32x4){0.f, 0.f, 0.f, 0.f};
        cur = nxt; cA = nA; cB = nB; ++ui;
        if constexpr (ALIGN_EPI) { if (wr == 1) PG8_BAR; }
    }
    PG8_WAIT_V(0);
    if constexpr (!ALIGN_EPI) { if (wr == 0) PG8_BAR; }
    PG8_BAR;
    if constexpr (Epi::AFTER_DRAIN) { E.fused(acc, cur, wr, wc, fr, fq, lds, wid, lane); S.done(cur); }
#undef PG8_SA
#undef PG8_SB
#undef PG8_STAGE
#undef PG8_LDA
#undef PG8_LDB
#undef PG8_MMA
#undef PG8_WAIT_V
#undef PG8_WAIT_L
#undef PG8_BAR
#undef PG8_SCHED
}
}

constexpr int BATCH = 2, SEQ = 16384, DM = 2048, MTOK = BATCH * SEQ;
constexpr int HGH = 8, HGD = 128, HGW = 1024;
constexpr int ATH = 16, ATD = 64, ATW = 1024, WIN = 128;
constexpr int DIN = 9472, DFF = 8192;
constexpr float EPSF = 1e-6f;

#define LAS __attribute__((address_space(3)))
typedef unsigned short bf16;
typedef float f32x4 __attribute__((ext_vector_type(4)));
typedef unsigned u32x4 __attribute__((ext_vector_type(4)));
typedef unsigned u32x2 __attribute__((ext_vector_type(2)));

__device__ __forceinline__ float sigm(float x) { return __builtin_amdgcn_rcpf(1.f + __expf(-x)); }
__device__ __forceinline__ float bflo(unsigned w) { return __uint_as_float(w << 16); }
__device__ __forceinline__ float bfhi(unsigned w) { return __uint_as_float(w & 0xffff0000u); }
typedef __bf16 bf16x2_t __attribute__((ext_vector_type(2)));
typedef float f32x2_t __attribute__((ext_vector_type(2)));
__device__ __forceinline__ unsigned pk2(float lo, float hi) { const f32x2_t v = {lo, hi}; const bf16x2_t b = __builtin_convertvector(v, bf16x2_t); return __builtin_bit_cast(unsigned, b); }

constexpr size_t WS_RS = 0;
constexpr size_t WS_LB = 131072;
constexpr size_t WS_BAR = 196608;
constexpr size_t WS_PART = 262144;
constexpr size_t WS_W = WS_PART + (size_t)MTOK * 32 * 4;
constexpr size_t W_IN = 0, W_HG = W_IN + (size_t)DIN * DM * 2, W_AT = W_HG + (size_t)DM * HGW * 2, W_OUT = W_AT + (size_t)DM * ATW * 2,
                 W_UP = W_OUT + (size_t)DM * DM * 2, W_DN = W_UP + (size_t)DFF * DM * 2, W_LAYER = W_DN + (size_t)DM * DFF * 2;
constexpr size_t WS_XB = WS_W + 2 * W_LAYER;
constexpr size_t WS_Z = WS_XB + (size_t)MTOK * DM * 2;
constexpr size_t Z_QF = 0, Z_LOGF = Z_QF + (size_t)MTOK * 1024 * 2, Z_VI = Z_LOGF + (size_t)MTOK * 1024 * 4, Z_HGATE = Z_VI + (size_t)MTOK * 1024 * 2,
                 Z_AQ = Z_HGATE + (size_t)MTOK * 1024 * 2, Z_AKV = Z_AQ + (size_t)MTOK * 1024 * 2, Z_GH = Z_AKV + (size_t)MTOK * 256 * 2,
                 Z_GA = Z_GH + (size_t)MTOK * 2048 * 2, Z_END = Z_GA + (size_t)MTOK * 2048 * 2;
constexpr size_t Z_T1 = 0, Z_MIX = (size_t)MTOK * 2048 * 2;
constexpr size_t Z_U = 0;
constexpr size_t WS_D = WS_Z + Z_LOGF + (size_t)MTOK * 1024 * 2;
constexpr size_t WS_END = WS_Z + Z_END;
static_assert(Z_MIX + (size_t)MTOK * 2048 * 2 <= Z_HGATE, "T1|MIX overlay");
static_assert((size_t)MTOK * DFF * 2 <= Z_END, "U overlay");
static_assert(WS_END <= 1073741824ull, "workspace");

constexpr int LDS_BYTES = 147456;
#ifndef PH
#define PH 0xFFFF
#endif
#define ON(k) ((PH >> (k)) & 1)
#ifndef REP_G1
#define REP_G1 1
#endif
#ifndef REP_G5
#define REP_G5 1
#endif
#ifndef REP_G23
#define REP_G23 1
#endif
#ifndef PG_ALIGN
#define PG_ALIGN true
#endif
#ifndef PG_SP2
#define PG_SP2 true
#endif
#ifndef REP_G46
#define REP_G46 1
#endif
#ifndef REP_MIX
#define REP_MIX 0
#endif
#ifndef SKEW_G1
#define SKEW_G1 0
#endif
#ifndef SKEW_G5
#define SKEW_G5 0
#endif
#ifndef NT_ST
#define NT_ST 0
#endif
#ifndef REP_P0
#define REP_P0 1
#endif
#ifndef XSYNC
#define XSYNC 0
#endif
#ifndef REP_HA
#define REP_HA 1
#endif

namespace pg8 {
__device__ __forceinline__ void st16(u32x4* p, u32x4 v) { if (NT_ST) __builtin_nontemporal_store(v, p); else *p = v; }
struct EpiIn {
    static constexpr bool PERM = true, AFTER_DRAIN = false;
    const PG8_LAS float* rsl; const float* lb; unsigned char* Z;
    __device__ __forceinline__ void operator()(const f32x4 (&acc)[2][2][4][2], const Unit& u, int wr, int wc, int fr, int fq) const {
        const int pn = u.pn; int kind, ld, tb; size_t zo;
        if (pn < 4)       { kind = 0; zo = Z_QF;    ld = 1024; tb = pn * 256; }
        else if (pn < 8)  { kind = 1; zo = Z_LOGF;  ld = 1024; tb = (pn - 4) * 256; }
        else if (pn < 12) { kind = 2; zo = Z_VI;    ld = 1024; tb = (pn - 8) * 256; }
        else if (pn < 16) { kind = 0; zo = Z_HGATE; ld = 1024; tb = (pn - 12) * 256; }
        else if (pn < 20) { kind = 2; zo = Z_AQ;    ld = 1024; tb = (pn - 16) * 256; }
        else if (pn == 20){ kind = 2; zo = Z_AKV;   ld = 256;  tb = 0; }
        else              { kind = 4; zo = Z_GH;    ld = 2048; tb = (pn - 21) * 128; }
        const int row0 = u.pm * BM + wr * 64 + fr, col0 = tb + wc * 32 + 8 * fq;
        if (kind == 4) {
            bf16_t* Rb = (bf16_t*)(Z + Z_GH); bf16_t* Ab = (bf16_t*)(Z + Z_GA);
#pragma unroll
            for (int ai = 0; ai < 2; ++ai)
#pragma unroll
                for (int m = 0; m < 4; ++m) { const int row = row0 + ai * HALF + m * 16; const float s = rsl[u.slot * 256 + (row - u.pm * BM)]; const size_t off = (size_t)row * 2048 + col0;
                    float rr[8], gg[8];
#pragma unroll
                    for (int n = 0; n < 2; ++n) { const f32x4 zh = acc[ai][0][m][n] * s, za = acc[ai][1][m][n] * s;
#pragma unroll
                        for (int e = 0; e < 4; ++e) { const float ea1 = 1.f + __expf(-za[e]), sh = __builtin_amdgcn_rcpf(1.f + __expf(-zh[e])); rr[4 * n + e] = ea1 * sh; gg[4 * n + e] = __builtin_amdgcn_rcpf(ea1); } }
                    u32x4 w; w.x = pk2(rr[0], rr[1]); w.y = pk2(rr[2], rr[3]); w.z = pk2(rr[4], rr[5]); w.w = pk2(rr[6], rr[7]);
                    *(u32x4*)(Rb + off) = w;
                    w.x = pk2(gg[0], gg[1]); w.y = pk2(gg[2], gg[3]); w.z = pk2(gg[4], gg[5]); w.w = pk2(gg[6], gg[7]);
                    *(u32x4*)(Ab + off) = w; }
        } else if (kind == 1) {
            bf16_t* LOGF = (bf16_t*)(Z + zo);
            f32x4 lbv[2][2];
#pragma unroll
            for (int bj = 0; bj < 2; ++bj)
#pragma unroll
                for (int n = 0; n < 2; ++n) lbv[bj][n] = *(const f32x4*)(lb + col0 + bj * HALF + 4 * n);
#pragma unroll
            for (int ai = 0; ai < 2; ++ai)
#pragma unroll
                for (int m = 0; m < 4; ++m) { const int row = row0 + ai * HALF + m * 16; const float s = rsl[u.slot * 256 + (row - u.pm * BM)]; bf16_t* rp = LOGF + (size_t)row * 1024 + col0;
#pragma unroll
                    for (int bj = 0; bj < 2; ++bj) { f32x4 o[2];
#pragma unroll
                        for (int n = 0; n < 2; ++n) { const f32x4 v = acc[ai][bj][m][n] * s;
#pragma unroll
                            for (int e = 0; e < 4; ++e) { const float l = lbv[bj][n][e]; o[n][e] = __log2f(l + (1.f - l) * sigm(v[e])); } }
                        u32x4 w; w.x = pk2(o[0][0], o[0][1]); w.y = pk2(o[0][2], o[0][3]); w.z = pk2(o[1][0], o[1][1]); w.w = pk2(o[1][2], o[1][3]);
                        st16((u32x4*)(rp + bj * HALF), w); } }
        } else {
            bf16_t* dst = (bf16_t*)(Z + zo);
#pragma unroll
            for (int ai = 0; ai < 2; ++ai)
#pragma unroll
                for (int m = 0; m < 4; ++m) { const int row = row0 + ai * HALF + m * 16; const float s = rsl[u.slot * 256 + (row - u.pm * BM)]; bf16_t* rp = dst + (size_t)row * ld + col0;
#pragma unroll
                    for (int bj = 0; bj < 2; ++bj) { f32x4 v0 = acc[ai][bj][m][0] * s, v1 = acc[ai][bj][m][1] * s;
                        if (kind == 0) {
#pragma unroll
                            for (int e = 0; e < 4; ++e) { v0[e] = v0[e] * sigm(v0[e]); v1[e] = v1[e] * sigm(v1[e]); }
                        }
                        u32x4 w; w.x = pk2(v0[0], v0[1]); w.y = pk2(v0[2], v0[3]); w.z = pk2(v1[0], v1[1]); w.w = pk2(v1[2], v1[3]);
                        st16((u32x4*)(rp + bj * HALF), w); } }
        }
    }
};
struct EpiMix {
    static constexpr bool PERM = true, AFTER_DRAIN = false;
    const bf16_t* gh; const bf16_t* ga; bf16_t* dst;
    __device__ __forceinline__ void mid(f32x4 (&acc)[2][2][4][2], const Unit& u, int wr, int wc, int fr, int fq) const {
        const int row0 = u.pm * BM + wr * 64 + fr, col0 = u.pn * BM + wc * 32 + 8 * fq;
#pragma unroll
        for (int ai = 0; ai < 2; ++ai)
#pragma unroll
            for (int m = 0; m < 4; ++m) { const size_t off = (size_t)(row0 + ai * HALF + m * 16) * 2048 + col0;
#pragma unroll
                for (int bj = 0; bj < 2; ++bj) { const u32x4 g = *(const u32x4*)(gh + off + bj * HALF);
                    acc[ai][bj][m][0][0] *= bflo(g.x); acc[ai][bj][m][0][1] *= bfhi(g.x); acc[ai][bj][m][0][2] *= bflo(g.y); acc[ai][bj][m][0][3] *= bfhi(g.y);
                    acc[ai][bj][m][1][0] *= bflo(g.z); acc[ai][bj][m][1][1] *= bfhi(g.z); acc[ai][bj][m][1][2] *= bflo(g.w); acc[ai][bj][m][1][3] *= bfhi(g.w); } }
    }
    __device__ __forceinline__ void operator()(const f32x4 (&acc)[2][2][4][2], const Unit& u, int wr, int wc, int fr, int fq) const {
        const int row0 = u.pm * BM + wr * 64 + fr, col0 = u.pn * BM + wc * 32 + 8 * fq;
#pragma unroll
        for (int ai = 0; ai < 2; ++ai)
#pragma unroll
            for (int m = 0; m < 4; ++m) { const size_t off = (size_t)(row0 + ai * HALF + m * 16) * 2048 + col0;
#pragma unroll
                for (int bj = 0; bj < 2; ++bj) { const u32x4 a = *(const u32x4*)(ga + off + bj * HALF);
                    f32x4 v0 = acc[ai][bj][m][0], v1 = acc[ai][bj][m][1];
                    v0[0] *= bflo(a.x); v0[1] *= bfhi(a.x); v0[2] *= bflo(a.y); v0[3] *= bfhi(a.y); v1[0] *= bflo(a.z); v1[1] *= bfhi(a.z); v1[2] *= bflo(a.w); v1[3] *= bfhi(a.w);
                    u32x4 w; w.x = pk2(v0[0], v0[1]); w.y = pk2(v0[2], v0[3]); w.z = pk2(v1[0], v1[1]); w.w = pk2(v1[2], v1[3]);
                    *(u32x4*)(dst + off + bj * HALF) = w; } }
    }
};
struct EpiRes {
    static constexpr bool PERM = true, AFTER_DRAIN = false;
    const bf16_t* resid; float* outf; bf16_t* xb; float* part;
    __device__ __forceinline__ void operator()(const f32x4 (&acc)[2][2][4][2], const Unit& u, int wr, int wc, int fr, int fq) const {
        if (REP_G46 > 1 && u.pass == 0) return;
        const int row0 = u.pm * BM + wr * 64 + fr, col0 = u.pn * BM + wc * 32 + 8 * fq;
#pragma unroll
        for (int ai = 0; ai < 2; ++ai)
#pragma unroll
            for (int m = 0; m < 4; ++m) { const int row = row0 + ai * HALF + m * 16; const size_t off = (size_t)row * 2048 + col0; float ss = 0.f;
#pragma unroll
                for (int bj = 0; bj < 2; ++bj) { const u32x4 rw = *(const u32x4*)(resid + off + bj * HALF);
                    f32x4 o0 = acc[ai][bj][m][0], o1 = acc[ai][bj][m][1];
                    o0[0] += bflo(rw.x); o0[1] += bfhi(rw.x); o0[2] += bflo(rw.y); o0[3] += bfhi(rw.y); o1[0] += bflo(rw.z); o1[1] += bfhi(rw.z); o1[2] += bflo(rw.w); o1[3] += bfhi(rw.w);
                    if (outf) { *(f32x4*)(outf + off + bj * HALF) = o0; *(f32x4*)(outf + off + bj * HALF + 4) = o1; }
                    else { ss += (o0[0] * o0[0] + o0[1] * o0[1]) + (o0[2] * o0[2] + o0[3] * o0[3]) + (o1[0] * o1[0] + o1[1] * o1[1]) + (o1[2] * o1[2] + o1[3] * o1[3]);
                        u32x4 w; w.x = pk2(o0[0], o0[1]); w.y = pk2(o0[2], o0[3]); w.z = pk2(o1[0], o1[1]); w.w = pk2(o1[2], o1[3]);
                        *(u32x4*)(xb + off + bj * HALF) = w; } }
                if (!outf) { ss += __shfl_xor(ss, 16); ss += __shfl_xor(ss, 32); if (fq == 0) part[(size_t)row * 32 + u.pn * 4 + wc] = ss; } }
    }
};
struct EpiUp {
    static constexpr bool PERM = true, AFTER_DRAIN = false;
    const PG8_LAS float* rsl; bf16_t* dst;
    __device__ __forceinline__ void operator()(const f32x4 (&acc)[2][2][4][2], const Unit& u, int wr, int wc, int fr, int fq) const {
        const int row0 = u.pm * BM + wr * 64 + fr, col0 = u.pn * BM + wc * 32 + 8 * fq;
#pragma unroll
        for (int ai = 0; ai < 2; ++ai)
#pragma unroll
            for (int m = 0; m < 4; ++m) { const int row = row0 + ai * HALF + m * 16; const float s = rsl[u.slot * 256 + (row - u.pm * BM)]; bf16_t* rp = dst + (size_t)row * DFF + col0;
#pragma unroll
                for (int bj = 0; bj < 2; ++bj) { f32x4 v0 = acc[ai][bj][m][0] * s, v1 = acc[ai][bj][m][1] * s;
#pragma unroll
                    for (int e = 0; e < 4; ++e) { const float a = fmaxf(v0[e], 0.f), b = fmaxf(v1[e], 0.f); v0[e] = a * a; v1[e] = b * b; }
                    u32x4 w; w.x = pk2(v0[0], v0[1]); w.y = pk2(v0[2], v0[3]); w.z = pk2(v1[0], v1[1]); w.w = pk2(v1[2], v1[3]);
                    st16((u32x4*)(rp + bj * HALF), w); } }
    }
};
}

__device__ __forceinline__ float wave_sum(float v) {
#pragma unroll
    for (int o = 1; o < 64; o <<= 1) v += __shfl_xor(v, o);
    return v;
}
__device__ __forceinline__ int gate_row_remap(int n0) {
    constexpr int G0 = 5376, G1 = 7424;
    if (n0 < G0) return n0;
    if (n0 < G1) { const int q = n0 - G0; return G0 + 256 * (q / 128) + (q % 128); }
    const int q = n0 - G1; return G0 + 256 * (q / 128) + 128 + (q % 128);
}
__device__ __forceinline__ void transpose_item(const float* __restrict__ W, const float* __restrict__ gain, int K, int N, bf16* __restrict__ WT, LAS float* scr, int item, int lane, bool remap = false) {
    const int nblk = N / 32, kb = item / nblk, nb = item % nblk, k0 = 64 * kb, n0 = 32 * nb, nd0 = remap ? gate_row_remap(n0) : n0;
    float wv[32];
#pragma unroll
    for (int i = 0; i < 32; ++i) { const int kk = 2 * i + (lane >> 5); wv[i] = W[(size_t)(k0 + kk) * N + n0 + (lane & 31)]; }
    const float g0 = gain ? gain[k0 + (lane & 63)] : 1.f;
#pragma unroll
    for (int i = 0; i < 32; ++i) { const int kk = 2 * i + (lane >> 5); const float g = __shfl(g0, kk); scr[kk * 33 + (lane & 31)] = wv[i] * g; }
    asm volatile("s_waitcnt lgkmcnt(0)" ::: "memory");
    const int c = lane & 7;
#pragma unroll
    for (int j = 0; j < 4; ++j) { const int n = (lane >> 3) + 8 * j; const LAS float* s = scr + (8 * c) * 33 + n;
        u32x4 o; o.x = pk2(s[0 * 33], s[1 * 33]); o.y = pk2(s[2 * 33], s[3 * 33]); o.z = pk2(s[4 * 33], s[5 * 33]); o.w = pk2(s[6 * 33], s[7 * 33]);
        *(u32x4*)(WT + (size_t)(nd0 + n) * K + k0 + 8 * c) = o; }
    asm volatile("s_waitcnt lgkmcnt(0)" ::: "memory");
}

struct Args {
    const float *x, *norm_mix, *w_in, *lb_logits, *hg_norm, *q_norm, *k_norm, *sinks, *w_hg_out, *w_at_out, *w_out, *norm_ffn, *w_up, *w_down;
    float* out; unsigned char* ws;
};

__device__ __forceinline__ u32x4 headnorm8(u32x4 w, f32x4 g0, f32x4 g1, float scale) {
    float v[8] = {bflo(w.x), bfhi(w.x), bflo(w.y), bfhi(w.y), bflo(w.z), bfhi(w.z), bflo(w.w), bfhi(w.w)};
    float ss = 0.f;
#pragma unroll
    for (int e = 0; e < 8; ++e) ss += v[e] * v[e];
    ss += __shfl_xor(ss, 1); ss += __shfl_xor(ss, 2); ss += __shfl_xor(ss, 4);
    const float r = rsqrtf(ss * (1.f / 64.f) + EPSF) * scale;
    u32x4 o; o.x = pk2(v[0] * r * g0[0], v[1] * r * g0[1]); o.y = pk2(v[2] * r * g0[2], v[3] * r * g0[3]); o.z = pk2(v[4] * r * g1[0], v[5] * r * g1[1]); o.w = pk2(v[6] * r * g1[2], v[7] * r * g1[3]);
    return o;
}
typedef short bf16x8 __attribute__((ext_vector_type(8)));
typedef float f32x2 __attribute__((ext_vector_type(2)));
#define MFMA16(a, b, c) __builtin_amdgcn_mfma_f32_16x16x32_bf16((a), (b), (c), 0, 0, 0)
constexpr int HL_CUM = 0, HL_ABUF = 0, HL_TOT = 32768, HL_REF = 34816, HL_QT = 35840, HL_KST = HL_QT, HL_KT = HL_QT + 17408, HL_QO = HL_KT + 17408,
              HL_VT = HL_QO + 17408, HL_ST = HL_VT + 18432, HL_SS = HL_ST + 34816, HL_END = HL_SS + 512;
static_assert(HL_END <= LDS_BYTES, "HGRN2 LDS map");
struct Prep { float cum[16]; float lf[16]; float ref, last; };
struct ALoads { float lf[16]; unsigned vv[16]; };
struct CLoads { ALoads a; u32x4 st[4]; u32x4 lfR[2]; u32x4 qR[2]; u32x2 hg[4]; f32x4 hnv[4]; };
__device__ __forceinline__ void hg_issue1(ALoads& L, const bf16* __restrict__ LOGF, const bf16* __restrict__ VI, int item, int tid) {
    const int h = item & 7, k = tid & 127, seg = tid >> 7; const size_t tok0 = (size_t)(item >> 3) * 64;
    const bf16* lp = LOGF + (tok0 + 16 * seg) * 1024 + h * 128 + k;
    const bf16* vp = VI + (tok0 + 16 * seg) * 1024 + h * 128 + k;
#pragma unroll
    for (int i = 0; i < 16; ++i) { L.lf[i] = __uint_as_float((unsigned)lp[i * 1024] << 16); L.vv[i] = vp[i * 1024]; }
}
__device__ __forceinline__ void hg_step1(LAS unsigned char* lds, const ALoads& L, int tid, Prep& P) {
    const int k = tid & 127, seg = tid >> 7;
    float run = 0.f;
#pragma unroll
    for (int i = 0; i < 16; ++i) { P.lf[i] = L.lf[i]; run += L.lf[i]; P.cum[i] = run; }
    LAS float* TOT = (LAS float*)(lds + HL_TOT);
    TOT[seg * 128 + k] = run;
    u32x4 w0, w1;
    w0.x = L.vv[0] | (L.vv[1] << 16); w0.y = L.vv[2] | (L.vv[3] << 16); w0.z = L.vv[4] | (L.vv[5] << 16); w0.w = L.vv[6] | (L.vv[7] << 16);
    w1.x = L.vv[8] | (L.vv[9] << 16); w1.y = L.vv[10] | (L.vv[11] << 16); w1.z = L.vv[12] | (L.vv[13] << 16); w1.w = L.vv[14] | (L.vv[15] << 16);
    *(LAS u32x4*)(lds + HL_VT + (k * 72 + 16 * seg) * 2) = w0; *(LAS u32x4*)(lds + HL_VT + (k * 72 + 16 * seg) * 2 + 16) = w1;
    __syncthreads();
    const float t0 = TOT[k], t1 = TOT[128 + k], t2 = TOT[256 + k], t3 = TOT[384 + k];
    const float off = seg == 0 ? 0.f : seg == 1 ? t0 : seg == 2 ? t0 + t1 : (t0 + t1) + t2;
#pragma unroll
    for (int i = 0; i < 16; ++i) P.cum[i] += off;
    P.ref = t0 + t1; P.last = (t0 + t1) + (t2 + t3);
}
__device__ __forceinline__ void hgrn_a_item(LAS unsigned char* lds, ALoads& L, const bf16* __restrict__ LOGF, const bf16* __restrict__ VI, bf16* __restrict__ UT, float* __restrict__ D, int item, int next, int tid) {
    (void)next; hg_issue1(L, LOGF, VI, item, tid);
    Prep P; hg_step1(lds, L, tid, P);
    const int k = tid & 127, seg = tid >> 7;
    unsigned pk[8];
#pragma unroll
    for (int i = 0; i < 8; ++i) { const float a = (1.f - __builtin_amdgcn_exp2f(P.lf[2 * i])) * __builtin_amdgcn_exp2f(P.last - P.cum[2 * i]), b = (1.f - __builtin_amdgcn_exp2f(P.lf[2 * i + 1])) * __builtin_amdgcn_exp2f(P.last - P.cum[2 * i + 1]); pk[i] = pk2(a, b); }
    *(LAS u32x4*)(lds + HL_KST + (k * 72 + 16 * seg) * 2) = (u32x4){pk[0], pk[1], pk[2], pk[3]};
    *(LAS u32x4*)(lds + HL_KST + (k * 72 + 16 * seg) * 2 + 16) = (u32x4){pk[4], pk[5], pk[6], pk[7]};
    if (seg == 0) D[(size_t)item * 128 + k] = __builtin_amdgcn_exp2f(P.last);
    __syncthreads();
    const int lane = tid & 63, w = tid >> 6, r = lane & 15, q = lane >> 4;
    bf16x8 af[2];
#pragma unroll
    for (int ks = 0; ks < 2; ++ks) af[ks] = *(const LAS bf16x8*)(lds + HL_KST + ((16 * w + r) * 72 + 32 * ks + 8 * q) * 2);
    bf16* ut = UT + (size_t)item * 16384;
#pragma unroll
    for (int nt = 0; nt < 8; ++nt) { f32x4 acc = {0.f, 0.f, 0.f, 0.f};
#pragma unroll
        for (int ks = 0; ks < 2; ++ks) { const bf16x8 bfr = *(const LAS bf16x8*)(lds + HL_VT + ((16 * nt + r) * 72 + 32 * ks + 8 * q) * 2); acc = MFMA16(af[ks], bfr, acc); }
        u32x2 o; o.x = pk2(acc[0], acc[1]); o.y = pk2(acc[2], acc[3]);
        *(u32x2*)(ut + (16 * nt + r) * 128 + 16 * w + 4 * q) = o; }
    __syncthreads();
}
__device__ __forceinline__ void hgrn_scan(bf16* UT, bf16* SDST, const float* __restrict__ D, int gtid, int NT) {
    for (int e = gtid; e < 16 * 8192; e += NT) {
        const int bh = e >> 13, off = (e & 8191) * 2, b = bh >> 3, h = bh & 7, k = off & 127;
        unsigned* up = (unsigned*)(UT + ((size_t)(b * 256) * 8 + h) * 16384 + off);
        unsigned* sp = (unsigned*)(SDST + ((size_t)(b * 256) * 8 + h) * 16384 + off);
        const float* dp = D + ((size_t)(b * 256) * 8 + h) * 128 + k;
        float s0 = 0.f, s1 = 0.f;
        for (int n = 0; n < 256; n += 16) {
            unsigned u[16]; f32x2 d[16];
#pragma unroll
            for (int j = 0; j < 16; ++j) { u[j] = up[(size_t)(n + j) * 65536]; d[j] = *(const f32x2*)(dp + (size_t)(n + j) * 1024); }
#pragma unroll
            for (int j = 0; j < 16; ++j) { sp[(size_t)(n + j) * 65536] = pk2(s0, s1); s0 = d[j].x * s0 + bflo(u[j]); s1 = d[j].y * s1 + bfhi(u[j]); }
        }
    }
}
__device__ __forceinline__ void hgc_issue_st(CLoads& L, const bf16* __restrict__ ST, int item, int tid) {
    const u32x4* sg = (const u32x4*)(ST + (size_t)item * 16384);
#pragma unroll
    for (int j = 0; j < 4; ++j) L.st[j] = sg[tid + 512 * j];
}
__device__ __forceinline__ void hgc_issue_r(CLoads& L, const bf16* __restrict__ QF, const bf16* __restrict__ LOGF, int item, int tid) {
    const int h = item & 7, t = tid >> 3, k0 = 16 * (tid & 7); const size_t go = ((size_t)(item >> 3) * 64 + t) * 1024 + h * 128 + k0;
    L.lfR[0] = *(const u32x4*)(LOGF + go); L.lfR[1] = *(const u32x4*)(LOGF + go + 8);
    L.qR[0] = *(const u32x4*)(QF + go); L.qR[1] = *(const u32x4*)(QF + go + 8);
}
__device__ __forceinline__ void hgc_issue_hg(CLoads& L, const bf16* HGATE, const float* __restrict__ hn, int item, int tid) {
    const int h = item & 7, lane = tid & 63, w = tid >> 6, r = lane & 15, q = lane >> 4, nt = w & 3, vh = w >> 2;
    const bf16* hp = HGATE + ((size_t)(item >> 3) * 64 + 16 * nt + r) * 1024 + h * 128;
#pragma unroll
    for (int j = 0; j < 4; ++j) { L.hg[j] = *(const u32x2*)(hp + 16 * (4 * vh + j) + 4 * q); L.hnv[j] = *(const f32x4*)(hn + 16 * (4 * vh + j) + 4 * q); }
}
__device__ __forceinline__ void hgrn_c_item(LAS unsigned char* lds, CLoads& L, const bf16* __restrict__ QF, const bf16* __restrict__ LOGF, const bf16* __restrict__ VI, const bf16* __restrict__ ST,
                                            bf16* HGATE, bf16* HDST, const float* __restrict__ hn, int item, int next, int tid) {
    const int h = item & 7; const size_t tok0 = (size_t)(item >> 3) * 64;
    hgc_issue_hg(L, HGATE, hn, item, tid);
    Prep P; hg_step1(lds, L.a, tid, P);
    if (next >= 0) hg_issue1(L.a, LOGF, VI, next, tid);
    {
        const int k = tid & 127, seg = tid >> 7;
        LAS float* CUM = (LAS float*)(lds + HL_CUM);
#pragma unroll
        for (int i = 0; i < 16; ++i) CUM[(16 * seg + i) * 128 + k] = P.cum[i];
        if (seg == 0) ((LAS float*)(lds + HL_REF))[k] = P.ref;
#pragma unroll
        for (int j = 0; j < 4; ++j) { const int idx = tid + 512 * j, v = idx >> 4, c = idx & 15; *(LAS u32x4*)(lds + HL_ST + (v * 136 + c * 8) * 2) = L.st[j]; }
        if (next >= 0) hgc_issue_st(L, ST, next, tid);
    }
    __syncthreads();
    {
        const int t = tid >> 3, k0 = 16 * (tid & 7);
        f32x4 cm[4], rf[4];
#pragma unroll
        for (int j = 0; j < 4; ++j) { cm[j] = *(const LAS f32x4*)(lds + HL_CUM + (t * 128 + k0 + 4 * j) * 4); rf[j] = *(const LAS f32x4*)(lds + HL_REF + (k0 + 4 * j) * 4); }
        unsigned pq[8], pkk[8], po[8];
#pragma unroll
        for (int j = 0; j < 8; ++j) {
            const unsigned qw = L.qR[j >> 2][j & 3]; const float q0 = bflo(qw), q1 = bfhi(qw);
            const int e0 = 2 * j, e1 = 2 * j + 1;
            const float c0 = cm[e0 >> 2][e0 & 3], c1 = cm[e1 >> 2][e1 & 3], r0 = rf[e0 >> 2][e0 & 3], r1 = rf[e1 >> 2][e1 & 3];
            const unsigned lw = L.lfR[j >> 2][j & 3]; const float kf0 = 1.f - __builtin_amdgcn_exp2f(bflo(lw)), kf1 = 1.f - __builtin_amdgcn_exp2f(bfhi(lw));
            pq[j] = pk2(q0 * __builtin_amdgcn_exp2f(c0 - r0), q1 * __builtin_amdgcn_exp2f(c1 - r1));
            pkk[j] = pk2(kf0 * __builtin_amdgcn_exp2f(r0 - c0), kf1 * __builtin_amdgcn_exp2f(r1 - c1));
            po[j] = pk2(q0 * __builtin_amdgcn_exp2f(c0), q1 * __builtin_amdgcn_exp2f(c1));
        }
        if (next >= 0) hgc_issue_r(L, QF, LOGF, next, tid);
        const int lo = (t * 136 + k0) * 2;
        *(LAS u32x4*)(lds + HL_QT + lo) = (u32x4){pq[0], pq[1], pq[2], pq[3]}; *(LAS u32x4*)(lds + HL_QT + lo + 16) = (u32x4){pq[4], pq[5], pq[6], pq[7]};
        *(LAS u32x4*)(lds + HL_KT + lo) = (u32x4){pkk[0], pkk[1], pkk[2], pkk[3]}; *(LAS u32x4*)(lds + HL_KT + lo + 16) = (u32x4){pkk[4], pkk[5], pkk[6], pkk[7]};
        *(LAS u32x4*)(lds + HL_QO + lo) = (u32x4){po[0], po[1], po[2], po[3]}; *(LAS u32x4*)(lds + HL_QO + lo + 16) = (u32x4){po[4], po[5], po[6], po[7]};
    }
    __syncthreads();
    const int lane = tid & 63, w = tid >> 6, r = lane & 15, q = lane >> 4, nt = w & 3, vh = w >> 2;
    {
#pragma unroll
        for (int mm = 0; mm < 2; ++mm) { const int mt = vh * 2 + mm; f32x4 acc = {0.f, 0.f, 0.f, 0.f};
            if (mt <= nt) {
#pragma unroll
                for (int ks = 0; ks < 4; ++ks) { const bf16x8 a = *(const LAS bf16x8*)(lds + HL_KT + ((16 * mt + r) * 136 + 32 * ks + 8 * q) * 2), b = *(const LAS bf16x8*)(lds + HL_QT + ((16 * nt + r) * 136 + 32 * ks + 8 * q) * 2);
                    acc = MFMA16(a, b, acc); } }
            const int c = 16 * nt + r, s0 = 16 * mt + 4 * q;
            const float a0 = (mt <= nt && s0 + 0 <= c) ? acc[0] : 0.f, a1 = (mt <= nt && s0 + 1 <= c) ? acc[1] : 0.f, a2 = (mt <= nt && s0 + 2 <= c) ? acc[2] : 0.f, a3 = (mt <= nt && s0 + 3 <= c) ? acc[3] : 0.f;
            u32x2 o; o.x = pk2(a0, a1); o.y = pk2(a2, a3);
            *(LAS u32x2*)(lds + HL_ABUF + (c * 72 + s0) * 2) = o; }
    }
    __syncthreads();
    {
        bf16x8 bA[2], bQ[4];
#pragma unroll
        for (int ks = 0; ks < 2; ++ks) bA[ks] = *(const LAS bf16x8*)(lds + HL_ABUF + ((16 * nt + r) * 72 + 32 * ks + 8 * q) * 2);
#pragma unroll
        for (int ks = 0; ks < 4; ++ks) bQ[ks] = *(const LAS bf16x8*)(lds + HL_QO + ((16 * nt + r) * 136 + 32 * ks + 8 * q) * 2);
        f32x4 acc[4]; float ss = 0.f;
#pragma unroll
        for (int j = 0; j < 4; ++j) { const int vt = 4 * vh + j; acc[j] = (f32x4){0.f, 0.f, 0.f, 0.f};
#pragma unroll
            for (int ks = 0; ks < 2; ++ks) { const bf16x8 a = *(const LAS bf16x8*)(lds + HL_VT + ((16 * vt + r) * 72 + 32 * ks + 8 * q) * 2); acc[j] = MFMA16(a, bA[ks], acc[j]); }
#pragma unroll
            for (int ks = 0; ks < 4; ++ks) { const bf16x8 a = *(const LAS bf16x8*)(lds + HL_ST + ((16 * vt + r) * 136 + 32 * ks + 8 * q) * 2); acc[j] = MFMA16(a, bQ[ks], acc[j]); }
            ss += (acc[j][0] * acc[j][0] + acc[j][1] * acc[j][1]) + (acc[j][2] * acc[j][2] + acc[j][3] * acc[j][3]); }
        ss += __shfl_xor(ss, 16); ss += __shfl_xor(ss, 32);
        LAS float* SS = (LAS float*)(lds + HL_SS);
        if (q == 0) SS[vh * 64 + 16 * nt + r] = ss;
        __syncthreads();
        const float rr = rsqrtf((SS[16 * nt + r] + SS[64 + 16 * nt + r]) * (1.f / 128.f) + EPSF);
        bf16* hp = HGATE + (tok0 + 16 * nt + r) * 1024 + h * 128;
#pragma unroll
        for (int j = 0; j < 4; ++j) { const int vb = 16 * (4 * vh + j) + 4 * q; const f32x4 g = L.hnv[j]; const u32x2 hg = L.hg[j];
            u32x2 o; o.x = pk2(acc[j][0] * rr * g[0] * bflo(hg.x), acc[j][1] * rr * g[1] * bfhi(hg.x)); o.y = pk2(acc[j][2] * rr * g[2] * bflo(hg.y), acc[j][3] * rr * g[3] * bfhi(hg.y));
            *(u32x2*)(HDST + (hp - HGATE) + vb) = o; }
    }
    __syncthreads();
}

constexpr int AL_K = 0, AL_VT = 208 * 144, AL_END = AL_VT + 64 * 432;
static_assert(AL_END <= LDS_BYTES, "attention LDS map");
__device__ __forceinline__ void attn_item(LAS unsigned char* lds, bf16* AQ, bf16* ODST, const bf16* __restrict__ AKV, const float* __restrict__ sinks, const float* __restrict__ qn, const float* __restrict__ kn, int item, int tid) {
    const int b = item >> 9, kvh = (item >> 8) & 1, qb = item & 255, t0 = qb * 64;
    const size_t tokb = (size_t)b * SEQ;
    const int lane = tid & 63, w = tid >> 6, r = lane & 15, quad = lane >> 4, h = kvh * 8 + w;
    bf16* qbase = AQ + (tokb + t0) * 1024 + h * 64;
    u32x4 qnx[2];
#pragma unroll
    for (int ks = 0; ks < 2; ++ks) qnx[ks] = *(const u32x4*)(qbase + (size_t)r * 1024 + 32 * ks + 8 * quad);
    {
        const f32x4 kg0 = *(const f32x4*)(kn + (tid & 7) * 8), kg1 = *(const f32x4*)(kn + (tid & 7) * 8 + 4);
        u32x4 kv[3];
#pragma unroll
        for (int j = 0; j < 3; ++j) { const int idx = tid + 512 * j, key = idx >> 3, c = idx & 7, s = t0 - 128 + key; kv[j] = (u32x4){0u, 0u, 0u, 0u};
            if (s >= 0) kv[j] = *(const u32x4*)(AKV + (tokb + s) * 256 + kvh * 64 + c * 8); }
#pragma unroll
        for (int j = 0; j < 3; ++j) { const int idx = tid + 512 * j, key = idx >> 3, c = idx & 7;
            *(LAS u32x4*)(lds + AL_K + (key * 72 + c * 8) * 2) = headnorm8(kv[j], kg0, kg1, 1.f); }
    }
    {
        const int d = tid & 63, kseg = tid >> 6; unsigned vv[24];
#pragma unroll
        for (int i = 0; i < 24; ++i) { const int s = t0 - 128 + 24 * kseg + i; vv[i] = s >= 0 ? (unsigned)AKV[(tokb + s) * 256 + 128 + kvh * 64 + d] : 0u; }
#pragma unroll
        for (int j = 0; j < 3; ++j) { u32x4 w; w.x = vv[8 * j] | (vv[8 * j + 1] << 16); w.y = vv[8 * j + 2] | (vv[8 * j + 3] << 16); w.z = vv[8 * j + 4] | (vv[8 * j + 5] << 16); w.w = vv[8 * j + 6] | (vv[8 * j + 7] << 16);
            *(LAS u32x4*)(lds + AL_VT + (d * 216 + 24 * kseg + 8 * j) * 2) = w; }
        if (kseg == 0) { *(LAS u32x4*)(lds + AL_VT + (d * 216 + 192) * 2) = (u32x4){0u, 0u, 0u, 0u}; *(LAS u32x4*)(lds + AL_VT + (d * 216 + 200) * 2) = (u32x4){0u, 0u, 0u, 0u}; }
    }
    __syncthreads();
    const float L2E = 1.44269504f, slope2 = exp2f(-0.5f * (float)(h + 1)) * L2E, sink2 = sinks[h] * L2E;
    const int m0 = r - 4 * quad;
    const float nb = -slope2 * (float)(128 + m0);
    float bias[9][4];
#pragma unroll
    for (int a = 0; a < 9; ++a)
#pragma unroll
        for (int i = 0; i < 4; ++i) bias[a][i] = fmaf(slope2, (float)(16 * a + i), nb);
#pragma unroll
    for (int i = 0; i < 4; ++i) { if (!(i > m0)) bias[0][i] = -INFINITY; if (!(i <= m0)) bias[8][i] = -INFINITY; }
    f32x4 qg[2][2];
#pragma unroll
    for (int ks = 0; ks < 2; ++ks) { qg[ks][0] = *(const f32x4*)(qn + 32 * ks + 8 * quad); qg[ks][1] = *(const f32x4*)(qn + 32 * ks + 8 * quad + 4); }
#pragma unroll 1
    for (int qt = 0; qt < 4; ++qt) {
        bf16x8 qf[2];
        {
            u32x4 qw[2]; float qv[2][8]; float ss = 0.f;
#pragma unroll
            for (int ks = 0; ks < 2; ++ks) qw[ks] = qnx[ks];
            if (qt < 3) {
#pragma unroll
                for (int ks = 0; ks < 2; ++ks) qnx[ks] = *(const u32x4*)(qbase + (size_t)(16 * (qt + 1) + r) * 1024 + 32 * ks + 8 * quad); }
#pragma unroll
            for (int ks = 0; ks < 2; ++ks) {
                qv[ks][0] = bflo(qw[ks].x); qv[ks][1] = bfhi(qw[ks].x); qv[ks][2] = bflo(qw[ks].y); qv[ks][3] = bfhi(qw[ks].y); qv[ks][4] = bflo(qw[ks].z); qv[ks][5] = bfhi(qw[ks].z); qv[ks][6] = bflo(qw[ks].w); qv[ks][7] = bfhi(qw[ks].w);
#pragma unroll
                for (int e = 0; e < 8; ++e) ss += qv[ks][e] * qv[ks][e]; }
            ss += __shfl_xor(ss, 16); ss += __shfl_xor(ss, 32);
            const float rq = rsqrtf(ss * (1.f / 64.f) + EPSF) * (0.125f * L2E);
#pragma unroll
            for (int ks = 0; ks < 2; ++ks) { const f32x4 g0 = qg[ks][0], g1 = qg[ks][1];
                const u32x4 pw = {pk2(qv[ks][0] * rq * g0[0], qv[ks][1] * rq * g0[1]), pk2(qv[ks][2] * rq * g0[2], qv[ks][3] * rq * g0[3]), pk2(qv[ks][4] * rq * g1[0], qv[ks][5] * rq * g1[1]), pk2(qv[ks][6] * rq * g1[2], qv[ks][7] * rq * g1[3])};
                qf[ks] = __builtin_bit_cast(bf16x8, pw); }
        }
        f32x4 s[9];
#pragma unroll
        for (int a = 0; a < 9; ++a) { s[a] = (f32x4){0.f, 0.f, 0.f, 0.f};
#pragma unroll
            for (int ks = 0; ks < 2; ++ks) { const bf16x8 kf = *(const LAS bf16x8*)(lds + AL_K + ((16 * (qt + a) + r) * 72 + 32 * ks + 8 * quad) * 2); s[a] = MFMA16(kf, qf[ks], s[a]); } }
        const int iq = 16 * qt + r;
#pragma unroll
        for (int a = 0; a < 9; ++a)
#pragma unroll
            for (int i = 0; i < 4; ++i) s[a][i] += bias[a][i];
        if (t0 < 128) {
            const int jmin = 128 - t0;
#pragma unroll
            for (int a = 0; a < 9; ++a)
#pragma unroll
                for (int i = 0; i < 4; ++i) if (16 * (qt + a) + 4 * quad + i < jmin) s[a][i] = -INFINITY;
        }
        float mx = sink2;
#pragma unroll
        for (int a = 0; a < 9; ++a) mx = fmaxf(fmaxf(mx, fmaxf(s[a][0], s[a][1])), fmaxf(s[a][2], s[a][3]));
        mx = fmaxf(mx, __shfl_xor(mx, 16)); mx = fmaxf(mx, __shfl_xor(mx, 32));
        float sum = 0.f;
#pragma unroll
        for (int a = 0; a < 9; ++a)
#pragma unroll
            for (int i = 0; i < 4; ++i) { const float p = __builtin_amdgcn_exp2f(s[a][i] - mx); s[a][i] = p; sum += p; }
        sum += __shfl_xor(sum, 16); sum += __shfl_xor(sum, 32); sum += __builtin_amdgcn_exp2f(sink2 - mx);
        const float inv = 1.f / sum;
        f32x4 o[4];
#pragma unroll
        for (int dt = 0; dt < 4; ++dt) o[dt] = (f32x4){0.f, 0.f, 0.f, 0.f};
#pragma unroll
        for (int kp = 0; kp < 5; ++kp) {
            u32x4 pw = {pk2(s[2 * kp][0], s[2 * kp][1]), pk2(s[2 * kp][2], s[2 * kp][3]), 0u, 0u};
            if (kp < 4) { pw.z = pk2(s[(2 * kp + 1) % 9][0], s[(2 * kp + 1) % 9][1]); pw.w = pk2(s[(2 * kp + 1) % 9][2], s[(2 * kp + 1) % 9][3]); }
            const bf16x8 pb = __builtin_bit_cast(bf16x8, pw);
#pragma unroll
            for (int dt = 0; dt < 4; ++dt) {
                const u32x2 lo = *(const LAS u32x2*)(lds + AL_VT + ((16 * dt + r) * 216 + 16 * (qt + 2 * kp) + 4 * quad) * 2);
                u32x4 vw = {lo.x, lo.y, 0u, 0u};
                if (kp < 4) { const u32x2 hi = *(const LAS u32x2*)(lds + AL_VT + ((16 * dt + r) * 216 + 16 * (qt + 2 * kp + 1) + 4 * quad) * 2); vw.z = hi.x; vw.w = hi.y; }
                o[dt] = MFMA16(__builtin_bit_cast(bf16x8, vw), pb, o[dt]); }
        }
#pragma unroll
        for (int dt = 0; dt < 4; ++dt) { u32x2 wv; wv.x = pk2(o[dt][0] * inv, o[dt][1] * inv); wv.y = pk2(o[dt][2] * inv, o[dt][3] * inv);
            *(u32x2*)(ODST + (qbase - AQ) + (size_t)iq * 1024 + 16 * dt + 4 * quad) = wv; }
    }
    __syncthreads();
}

constexpr int RSL_OFF = 132096;
template <bool FROM_PART>
__device__ __forceinline__ void fill_rs_table(LAS unsigned char* lds, const pg8::StaticOrder& S, const float* __restrict__ src, int tid) {
    int p0 = 0, p1 = 0, p2 = 0, p3 = 0;
    if (S.G == 256 && (S.nwg % (8 * pg8::WGM * S.nN)) == 0) {
        const int xcd = S.c % 8, j = S.c / 8, nig = pg8::WGM * S.nN, gid0 = (xcd * (S.nwg / 8)) / nig, b = j % pg8::WGM;
        p0 = gid0 * pg8::WGM + b; p1 = p0 + pg8::WGM; p2 = p1 + pg8::WGM; p3 = p2 + pg8::WGM;
    } else { pg8::Unit u; for (int i = 0; S.next(i, u); ++i) { if (u.slot == 0) p0 = u.pm; else if (u.slot == 1) p1 = u.pm; else if (u.slot == 2) p2 = u.pm; else p3 = u.pm; } }
    LAS float* T = (LAS float*)(lds + RSL_OFF);
    for (int e = tid; e < 1024; e += 512) { const int slot = e >> 8, t = e & 255; int pm = slot == 0 ? p0 : slot == 1 ? p1 : slot == 2 ? p2 : p3; pm = pm < MTOK / 256 ? pm : 0; const int row = pm * 256 + t;
        float v;
        if (FROM_PART) { const f32x4* p = (const f32x4*)(src + (size_t)row * 32); float s = 0.f;
#pragma unroll
            for (int jj = 0; jj < 8; ++jj) { const f32x4 w = p[jj]; s += (w[0] + w[1]) + (w[2] + w[3]); }
            v = rsqrtf(s * (1.f / DM) + EPSF); }
        else v = src[row];
        T[e] = v; }
    __syncthreads();
}

template <bool FROM_PART>
__device__ __forceinline__ void fill_rs_one(LAS unsigned char* lds, int pm, const float* __restrict__ src, int tid) {
    LAS float* T = (LAS float*)(lds + RSL_OFF);
    if (tid < 256) { const int row = pm * 256 + tid; float v;
        if (FROM_PART) { const f32x4* p = (const f32x4*)(src + (size_t)row * 32); float s = 0.f;
#pragma unroll
            for (int jj = 0; jj < 8; ++jj) { const f32x4 w = p[jj]; s += (w[0] + w[1]) + (w[2] + w[3]); }
            v = rsqrtf(s * (1.f / DM) + EPSF); }
        else v = src[row];
        T[tid] = v; }
    __syncthreads();
}
#define XB_TMO      128
#define XB_XCNT(j)  (256  + 64 * (j))
#define XB_XSUB(j)  (1280 + 64 * (j))
#define XB_XGEN(j)  (2304 + 64 * (j))
#define XB_TOP      3328
#define XB_TOPGEN   3392
#define XCD_BAR_WORDS 3456
#define XB_SPIN_CAP (1u << 18)

__device__ __forceinline__ unsigned xb_ld(unsigned* p)              { return __hip_atomic_load(p, __ATOMIC_RELAXED, __HIP_MEMORY_SCOPE_AGENT); }
__device__ __forceinline__ unsigned xb_add(unsigned* p, unsigned v) { return __hip_atomic_fetch_add(p, v, __ATOMIC_RELAXED, __HIP_MEMORY_SCOPE_AGENT); }
__device__ __forceinline__ unsigned xb_xcc_id() { return (unsigned)__builtin_amdgcn_s_getreg((3 << 11) | 20) & 0xFu; }
#define XB_SPIN(cond, bar) do { unsigned _sp = 0; while (cond) { __builtin_amdgcn_s_sleep(1); \
    if ((++_sp & 255u) == 0u) { if (xb_ld(&(bar)[XB_TMO])) break; if (_sp > XB_SPIN_CAP) { atomicAdd(&(bar)[XB_TMO], 1u); break; } } } } while (0)

struct XcdBarrier {
    unsigned* bar; unsigned x;
    volatile LAS unsigned* st;
};

__device__ __forceinline__ XcdBarrier xcd_barrier_post(unsigned* bar, volatile LAS unsigned* st) {
    XcdBarrier b; b.bar = bar; b.x = xb_xcc_id(); b.st = st;
    if (threadIdx.x == 0) (void)xb_add(&bar[XB_XCNT(b.x)], 1u);
    return b;
}
__device__ __forceinline__ void xcd_barrier_complete(unsigned* bar, unsigned x, unsigned& nloc, unsigned& nx) {
    const unsigned G = gridDim.x * gridDim.y * gridDim.z;
    unsigned sum, cnt, mine, sp = 0u;
    for (;;) {
        sum = 0u; cnt = 0u; mine = 0u;
#pragma unroll
        for (unsigned j = 0; j < 16; ++j) { const unsigned c = xb_ld(&bar[XB_XCNT(j)]); sum += c; cnt += (c > 0u) ? 1u : 0u; mine = (j == x) ? c : mine; }
        if (sum == G) break;
        __builtin_amdgcn_s_sleep(1);
        if ((++sp & 255u) == 0u) { if (xb_ld(&bar[XB_TMO])) break; if (sp > XB_SPIN_CAP) { atomicAdd(&bar[XB_TMO], 1u); break; } }
    }
    nloc = mine > 0u ? mine : 1u; nx = cnt > 0u ? cnt : 1u;
}

__device__ __forceinline__ void xcd_barrier(const XcdBarrier& b, bool leader) {
    asm volatile("s_waitcnt vmcnt(0)" ::: "memory");
    __syncthreads();
    if (leader) {
        unsigned* bar = b.bar;
        __builtin_amdgcn_s_waitcnt(0);
        unsigned nloc = b.st[0], nx = b.st[1];
        if (nloc == 0u) { xcd_barrier_complete(bar, b.x, nloc, nx); b.st[0] = nloc; b.st[1] = nx; }
        const unsigned old = xb_add(&bar[XB_XSUB(b.x)], 1u);
        const unsigned gen = old / nloc;
        if (old + 1u == (gen + 1u) * nloc) {
            __builtin_amdgcn_fence(__ATOMIC_RELEASE, "agent");
            asm volatile("s_waitcnt vmcnt(0)" ::: "memory");
            const unsigned og = xb_add(&bar[XB_TOP], 1u);
            const unsigned tg = og / nx;
            if (og + 1u == (tg + 1u) * nx) xb_add(&bar[XB_TOPGEN], 1u);
            else XB_SPIN(xb_ld(&bar[XB_TOPGEN]) == tg, bar);
            __builtin_amdgcn_fence(__ATOMIC_ACQUIRE, "agent");
            xb_add(&bar[XB_XGEN(b.x)], 1u);
            asm volatile("s_waitcnt vmcnt(0)" ::: "memory");
        } else {
            XB_SPIN(xb_ld(&bar[XB_XGEN(b.x)]) == gen, bar);
            __builtin_amdgcn_fence(__ATOMIC_ACQUIRE, "agent");
            asm volatile("s_waitcnt vmcnt(0)" ::: "memory");
        }
    }
    __syncthreads();
}

constexpr int MISC_OFF = LDS_BYTES - 256;
static_assert(MISC_OFF >= 141824 && MISC_OFF >= 131072, "LDS control words above every phase's LDS map");
typedef const Args __attribute__((address_space(4)))* KArgsP;
__device__ __forceinline__ KArgsP kargs() { KArgsP p = (KArgsP)__builtin_amdgcn_kernarg_segment_ptr(); asm volatile("" : "+s"(p)); return p; }
#define ZP(off) (ka->ws + WS_Z + (off))
#define WL(off) ((const bf16*)(ka->ws + WS_W + (size_t)l * W_LAYER + (off)))
__global__ void __launch_bounds__(512, 2) fwd_mega(Args a_unused) {
    extern __shared__ __attribute__((aligned(16))) unsigned char lds_raw[];
    LAS unsigned char* lds = (LAS unsigned char*)lds_raw;
    cg::grid_group grid = cg::this_grid();
    const int G = gridDim.x, bx = blockIdx.x;
    const int wave_s = __builtin_amdgcn_readfirstlane((int)threadIdx.x >> 6);
#define MYTID() ((wave_s << 6) | (int)__builtin_amdgcn_mbcnt_hi(~0u, __builtin_amdgcn_mbcnt_lo(~0u, 0u)))
    if (threadIdx.x < 2) ((volatile LAS unsigned*)(lds + MISC_OFF))[threadIdx.x] = 0u;
    __syncthreads();
    { KArgsP ka = kargs(); (void)xcd_barrier_post((unsigned*)(ka->ws + WS_BAR), (volatile LAS unsigned*)(lds + MISC_OFF)); }
#define GSYNC() do { KArgsP ka_ = kargs(); XcdBarrier b_; b_.bar = (unsigned*)(ka_->ws + WS_BAR); b_.x = xb_xcc_id(); b_.st = (volatile LAS unsigned*)(lds + MISC_OFF); xcd_barrier(b_, MYTID() == 0); } while (0)
#define TIDS int tid_ = MYTID(); asm volatile("" : "+v"(tid_)); const int tid = tid_, lane = tid & 63, wave = __builtin_amdgcn_readfirstlane(tid >> 6), gw = bx * 8 + wave, NGW = G * 8, gtid = bx * 512 + tid, NT = G * 512; (void)lane; (void)gw; (void)NGW; (void)gtid; (void)NT;

#if REP_P0 > 1
    int np0 = REP_P0; asm volatile("" : "+s"(np0));
#pragma unroll 1
    for (int rep0 = 0; rep0 < np0; ++rep0)
#endif
    {
        KArgsP ka = kargs(); TIDS
        unsigned char* ws = ka->ws; float* RS = (float*)(ws + WS_RS); float* LB = (float*)(ws + WS_LB); bf16* XB = (bf16*)(ws + WS_XB);
        LAS float* scr = (LAS float*)(lds + wave * 16384);
        constexpr int I_IN = (DM / 64) * (DIN / 32), I_HG = (HGW / 64) * (DM / 32), I_AT = (ATW / 64) * (DM / 32), I_OUT = (DM / 64) * (DM / 32), I_UP = (DM / 64) * (DFF / 32), I_DN = (DFF / 64) * (DM / 32);
        constexpr int I_LAYER = I_IN + I_HG + I_AT + I_OUT + I_UP + I_DN;
        for (int it = gw; it < 2 * I_LAYER; it += NGW) {
            const int l = it >= I_LAYER ? 1 : 0; int r = it - l * I_LAYER; unsigned char* wl = ws + WS_W + (size_t)l * W_LAYER;
            if (r < I_IN) { transpose_item(ka->w_in + (size_t)l * DM * DIN, ka->norm_mix + l * DM, DM, DIN, (bf16*)(wl + W_IN), scr, r, lane, true); continue; } r -= I_IN;
            if (r < I_HG) { transpose_item(ka->w_hg_out + (size_t)l * HGW * DM, nullptr, HGW, DM, (bf16*)(wl + W_HG), scr, r, lane); continue; } r -= I_HG;
            if (r < I_AT) { transpose_item(ka->w_at_out + (size_t)l * ATW * DM, nullptr, ATW, DM, (bf16*)(wl + W_AT), scr, r, lane); continue; } r -= I_AT;
            if (r < I_OUT) { transpose_item(ka->w_out + (size_t)l * DM * DM, nullptr, DM, DM, (bf16*)(wl + W_OUT), scr, r, lane); continue; } r -= I_OUT;
            if (r < I_UP) { transpose_item(ka->w_up + (size_t)l * DM * DFF, ka->norm_ffn + l * DM, DM, DFF, (bf16*)(wl + W_UP), scr, r, lane); continue; } r -= I_UP;
            transpose_item(ka->w_down + (size_t)l * DFF * DM, nullptr, DFF, DM, (bf16*)(wl + W_DN), scr, r, lane);
        }
        for (int c = gtid; c < 1024; c += NT) { LB[c] = 0.f; LB[1024 + c] = sigm(ka->lb_logits[1024 + c] - ka->lb_logits[c]); }
        const float* x = ka->x;
        for (int m = gw; m < MTOK; m += NGW) {
            const f32x4* xr = (const f32x4*)(x + (size_t)m * DM) + lane; f32x4 v[8]; float s = 0.f;
#pragma unroll
            for (int j = 0; j < 8; ++j) { v[j] = xr[64 * j]; s += (v[j][0] * v[j][0] + v[j][1] * v[j][1]) + (v[j][2] * v[j][2] + v[j][3] * v[j][3]); }
            s = wave_sum(s);
            if (lane == 0) RS[m] = rsqrtf(s * (1.f / DM) + EPSF);
            u32x2* o8 = (u32x2*)(XB + (size_t)m * DM) + lane;
#pragma unroll
            for (int j = 0; j < 8; ++j) { u32x2 w; w.x = pk2(v[j][0], v[j][1]); w.y = pk2(v[j][2], v[j][3]); o8[64 * j] = w; }
        }
    }
    { KArgsP ka = kargs(); if (ka->ws == nullptr) grid.sync(); }
    GSYNC();

    for (int l = 0; l < 2; ++l) {
        if (ON(1)) {
            KArgsP ka = kargs();
            pg8::Gemm g{(const bf16*)(ka->ws + WS_XB), WL(W_IN), MTOK, DIN, DM}; pg8::StaticOrder S; S.init(MTOK, DIN - 256, G, bx, REP_G1);
            { TIDS if (l == 0) fill_rs_table<false>(lds, S, (const float*)(ka->ws + WS_RS), tid); else fill_rs_table<true>(lds, S, (const float*)(ka->ws + WS_PART), tid); }
            pg8::EpiIn E{(const LAS float*)(lds + RSL_OFF), (const float*)(ka->ws + WS_LB) + l * 1024, ka->ws + WS_Z};
            if (SKEW_G1 > 0 && bx >= G / 2) { const unsigned long long t0 = __builtin_amdgcn_s_memrealtime(); while (__builtin_amdgcn_s_memrealtime() - t0 < (unsigned long long)SKEW_G1) __builtin_amdgcn_s_sleep(32); }
            pg8::gemm_phase<pg8::EpiIn, pg8::StaticOrder, PG_ALIGN, PG_SP2>(lds, g, S, E, MYTID());
        }
        GSYNC();
#if XSYNC > 0
        { int nx = XSYNC; asm volatile("" : "+s"(nx));
#pragma unroll 1
          for (int i = 0; i < nx; ++i) GSYNC(); }
#endif
        {
            KArgsP ka = kargs(); TIDS
#if REP_HA > 1
            int nha = REP_HA; asm volatile("" : "+s"(nha));
#pragma unroll 1
            for (int rha = 0; rha < nha; ++rha)
#endif
            if (ON(2)) { ALoads L;
                for (int item = bx; item < 4096; item += G) hgrn_a_item(lds, L, (const bf16*)ZP(Z_LOGF), (const bf16*)ZP(Z_VI), (bf16*)ka->out, (float*)(ka->ws + WS_D), item, item + G < 4096 ? item + G : -1, tid); }
        }
        GSYNC();
        if (ON(2)) { KArgsP ka = kargs(); TIDS hgrn_scan((bf16*)ka->out, (bf16*)ka->out, (const float*)(ka->ws + WS_D), gtid, NT); }
        if (ON(5)) {
            KArgsP ka = kargs();
#define G1_LAST_PANEL(PM) do { pg8::Gemm g{(const bf16*)(ka->ws + WS_XB), WL(W_IN), MTOK, DIN, DM}; pg8::OneOrder S1{(PM), DIN / 256 - 1}; \
                if (l == 0) fill_rs_one<false>(lds, (PM), (const float*)(ka->ws + WS_RS), MYTID()); else fill_rs_one<true>(lds, (PM), (const float*)(ka->ws + WS_PART), MYTID()); \
                pg8::EpiIn E{(const LAS float*)(lds + RSL_OFF), (const float*)(ka->ws + WS_LB) + l * 1024, ka->ws + WS_Z}; \
                pg8::gemm_phase<pg8::EpiIn, pg8::OneOrder, PG_ALIGN, PG_SP2>(lds, g, S1, E, MYTID()); __syncthreads(); } while (0)
            if (G == 256) { if (bx >= 128) G1_LAST_PANEL(bx - 128); }
            else for (int pmx = bx; pmx < MTOK / 256; pmx += G) G1_LAST_PANEL(pmx);
        }
        {
            KArgsP ka = kargs(); TIDS
#define ATT(ITEM) attn_item(lds, (bf16*)ZP(Z_AQ), (bf16*)ZP(Z_AQ), (const bf16*)ZP(Z_AKV), ka->sinks + l * 16, ka->q_norm + l * 64, ka->k_norm + l * 64, (ITEM), tid)
            if (ON(5)) {
                if (G == 256) {
                    if (bx >= 128) {
#pragma unroll 1
                        for (int k = 0; k < 2; ++k) ATT(768 + 128 * k + (bx - 128)); }
                    else {
#pragma unroll 1
                        for (int k = 0; k < 6; ++k) ATT(bx + 128 * k); }
                } else for (int item = bx; item < 1024; item += G) ATT(item);
            }
        }
        GSYNC();
        {
            KArgsP ka = kargs(); TIDS
            if (ON(4)) { CLoads L;
#define HGC_RUN(DST) do { { const int it0 = bx & 4095; hg_issue1(L.a, (const bf16*)ZP(Z_LOGF), (const bf16*)ZP(Z_VI), it0, tid); hgc_issue_st(L, (const bf16*)ka->out, it0, tid); hgc_issue_r(L, (const bf16*)ZP(Z_QF), (const bf16*)ZP(Z_LOGF), it0, tid); } \
                for (int item = bx; item < 4096; item += G) hgrn_c_item(lds, L, (const bf16*)ZP(Z_QF), (const bf16*)ZP(Z_LOGF), (const bf16*)ZP(Z_VI), (const bf16*)ka->out, (bf16*)ZP(Z_HGATE), (DST), ka->hg_norm + l * 128, item, item + G < 4096 ? item + G : -1, tid); } while (0)
#if REP_MIX & 4
                for (int rr_ = 0; rr_ < 4; ++rr_) if (l == 0) HGC_RUN((bf16*)ka->out + (size_t)MTOK * 2048);
#endif
                HGC_RUN((bf16*)ZP(Z_HGATE)); }
        }
        GSYNC();
        if (ON(6)) {
            KArgsP ka = kargs();
            pg8::Gemm g{(const bf16*)ZP(Z_HGATE), WL(W_HG), MTOK, DM, HGW, (const bf16*)ZP(Z_AQ), WL(W_AT)}; pg8::DualOrder S; S.b.init(MTOK, DM, G, bx, 1);
            pg8::EpiMix E{(const bf16*)ZP(Z_GH), (const bf16*)ZP(Z_GA), (bf16*)ZP(Z_MIX)};
            pg8::gemm_phase<pg8::EpiMix, pg8::DualOrder, PG_ALIGN, PG_SP2, true>(lds, g, S, E, MYTID());
        }
        GSYNC();
        if (ON(8)) {
            KArgsP ka = kargs();
            pg8::Gemm g{(const bf16*)ZP(Z_MIX), WL(W_OUT), MTOK, DM, DM}; pg8::StaticOrder S; S.init(MTOK, DM, G, bx, REP_G46);
            pg8::EpiRes E{(const bf16*)(ka->ws + WS_XB), nullptr, (bf16*)(ka->ws + WS_XB), (float*)(ka->ws + WS_PART)};
            pg8::gemm_phase<pg8::EpiRes, pg8::StaticOrder, PG_ALIGN, PG_SP2>(lds, g, S, E, MYTID());
        }
        GSYNC();
        if (ON(9)) {
            KArgsP ka = kargs();
            pg8::Gemm g{(const bf16*)(ka->ws + WS_XB), WL(W_UP), MTOK, DFF, DM}; pg8::StaticOrder S; S.init(MTOK, DFF, G, bx, REP_G5);
            { TIDS fill_rs_table<true>(lds, S, (const float*)(ka->ws + WS_PART), tid); }
            pg8::EpiUp E{(const LAS float*)(lds + RSL_OFF), (bf16*)ZP(Z_U)};
            if (SKEW_G5 > 0 && bx >= G / 2) { const unsigned long long t0 = __builtin_amdgcn_s_memrealtime(); while (__builtin_amdgcn_s_memrealtime() - t0 < (unsigned long long)SKEW_G5) __builtin_amdgcn_s_sleep(32); }
            pg8::gemm_phase<pg8::EpiUp, pg8::StaticOrder, PG_ALIGN, PG_SP2>(lds, g, S, E, MYTID());
        }
        GSYNC();
        if (ON(10)) {
            KArgsP ka = kargs();
            pg8::Gemm g{(const bf16*)ZP(Z_U), WL(W_DN), MTOK, DM, DFF}; pg8::StaticOrder S; S.init(MTOK, DM, G, bx, REP_G46);
            pg8::EpiRes E{(const bf16*)(ka->ws + WS_XB), l == 0 ? nullptr : ka->out, (bf16*)(ka->ws + WS_XB), (float*)(ka->ws + WS_PART)};
            pg8::gemm_phase<pg8::EpiRes, pg8::StaticOrder, PG_ALIGN, PG_SP2>(lds, g, S, E, MYTID());
        }
        if (l == 0) GSYNC();
    }
}

extern "C" void kernel_launch(void* const* d_in, const int* in_sizes, int n_in, void* d_out, int out_size, void* d_ws, size_t ws_size, hipStream_t stream) {
    static int grid = 0;
    if (grid == 0) {
        if (n_in != 14 || out_size != MTOK * DM || ws_size < WS_END) { fprintf(stderr, "kernel_launch: unexpected shapes (n_in %d out %d ws %zu need %zu)\n", n_in, out_size, ws_size, (size_t)WS_END); grid = -1; return; }
        int dev = 0, cus = 0, per_cu = 0;
        (void)hipGetDevice(&dev); (void)hipDeviceGetAttribute(&cus, hipDeviceAttributeMultiprocessorCount, dev);
        if (hipFuncSetAttribute((const void*)fwd_mega, hipFuncAttributeMaxDynamicSharedMemorySize, LDS_BYTES) != hipSuccess) { fprintf(stderr, "hipFuncSetAttribute failed\n"); grid = -1; return; }
        if (hipOccupancyMaxActiveBlocksPerMultiprocessor(&per_cu, (const void*)fwd_mega, 512, LDS_BYTES) != hipSuccess || per_cu < 1) { fprintf(stderr, "occupancy query: %d\n", per_cu); per_cu = 1; }
        (void)hipGetLastError();
        grid = cus * 1;
    }
    if (grid < 0) return;
    (void)hipMemsetAsync((unsigned char*)d_ws + WS_BAR, 0, 16384, stream);
    Args a{};
    a.x = (const float*)d_in[0]; a.norm_mix = (const float*)d_in[1]; a.w_in = (const float*)d_in[2]; a.lb_logits = (const float*)d_in[3]; a.hg_norm = (const float*)d_in[4];
    a.q_norm = (const float*)d_in[5]; a.k_norm = (const float*)d_in[6]; a.sinks = (const float*)d_in[7]; a.w_hg_out = (const float*)d_in[8]; a.w_at_out = (const float*)d_in[9];
    a.w_out = (const float*)d_in[10]; a.norm_ffn = (const float*)d_in[11]; a.w_up = (const float*)d_in[12]; a.w_down = (const float*)d_in[13];
    a.out = (float*)d_out; a.ws = (unsigned char*)d_ws;
    void* args[] = {&a};
    hipError_t e = hipLaunchCooperativeKernel((const void*)fwd_mega, dim3(grid), dim3(512), args, LDS_BYTES, stream);
    if (e != hipSuccess) fprintf(stderr, "cooperative launch failed: %s (grid %d)\n", hipGetErrorString(e), grid);
}
```

```cpp
#include <hip/hip_runtime.h>
#include <hip/hip_cooperative_groups.h>
#include <cstdio>
#include <cstdint>
namespace cg = cooperative_groups;
namespace pg8 {
#define PG8_LAS __attribute__((address_space(3)))
typedef unsigned short bf16_t;
typedef short bf16x8 __attribute__((ext_vector_type(8)));
typedef float f32x4 __attribute__((ext_vector_type(4)));
typedef unsigned u32x4 __attribute__((ext_vector_type(4)));
constexpr int BM = 256, BK = 64, HALF = 128, HTB = HALF * BK * 2  , STAGE_BYTES = 8 * HTB, NXCD = 8;
#ifndef PG_WGM
#define PG_WGM 4
#endif
constexpr int WGM = PG_WGM;

__host__ __device__ __forceinline__ int lds_byte(int r, int c) { const int st = (r >> 4) * 2 + (c >> 5), rr = r & 15, cc = c & 31, ob = rr * 64 + cc * 2; return st * 1024 + (ob ^ (((ob >> 9) & 1) << 5)); }
__host__ __device__ __forceinline__ void stage_rc(int b, int& R, int& C) { const int st = b / 1024, sb = b % 1024, swz = sb ^ (((sb >> 9) & 1) << 5); R = (st >> 1) * 16 + swz / 64; C = (st & 1) * 32 + (swz % 64) / 2; }
__host__ __device__ __forceinline__ int perm32(int rho) { const int n = rho >> 4, i = rho & 15; return 8 * (i >> 2) + 4 * n + (i & 3); }

struct Unit { int pm, pn, pass, slot; };
struct Gemm { const bf16_t* A; const bf16_t* Bt; int M, N, K; const bf16_t* A2; const bf16_t* Bt2; };

struct StaticOrder {
    int nM, nN, nwg, G, c, rep;
    __host__ __device__ void init(int M, int N, int G_, int c_, int rep_ = 1) { nM = M / BM; nN = N / BM; nwg = nM * nN; G = G_; c = c_; rep = rep_; }
    __host__ __device__ bool next(int i, Unit& u) const {
        int L = i * G + c; if (L >= nwg * rep) return false; u.pass = 0; if (L >= nwg) { L -= nwg; u.pass = 1; }
        int wgid = (int)L; { const int q = nwg / NXCD, r = nwg % NXCD, xcd = wgid % NXCD, off = wgid / NXCD; wgid = (xcd < r ? xcd * (q + 1) : r * (q + 1) + (xcd - r) * q) + off; }
        const int nig = WGM * nN, gid = wgid / nig, fm = gid * WGM, gsz = (nM - fm) < WGM ? (nM - fm) : WGM;
        u.slot = gid - ((L % NXCD) * (nwg / NXCD)) / nig;
        u.pm = fm + ((wgid % nig) % gsz); u.pn = (wgid % nig) / gsz; return true;
    }
    __device__ __forceinline__ void a_ready(const Unit&) const {}
    __device__ __forceinline__ void done(const Unit&) const {}
};
struct OneOrder {
    int pm, pn;
    __host__ __device__ bool next(int i, Unit& u) const { if (i != 0) return false; u.pm = pm; u.pn = pn; u.pass = 0; u.slot = 0; return true; }
    __device__ __forceinline__ void a_ready(const Unit&) const {}
    __device__ __forceinline__ void done(const Unit&) const {}
};
struct DualOrder {
    StaticOrder b;
    __host__ __device__ bool next(int i, Unit& u) const { if (!b.next(i >> 1, u)) return false; u.pass = i & 1; return true; }
    __device__ __forceinline__ void a_ready(const Unit&) const {}
    __device__ __forceinline__ void done(const Unit&) const {}
};
__device__ __forceinline__ unsigned cvt_pk_bf16(float lo, float hi) { unsigned r; asm volatile("v_cvt_pk_bf16_f32 %0, %1, %2" : "=v"(r) : "v"(lo), "v"(hi)); return r; }
typedef float f32x2 __attribute__((ext_vector_type(2)));
template <class Epi, class Sched, bool ALIGN_EPI = false, bool SP2 = false, bool DUAL = false>
__device__ __forceinline__ void gemm_phase(PG8_LAS unsigned char* lds, const Gemm g, const Sched& S, const Epi& E, int tid_in) {
    int tid_ = tid_in; asm volatile("" : "+v"(tid_));
    const int tid = tid_, wid = __builtin_amdgcn_readfirstlane(tid >> 6), lane = tid & 63, wr = wid >> 2, wc = wid & 3, fr = lane & 15, fq = lane >> 4;
    const int K = g.K, nt = K / BK;
    unsigned voffA[2], voffB[2];
#pragma unroll
    for (int i = 0; i < 2; ++i) { int R, C; stage_rc(tid * 16 + i * 8192, R, C); const int Rb = Epi::PERM ? ((R & ~31) + perm32(R & 31)) : R;
        voffA[i] = (unsigned)(R * K + C) * 2u; voffB[i] = (unsigned)(Rb * K + C) * 2u; }
    const size_t kstep = (size_t)(BK * 2);
    const size_t hstep = (size_t)HALF * K * 2;
    const size_t tstep = 2 * hstep;
    const unsigned ldsw = (unsigned)wid * 1024u;
    const int aoff = lds_byte(wr * 64 + fr, fq * 8), boff = lds_byte(wc * 32 + fr, fq * 8);
#define PG8_SA(b, h) (((b) * 2 + (h)) * HTB)
#define PG8_SB(b, h) ((4 + (b) * 2 + (h)) * HTB)
#define PG8_STAGE(bufoff, gbase, voff) do { _Pragma("unroll") for (int _i = 0; _i < 2; ++_i) \
        __builtin_amdgcn_global_load_lds((const unsigned*)((const char*)(gbase) + (voff)[_i]), (PG8_LAS unsigned*)(lds + (bufoff) + ldsw + _i * 8192), 16, 0, 0); } while (0)
#define PG8_LDA(dst, b, h) do { _Pragma("unroll") for (int m = 0; m < 4; ++m) _Pragma("unroll") for (int k = 0; k < 2; ++k) dst[m][k] = *(const PG8_LAS bf16x8*)(lds + PG8_SA(b, h) + aoff + m * 2048 + k * 1024); } while (0)
#define PG8_LDB(dst, b, h) do { _Pragma("unroll") for (int n = 0; n < 2; ++n) _Pragma("unroll") for (int k = 0; k < 2; ++k) dst[n][k] = *(const PG8_LAS bf16x8*)(lds + PG8_SB(b, h) + boff + n * 2048 + k * 1024); } while (0)
#define PG8_MMA(ai, bj, At, Bt) do { __builtin_amdgcn_s_setprio(1); _Pragma("unroll") for (int m = 0; m < 4; ++m) _Pragma("unroll") for (int n = 0; n < 2; ++n) _Pragma("unroll") for (int k = 0; k < 2; ++k) \
        acc[ai][bj][m][n] = __builtin_amdgcn_mfma_f32_16x16x32_bf16(Bt[n][k], At[m][k], acc[ai][bj][m][n], 0, 0, 0); __builtin_amdgcn_s_setprio(0); } while (0)
#define PG8_WAIT_V(n) asm volatile("s_waitcnt vmcnt(" #n ")" ::: "memory")
#define PG8_WAIT_L(n) asm volatile("s_waitcnt lgkmcnt(" #n ")" ::: "memory")
#define PG8_BAR __builtin_amdgcn_s_barrier()
#define PG8_SCHED __builtin_amdgcn_sched_barrier(0)
    Unit cur, nxt; int ui = 0;
    if (!S.next(0, cur)) return;
    f32x4 acc[2][2][4][2];
#pragma unroll
    for (int a = 0; a < 2; ++a)
#pragma unroll
        for (int b = 0; b < 2; ++b)
#pragma unroll
            for (int m = 0; m < 4; ++m)
#pragma unroll
                for (int n = 0; n < 2; ++n) acc[a][b][m][n] = (f32x4){0.f, 0.f, 0.f, 0.f};
    bf16x8 At[4][2], B0[2][2], B1[2][2];
    const char* cA = (const char*)((DUAL && cur.pass) ? g.A2 : g.A) + (size_t)cur.pm * tstep; const char* cB = (const char*)((DUAL && cur.pass) ? g.Bt2 : g.Bt) + (size_t)cur.pn * tstep;
    S.a_ready(cur);
    if constexpr (SP2) {
        PG8_STAGE(PG8_SB(0, 0), cB, voffB); PG8_STAGE(PG8_SB(0, 1), cB + hstep, voffB); PG8_STAGE(PG8_SA(0, 0), cA, voffA); PG8_STAGE(PG8_SA(0, 1), cA + hstep, voffA);
        if (wr == 1) PG8_BAR;
        PG8_WAIT_V(2); PG8_BAR;
        PG8_STAGE(PG8_SB(1, 0), cB + kstep, voffB); PG8_STAGE(PG8_SA(1, 0), cA + kstep, voffA); PG8_STAGE(PG8_SB(1, 1), cB + hstep + kstep, voffB);
        PG8_WAIT_V(6); PG8_BAR;
    } else {
        PG8_STAGE(PG8_SB(0, 0), cB, voffB); PG8_STAGE(PG8_SA(0, 0), cA, voffA); PG8_STAGE(PG8_SB(0, 1), cB + hstep, voffB); PG8_STAGE(PG8_SA(0, 1), cA + hstep, voffA);
        if (wr == 1) PG8_BAR;
        PG8_WAIT_V(4); PG8_BAR;
        PG8_STAGE(PG8_SB(1, 0), cB + kstep, voffB); PG8_STAGE(PG8_SA(1, 0), cA + kstep, voffA); PG8_STAGE(PG8_SB(1, 1), cB + hstep + kstep, voffB);
        PG8_WAIT_V(6); PG8_BAR;
    }
    for (;;) {
        const bool has_next = S.next(ui + 1, nxt);
        const char* nA = has_next ? (const char*)((DUAL && nxt.pass) ? g.A2 : g.A) + (size_t)nxt.pm * tstep : cA; const char* nB = has_next ? (const char*)((DUAL && nxt.pass) ? g.Bt2 : g.Bt) + (size_t)nxt.pn * tstep : cB;
        for (int t = 0; t < nt; t += 2) {
            const bool last = (t == nt - 2);
            const char* a1 = cA + (size_t)(t + 1) * kstep;
            const char* a2 = last ? nA : cA + (size_t)(t + 2) * kstep; const char* b2 = last ? nB : cB + (size_t)(t + 2) * kstep;
            const char* a3 = a2 + kstep; const char* b3 = b2 + kstep;
            if (last && has_next) S.a_ready(nxt);
            if constexpr (SP2) {
            PG8_LDB(B0, 0, 0); PG8_LDB(B1, 0, 1); PG8_SCHED; PG8_LDA(At, 0, 0); PG8_STAGE(PG8_SA(1, 1), a1 + hstep, voffA);
            PG8_WAIT_V(8); PG8_WAIT_L(0); PG8_BAR; PG8_MMA(0, 0, At, B0); PG8_MMA(0, 1, At, B1); PG8_BAR; PG8_SCHED;
            PG8_LDA(At, 0, 1); PG8_STAGE(PG8_SB(0, 0), b2, voffB); PG8_STAGE(PG8_SB(0, 1), b2 + hstep, voffB); PG8_STAGE(PG8_SA(0, 0), a2, voffA);
            PG8_WAIT_V(8); PG8_WAIT_L(0); PG8_BAR; PG8_MMA(1, 0, At, B0); PG8_MMA(1, 1, At, B1); PG8_BAR; PG8_SCHED;
            PG8_LDB(B0, 1, 0); PG8_LDB(B1, 1, 1); PG8_SCHED; PG8_LDA(At, 1, 0); PG8_STAGE(PG8_SA(0, 1), a2 + hstep, voffA);
            PG8_WAIT_V(8); PG8_WAIT_L(0); PG8_BAR; PG8_MMA(0, 0, At, B0); PG8_MMA(0, 1, At, B1); PG8_BAR; PG8_SCHED;
            PG8_LDA(At, 1, 1); PG8_STAGE(PG8_SB(1, 0), b3, voffB); PG8_STAGE(PG8_SB(1, 1), b3 + hstep, voffB); PG8_STAGE(PG8_SA(1, 0), a3, voffA);
            PG8_WAIT_V(8); PG8_WAIT_L(0); PG8_BAR; PG8_MMA(1, 0, At, B0); PG8_MMA(1, 1, At, B1); PG8_BAR; PG8_SCHED;
            } else {
            PG8_LDB(B0, 0, 0); PG8_SCHED; PG8_LDA(At, 0, 0); PG8_STAGE(PG8_SA(1, 1), a1 + hstep, voffA);
            PG8_WAIT_L(8); PG8_BAR; PG8_WAIT_L(0); PG8_MMA(0, 0, At, B0); PG8_BAR; PG8_SCHED;
            PG8_LDB(B1, 0, 1); PG8_STAGE(PG8_SB(0, 0), b2, voffB);
            PG8_BAR; PG8_WAIT_L(0); PG8_MMA(0, 1, At, B1); PG8_BAR;
            PG8_LDA(At, 0, 1); PG8_STAGE(PG8_SA(0, 0), a2, voffA);
            PG8_BAR; PG8_WAIT_L(0); PG8_MMA(1, 0, At, B0); PG8_BAR; PG8_SCHED;
            PG8_STAGE(PG8_SB(0, 1), b2 + hstep, voffB);
            PG8_WAIT_V(6); PG8_BAR; PG8_MMA(1, 1, At, B1); PG8_BAR;
            PG8_LDB(B0, 1, 0); PG8_SCHED; PG8_LDA(At, 1, 0); PG8_STAGE(PG8_SA(0, 1), a2 + hstep, voffA);
            PG8_WAIT_L(8); PG8_BAR; PG8_WAIT_L(0); PG8_MMA(0, 0, At, B0); PG8_BAR; PG8_SCHED;
            PG8_LDB(B1, 1, 1); PG8_STAGE(PG8_SB(1, 0), b3, voffB);
            PG8_BAR; PG8_WAIT_L(0); PG8_MMA(0, 1, At, B1); PG8_BAR;
            PG8_LDA(At, 1, 1); PG8_STAGE(PG8_SA(1, 0), a3, voffA);
            PG8_BAR; PG8_WAIT_L(0); PG8_MMA(1, 0, At, B0); PG8_BAR; PG8_SCHED;
            PG8_STAGE(PG8_SB(1, 1), b3 + hstep, voffB);
            PG8_WAIT_V(6); PG8_BAR; PG8_MMA(1, 1, At, B1); PG8_BAR;
            }
        }
        if constexpr (ALIGN_EPI) { if (wr == 0) PG8_BAR; }
        if constexpr (DUAL) { if (cur.pass == 0) E.mid(acc, cur, wr, wc, fr, fq); else E(acc, cur, wr, wc, fr, fq); }
        else if constexpr (!Epi::AFTER_DRAIN) { E(acc, cur, wr, wc, fr, fq); S.done(cur); }
        if (!has_next) break;
        if (!(DUAL && cur.pass == 0))
#pragma unroll
        for (int a = 0; a < 2; ++a)
#pragma unroll
            for (int b = 0; b < 2; ++b)
#pragma unroll
                for (int m = 0; m < 4; ++m)
#pragma unroll
                    for (int n = 0; n < 2; ++n) acc[a][b][m][n] = (f32x4){0.f, 0.f, 0.f, 0.f};
        cur = nxt; cA = nA; cB = nB; ++ui;
        if constexpr (ALIGN_EPI) { if (wr == 1) PG8_BAR; }
    }
    PG8_WAIT_V(0);
    if constexpr (!ALIGN_EPI) { if (wr == 0) PG8_BAR; }
    PG8_BAR;
    if constexpr (Epi::AFTER_DRAIN) { E.fused(acc, cur, wr, wc, fr, fq, lds, wid, lane); S.done(cur); }
#undef PG8_SA
#undef PG8_SB
#undef PG8_STAGE
#undef PG8_LDA
#undef PG8_LDB
#undef PG8_MMA
#undef PG8_WAIT_V
#undef PG8_WAIT_L
#undef PG8_BAR
#undef PG8_SCHED
}
}

constexpr int BATCH = 2, SEQ = 16384, DM = 2048, MTOK = BATCH * SEQ;
constexpr int HGH = 8, HGD = 128, HGW = 1024;
constexpr int ATH = 16, ATD = 64, ATW = 1024, WIN = 128;
constexpr int DIN = 9472, DFF = 8192;
constexpr float EPSF = 1e-6f;

#define LAS __attribute__((address_space(3)))
typedef unsigned short bf16;
typedef float f32x4 __attribute__((ext_vector_type(4)));
typedef unsigned u32x4 __attribute__((ext_vector_type(4)));
typedef unsigned u32x2 __attribute__((ext_vector_type(2)));

__device__ __forceinline__ float sigm(float x) { return __builtin_amdgcn_rcpf(1.f + __expf(-x)); }
__device__ __forceinline__ float bflo(unsigned w) { return __uint_as_float(w << 16); }
__device__ __forceinline__ float bfhi(unsigned w) { return __uint_as_float(w & 0xffff0000u); }
typedef __bf16 bf16x2_t __attribute__((ext_vector_type(2)));
typedef float f32x2_t __attribute__((ext_vector_type(2)));
__device__ __forceinline__ unsigned pk2(float lo, float hi) { const f32x2_t v = {lo, hi}; const bf16x2_t b = __builtin_convertvector(v, bf16x2_t); return __builtin_bit_cast(unsigned, b); }

constexpr size_t WS_RS = 0;
constexpr size_t WS_LB = 131072;
constexpr size_t WS_BAR = 196608;
constexpr size_t WS_PART = 262144;
constexpr size_t WS_W = WS_PART + (size_t)MTOK * 32 * 4;
constexpr size_t W_IN = 0, W_HG = W_IN + (size_t)DIN * DM * 2, W_AT = W_HG + (size_t)DM * HGW * 2, W_OUT = W_AT + (size_t)DM * ATW * 2,
                 W_UP = W_OUT + (size_t)DM * DM * 2, W_DN = W_UP + (size_t)DFF * DM * 2, W_LAYER = W_DN + (size_t)DM * DFF * 2;
constexpr size_t WS_XB = WS_W + 2 * W_LAYER;
constexpr size_t WS_Z = WS_XB + (size_t)MTOK * DM * 2;
constexpr size_t Z_QF = 0, Z_LOGF = Z_QF + (size_t)MTOK * 1024 * 2, Z_VI = Z_LOGF + (size_t)MTOK * 1024 * 4, Z_HGATE = Z_VI + (size_t)MTOK * 1024 * 2,
                 Z_AQ = Z_HGATE + (size_t)MTOK * 1024 * 2, Z_AKV = Z_AQ + (size_t)MTOK * 1024 * 2, Z_GH = Z_AKV + (size_t)MTOK * 256 * 2,
                 Z_GA = Z_GH + (size_t)MTOK * 2048 * 2, Z_END = Z_GA + (size_t)MTOK * 2048 * 2;
constexpr size_t Z_T1 = 0, Z_MIX = (size_t)MTOK * 2048 * 2;
constexpr size_t Z_U = 0;
constexpr size_t WS_D = WS_Z + Z_LOGF + (size_t)MTOK * 1024 * 2;
constexpr size_t WS_END = WS_Z + Z_END;
static_assert(Z_MIX + (size_t)MTOK * 2048 * 2 <= Z_HGATE, "T1|MIX overlay");
static_assert((size_t)MTOK * DFF * 2 <= Z_END, "U overlay");
static_assert(WS_END <= 1073741824ull, "workspace");

constexpr int LDS_BYTES = 147456;
#ifndef PH
#define PH 0xFFFF
#endif
#define ON(k) ((PH >> (k)) & 1)
#ifndef REP_G1
#define REP_G1 1
#endif
#ifndef REP_G5
#define REP_G5 1
#endif
#ifndef REP_G23
#define REP_G23 1
#endif
#ifndef PG_ALIGN
#define PG_ALIGN true
#endif
#ifndef PG_SP2
#define PG_SP2 true
#endif
#ifndef REP_G46
#define REP_G46 1
#endif
#ifndef REP_MIX
#define REP_MIX 0
#endif
#ifndef SKEW_G1
#define SKEW_G1 0
#endif
#ifndef SKEW_G5
#define SKEW_G5 0
#endif
#ifndef NT_ST
#define NT_ST 0
#endif
#ifndef REP_P0
#define REP_P0 1
#endif
#ifndef XSYNC
#define XSYNC 0
#endif
#ifndef REP_HA
#define REP_HA 1
#endif

namespace pg8 {
__device__ __forceinline__ void st16(u32x4* p, u32x4 v) { if (NT_ST) __builtin_nontemporal_store(v, p); else *p = v; }
struct EpiIn {
    static constexpr bool PERM = true, AFTER_DRAIN = false;
    const PG8_LAS float* rsl; const float* lb; unsigned char* Z;
    __device__ __forceinline__ void operator()(const f32x4 (&acc)[2][2][4][2], const Unit& u, int wr, int wc, int fr, int fq) const {
        const int pn = u.pn; int kind, ld, tb; size_t zo;
        if (pn < 4)       { kind = 0; zo = Z_QF;    ld = 1024; tb = pn * 256; }
        else if (pn < 8)  { kind = 1; zo = Z_LOGF;  ld = 1024; tb = (pn - 4) * 256; }
        else if (pn < 12) { kind = 2; zo = Z_VI;    ld = 1024; tb = (pn - 8) * 256; }
        else if (pn < 16) { kind = 0; zo = Z_HGATE; ld = 1024; tb = (pn - 12) * 256; }
        else if (pn < 20) { kind = 2; zo = Z_AQ;    ld = 1024; tb = (pn - 16) * 256; }
        else if (pn == 20){ kind = 2; zo = Z_AKV;   ld = 256;  tb = 0; }
        else              { kind = 4; zo = Z_GH;    ld = 2048; tb = (pn - 21) * 128; }
        const int row0 = u.pm * BM + wr * 64 + fr, col0 = tb + wc * 32 + 8 * fq;
        if (kind == 4) {
            bf16_t* Rb = (bf16_t*)(Z + Z_GH); bf16_t* Ab = (bf16_t*)(Z + Z_GA);
#pragma unroll
            for (int ai = 0; ai < 2; ++ai)
#pragma unroll
                for (int m = 0; m < 4; ++m) { const int row = row0 + ai * HALF + m * 16; const float s = rsl[u.slot * 256 + (row - u.pm * BM)]; const size_t off = (size_t)row * 2048 + col0;
                    float rr[8], gg[8];
#pragma unroll
                    for (int n = 0; n < 2; ++n) { const f32x4 zh = acc[ai][0][m][n] * s, za = acc[ai][1][m][n] * s;
#pragma unroll
                        for (int e = 0; e < 4; ++e) { const float ea1 = 1.f + __expf(-za[e]), sh = __builtin_amdgcn_rcpf(1.f + __expf(-zh[e])); rr[4 * n + e] = ea1 * sh; gg[4 * n + e] = __builtin_amdgcn_rcpf(ea1); } }
                    u32x4 w; w.x = pk2(rr[0], rr[1]); w.y = pk2(rr[2], rr[3]); w.z = pk2(rr[4], rr[5]); w.w = pk2(rr[6], rr[7]);
                    *(u32x4*)(Rb + off) = w;
                    w.x = pk2(gg[0], gg[1]); w.y = pk2(gg[2], gg[3]); w.z = pk2(gg[4], gg[5]); w.w = pk2(gg[6], gg[7]);
                    *(u32x4*)(Ab + off) = w; }
        } else if (kind == 1) {
            bf16_t* LOGF = (bf16_t*)(Z + zo);
            f32x4 lbv[2][2];
#pragma unroll
            for (int bj = 0; bj < 2; ++bj)
#pragma unroll
                for (int n = 0; n < 2; ++n) lbv[bj][n] = *(const f32x4*)(lb + col0 + bj * HALF + 4 * n);
#pragma unroll
            for (int ai = 0; ai < 2; ++ai)
#pragma unroll
                for (int m = 0; m < 4; ++m) { const int row = row0 + ai * HALF + m * 16; const float s = rsl[u.slot * 256 + (row - u.pm * BM)]; bf16_t* rp = LOGF + (size_t)row * 1024 + col0;
#pragma unroll
                    for (int bj = 0; bj < 2; ++bj) { f32x4 o[2];
#pragma unroll
                        for (int n = 0; n < 2; ++n) { const f32x4 v = acc[ai][bj][m][n] * s;
#pragma unroll
                            for (int e = 0; e < 4; ++e) { const float l = lbv[bj][n][e]; o[n][e] = __log2f(l + (1.f - l) * sigm(v[e])); } }
                        u32x4 w; w.x = pk2(o[0][0], o[0][1]); w.y = pk2(o[0][2], o[0][3]); w.z = pk2(o[1][0], o[1][1]); w.w = pk2(o[1][2], o[1][3]);
                        st16((u32x4*)(rp + bj * HALF), w); } }
        } else {
            bf16_t* dst = (bf16_t*)(Z + zo);
#pragma unroll
            for (int ai = 0; ai < 2; ++ai)
#pragma unroll
                for (int m = 0; m < 4; ++m) { const int row = row0 + ai * HALF + m * 16; const float s = rsl[u.slot * 256 + (row - u.pm * BM)]; bf16_t* rp = dst + (size_t)row * ld + col0;
#pragma unroll
                    for (int bj = 0; bj < 2; ++bj) { f32x4 v0 = acc[ai][bj][m][0] * s, v1 = acc[ai][bj][m][1] * s;
                        if (kind == 0) {
#pragma unroll
                            for (int e = 0; e < 4; ++e) { v0[e] = v0[e] * sigm(v0[e]); v1[e] = v1[e] * sigm(v1[e]); }
                        }
                        u32x4 w; w.x = pk2(v0[0], v0[1]); w.y = pk2(v0[2], v0[3]); w.z = pk2(v1[0], v1[1]); w.w = pk2(v1[2], v1[3]);
                        st16((u32x4*)(rp + bj * HALF), w); } }
        }
    }
};
struct EpiMix {
    static constexpr bool PERM = true, AFTER_DRAIN = false;
    const bf16_t* gh; const bf16_t* ga; bf16_t* dst;
    __device__ __forceinline__ void mid(f32x4 (&acc)[2][2][4][2], const Unit& u, int wr, int wc, int fr, int fq) const {
        const int row0 = u.pm * BM + wr * 64 + fr, col0 = u.pn * BM + wc * 32 + 8 * fq;
#pragma unroll
        for (int ai = 0; ai < 2; ++ai)
#pragma unroll
            for (int m = 0; m < 4; ++m) { const size_t off = (size_t)(row0 + ai * HALF + m * 16) * 2048 + col0;
#pragma unroll
                for (int bj = 0; bj < 2; ++bj) { const u32x4 g = *(const u32x4*)(gh + off + bj * HALF);
                    acc[ai][bj][m][0][0] *= bflo(g.x); acc[ai][bj][m][0][1] *= bfhi(g.x); acc[ai][bj][m][0][2] *= bflo(g.y); acc[ai][bj][m][0][3] *= bfhi(g.y);
                    acc[ai][bj][m][1][0] *= bflo(g.z); acc[ai][bj][m][1][1] *= bfhi(g.z); acc[ai][bj][m][1][2] *= bflo(g.w); acc[ai][bj][m][1][3] *= bfhi(g.w); } }
    }
    __device__ __forceinline__ void operator()(const f32x4 (&acc)[2][2][4][2], const Unit& u, int wr, int wc, int fr, int fq) const {
        const int row0 = u.pm * BM + wr * 64 + fr, col0 = u.pn * BM + wc * 32 + 8 * fq;
#pragma unroll
        for (int ai = 0; ai < 2; ++ai)
#pragma unroll
            for (int m = 0; m < 4; ++m) { const size_t off = (size_t)(row0 + ai * HALF + m * 16) * 2048 + col0;
#pragma unroll
                for (int bj = 0; bj < 2; ++bj) { const u32x4 a = *(const u32x4*)(ga + off + bj * HALF);
                    f32x4 v0 = acc[ai][bj][m][0], v1 = acc[ai][bj][m][1];
                    v0[0] *= bflo(a.x); v0[1] *= bfhi(a.x); v0[2] *= bflo(a.y); v0[3] *= bfhi(a.y); v1[0] *= bflo(a.z); v1[1] *= bfhi(a.z); v1[2] *= bflo(a.w); v1[3] *= bfhi(a.w);
                    u32x4 w; w.x = pk2(v0[0], v0[1]); w.y = pk2(v0[2], v0[3]); w.z = pk2(v1[0], v1[1]); w.w = pk2(v1[2], v1[3]);
                    *(u32x4*)(dst + off + bj * HALF) = w; } }
    }
};
struct EpiRes {
    static constexpr bool PERM = true, AFTER_DRAIN = false;
    const bf16_t* resid; float* outf; bf16_t* xb; float* part;
    __device__ __forceinline__ void operator()(const f32x4 (&acc)[2][2][4][2], const Unit& u, int wr, int wc, int fr, int fq) const {
        if (REP_G46 > 1 && u.pass == 0) return;
        const int row0 = u.pm * BM + wr * 64 + fr, col0 = u.pn * BM + wc * 32 + 8 * fq;
#pragma unroll
        for (int ai = 0; ai < 2; ++ai)
#pragma unroll
            for (int m = 0; m < 4; ++m) { const int row = row0 + ai * HALF + m * 16; const size_t off = (size_t)row * 2048 + col0; float ss = 0.f;
#pragma unroll
                for (int bj = 0; bj < 2; ++bj) { const u32x4 rw = *(const u32x4*)(resid + off + bj * HALF);
                    f32x4 o0 = acc[ai][bj][m][0], o1 = acc[ai][bj][m][1];
                    o0[0] += bflo(rw.x); o0[1] += bfhi(rw.x); o0[2] += bflo(rw.y); o0[3] += bfhi(rw.y); o1[0] += bflo(rw.z); o1[1] += bfhi(rw.z); o1[2] += bflo(rw.w); o1[3] += bfhi(rw.w);
                    if (outf) { *(f32x4*)(outf + off + bj * HALF) = o0; *(f32x4*)(outf + off + bj * HALF + 4) = o1; }
                    else { ss += (o0[0] * o0[0] + o0[1] * o0[1]) + (o0[2] * o0[2] + o0[3] * o0[3]) + (o1[0] * o1[0] + o1[1] * o1[1]) + (o1[2] * o1[2] + o1[3] * o1[3]);
                        u32x4 w; w.x = pk2(o0[0], o0[1]); w.y = pk2(o0[2], o0[3]); w.z = pk2(o1[0], o1[1]); w.w = pk2(o1[2], o1[3]);
                        *(u32x4*)(xb + off + bj * HALF) = w; } }
                if (!outf) { ss += __shfl_xor(ss, 16); ss += __shfl_xor(ss, 32); if (fq == 0) part[(size_t)row * 32 + u.pn * 4 + wc] = ss; } }
    }
};
struct EpiUp {
    static constexpr bool PERM = true, AFTER_DRAIN = false;
    const PG8_LAS float* rsl; bf16_t* dst;
    __device__ __forceinline__ void operator()(const f32x4 (&acc)[2][2][4][2], const Unit& u, int wr, int wc, int fr, int fq) const {
        const int row0 = u.pm * BM + wr * 64 + fr, col0 = u.pn * BM + wc * 32 + 8 * fq;
#pragma unroll
        for (int ai = 0; ai < 2; ++ai)
#pragma unroll
            for (int m = 0; m < 4; ++m) { const int row = row0 + ai * HALF + m * 16; const float s = rsl[u.slot * 256 + (row - u.pm * BM)]; bf16_t* rp = dst + (size_t)row * DFF + col0;
#pragma unroll
                for (int bj = 0; bj < 2; ++bj) { f32x4 v0 = acc[ai][bj][m][0] * s, v1 = acc[ai][bj][m][1] * s;
#pragma unroll
                    for (int e = 0; e < 4; ++e) { const float a = fmaxf(v0[e], 0.f), b = fmaxf(v1[e], 0.f); v0[e] = a * a; v1[e] = b * b; }
                    u32x4 w; w.x = pk2(v0[0], v0[1]); w.y = pk2(v0[2], v0[3]); w.z = pk2(v1[0], v1[1]); w.w = pk2(v1[2], v1[3]);
                    st16((u32x4*)(rp + bj * HALF), w); } }
    }
};
}

__device__ __forceinline__ float wave_sum(float v) {
#pragma unroll
    for (int o = 1; o < 64; o <<= 1) v += __shfl_xor(v, o);
    return v;
}
__device__ __forceinline__ int gate_row_remap(int n0) {
    constexpr int G0 = 5376, G1 = 7424;
    if (n0 < G0) return n0;
    if (n0 < G1) { const int q = n0 - G0; return G0 + 256 * (q / 128) + (q % 128); }
    const int q = n0 - G1; return G0 + 256 * (q / 128) + 128 + (q % 128);
}
__device__ __forceinline__ void transpose_item(const float* __restrict__ W, const float* __restrict__ gain, int K, int N, bf16* __restrict__ WT, LAS float* scr, int item, int lane, bool remap = false) {
    const int nblk = N / 32, kb = item / nblk, nb = item % nblk, k0 = 64 * kb, n0 = 32 * nb, nd0 = remap ? gate_row_remap(n0) : n0;
    float wv[32];
#pragma unroll
    for (int i = 0; i < 32; ++i) { const int kk = 2 * i + (lane >> 5); wv[i] = W[(size_t)(k0 + kk) * N + n0 + (lane & 31)]; }
    const float g0 = gain ? gain[k0 + (lane & 63)] : 1.f;
#pragma unroll
    for (int i = 0; i < 32; ++i) { const int kk = 2 * i + (lane >> 5); const float g = __shfl(g0, kk); scr[kk * 33 + (lane & 31)] = wv[i] * g; }
    asm volatile("s_waitcnt lgkmcnt(0)" ::: "memory");
    const int c = lane & 7;
#pragma unroll
    for (int j = 0; j < 4; ++j) { const int n = (lane >> 3) + 8 * j; const LAS float* s = scr + (8 * c) * 33 + n;
        u32x4 o; o.x = pk2(s[0 * 33], s[1 * 33]); o.y = pk2(s[2 * 33], s[3 * 33]); o.z = pk2(s[4 * 33], s[5 * 33]); o.w = pk2(s[6 * 33], s[7 * 33]);
        *(u32x4*)(WT + (size_t)(nd0 + n) * K + k0 + 8 * c) = o; }
    asm volatile("s_waitcnt lgkmcnt(0)" ::: "memory");
}

struct Args {
    const float *x, *norm_mix, *w_in, *lb_logits, *hg_norm, *q_norm, *k_norm, *sinks, *w_hg_out, *w_at_out, *w_out, *norm_ffn, *w_up, *w_down;
    float* out; unsigned char* ws;
};

__device__ __forceinline__ u32x4 headnorm8(u32x4 w, f32x4 g0, f32x4 g1, float scale) {
    float v[8] = {bflo(w.x), bfhi(w.x), bflo(w.y), bfhi(w.y), bflo(w.z), bfhi(w.z), bflo(w.w), bfhi(w.w)};
    float ss = 0.f;
#pragma unroll
    for (int e = 0; e < 8; ++e) ss += v[e] * v[e];
    ss += __shfl_xor(ss, 1); ss += __shfl_xor(ss, 2); ss += __shfl_xor(ss, 4);
    const float r = rsqrtf(ss * (1.f / 64.f) + EPSF) * scale;
    u32x4 o; o.x = pk2(v[0] * r * g0[0], v[1] * r * g0[1]); o.y = pk2(v[2] * r * g0[2], v[3] * r * g0[3]); o.z = pk2(v[4] * r * g1[0], v[5] * r * g1[1]); o.w = pk2(v[6] * r * g1[2], v[7] * r * g1[3]);
    return o;
}
typedef short bf16x8 __attribute__((ext_vector_type(8)));
typedef float f32x2 __attribute__((ext_vector_type(2)));
#define MFMA16(a, b, c) __builtin_amdgcn_mfma_f32_16x16x32_bf16((a), (b), (c), 0, 0, 0)
constexpr int HL_CUM = 0, HL_ABUF = 0, HL_TOT = 32768, HL_REF = 34816, HL_QT = 35840, HL_KST = HL_QT, HL_KT = HL_QT + 17408, HL_QO = HL_KT + 17408,
              HL_VT = HL_QO + 17408, HL_ST = HL_VT + 18432, HL_SS = HL_ST + 34816, HL_END = HL_SS + 512;
static_assert(HL_END <= LDS_BYTES, "HGRN2 LDS map");
struct Prep { float cum[16]; float lf[16]; float ref, last; };
struct ALoads { float lf[16]; unsigned vv[16]; };
struct CLoads { ALoads a; u32x4 st[4]; u32x4 lfR[2]; u32x4 qR[2]; u32x2 hg[4]; f32x4 hnv[4]; };
__device__ __forceinline__ void hg_issue1(ALoads& L, const bf16* __restrict__ LOGF, const bf16* __restrict__ VI, int item, int tid) {
    const int h = item & 7, k = tid & 127, seg = tid >> 7; const size_t tok0 = (size_t)(item >> 3) * 64;
    const bf16* lp = LOGF + (tok0 + 16 * seg) * 1024 + h * 128 + k;
    const bf16* vp = VI + (tok0 + 16 * seg) * 1024 + h * 128 + k;
#pragma unroll
    for (int i = 0; i < 16; ++i) { L.lf[i] = __uint_as_float((unsigned)lp[i * 1024] << 16); L.vv[i] = vp[i * 1024]; }
}
__device__ __forceinline__ void hg_step1(LAS unsigned char* lds, const ALoads& L, int tid, Prep& P, int vt) {
    const int k = tid & 127, seg = tid >> 7;
    float run = 0.f;
#pragma unroll
    for (int i = 0; i < 16; ++i) { P.lf[i] = L.lf[i]; run += L.lf[i]; P.cum[i] = run; }
    LAS float* TOT = (LAS float*)(lds + HL_TOT);
    TOT[seg * 128 + k] = run;
    u32x4 w0, w1;
    w0.x = L.vv[0] | (L.vv[1] << 16); w0.y = L.vv[2] | (L.vv[3] << 16); w0.z = L.vv[4] | (L.vv[5] << 16); w0.w = L.vv[6] | (L.vv[7] << 16);
    w1.x = L.vv[8] | (L.vv[9] << 16); w1.y = L.vv[10] | (L.vv[11] << 16); w1.z = L.vv[12] | (L.vv[13] << 16); w1.w = L.vv[14] | (L.vv[15] << 16);
    *(LAS u32x4*)(lds + vt + (k * 72 + 16 * seg) * 2) = w0; *(LAS u32x4*)(lds + vt + (k * 72 + 16 * seg) * 2 + 16) = w1;
    __syncthreads();
    const float t0 = TOT[k], t1 = TOT[128 + k], t2 = TOT[256 + k], t3 = TOT[384 + k];
    const float off = seg == 0 ? 0.f : seg == 1 ? t0 : seg == 2 ? t0 + t1 : (t0 + t1) + t2;
#pragma unroll
    for (int i = 0; i < 16; ++i) P.cum[i] += off;
    P.ref = t0 + t1; P.last = (t0 + t1) + (t2 + t3);
}
__device__ __forceinline__ void hgrn_a_item(LAS unsigned char* lds, ALoads& L, const bf16* __restrict__ LOGF, const bf16* __restrict__ VI, bf16* __restrict__ UT, float* __restrict__ D, int item, int next, int tid, int par) {
    const int vt = par ? HL_ST : HL_VT;
    (void)next; hg_issue1(L, LOGF, VI, item, tid);
    Prep P; hg_step1(lds, L, tid, P, vt);
    const int k = tid & 127, seg = tid >> 7;
    unsigned pk[8];
#pragma unroll
    for (int i = 0; i < 8; ++i) { const float a = (1.f - __builtin_amdgcn_exp2f(P.lf[2 * i])) * __builtin_amdgcn_exp2f(P.last - P.cum[2 * i]), b = (1.f - __builtin_amdgcn_exp2f(P.lf[2 * i + 1])) * __builtin_amdgcn_exp2f(P.last - P.cum[2 * i + 1]); pk[i] = pk2(a, b); }
    *(LAS u32x4*)(lds + HL_KST + (k * 72 + 16 * seg) * 2) = (u32x4){pk[0], pk[1], pk[2], pk[3]};
    *(LAS u32x4*)(lds + HL_KST + (k * 72 + 16 * seg) * 2 + 16) = (u32x4){pk[4], pk[5], pk[6], pk[7]};
    if (seg == 0) D[(size_t)item * 128 + k] = __builtin_amdgcn_exp2f(P.last);
    __syncthreads();
    const int lane = tid & 63, w = tid >> 6, r = lane & 15, q = lane >> 4;
    bf16x8 af[2];
#pragma unroll
    for (int ks = 0; ks < 2; ++ks) af[ks] = *(const LAS bf16x8*)(lds + HL_KST + ((16 * w + r) * 72 + 32 * ks + 8 * q) * 2);
    bf16* ut = UT + (size_t)item * 16384;
#pragma unroll
    for (int nt = 0; nt < 8; ++nt) { f32x4 acc = {0.f, 0.f, 0.f, 0.f};
#pragma unroll
        for (int ks = 0; ks < 2; ++ks) { const bf16x8 bfr = *(const LAS bf16x8*)(lds + vt + ((16 * nt + r) * 72 + 32 * ks + 8 * q) * 2); acc = MFMA16(af[ks], bfr, acc); }
        u32x2 o; o.x = pk2(acc[0], acc[1]); o.y = pk2(acc[2], acc[3]);
        *(u32x2*)(ut + (16 * nt + r) * 128 + 16 * w + 4 * q) = o; }
}
__device__ __forceinline__ void hgrn_scan(bf16* UT, bf16* SDST, const float* __restrict__ D, int gtid, int NT) {
    for (int e = gtid; e < 16 * 8192; e += NT) {
        const int bh = e >> 13, off = (e & 8191) * 2, b = bh >> 3, h = bh & 7, k = off & 127;
        unsigned* up = (unsigned*)(UT + ((size_t)(b * 256) * 8 + h) * 16384 + off);
        unsigned* sp = (unsigned*)(SDST + ((size_t)(b * 256) * 8 + h) * 16384 + off);
        const float* dp = D + ((size_t)(b * 256) * 8 + h) * 128 + k;
        float s0 = 0.f, s1 = 0.f;
        for (int n = 0; n < 256; n += 16) {
            unsigned u[16]; f32x2 d[16];
#pragma unroll
            for (int j = 0; j < 16; ++j) { u[j] = up[(size_t)(n + j) * 65536]; d[j] = *(const f32x2*)(dp + (size_t)(n + j) * 1024); }
#pragma unroll
            for (int j = 0; j < 16; ++j) { sp[(size_t)(n + j) * 65536] = pk2(s0, s1); s0 = d[j].x * s0 + bflo(u[j]); s1 = d[j].y * s1 + bfhi(u[j]); }
        }
    }
}
__device__ __forceinline__ void hgc_issue_st(CLoads& L, const bf16* __restrict__ ST, int item, int tid) {
    const u32x4* sg = (const u32x4*)(ST + (size_t)item * 16384);
#pragma unroll
    for (int j = 0; j < 4; ++j) L.st[j] = sg[tid + 512 * j];
}
__device__ __forceinline__ void hgc_issue_r(CLoads& L, const bf16* __restrict__ QF, const bf16* __restrict__ LOGF, int item, int tid) {
    const int h = item & 7, t = tid >> 3, k0 = 16 * (tid & 7); const size_t go = ((size_t)(item >> 3) * 64 + t) * 1024 + h * 128 + k0;
    L.lfR[0] = *(const u32x4*)(LOGF + go); L.lfR[1] = *(const u32x4*)(LOGF + go + 8);
    L.qR[0] = *(const u32x4*)(QF + go); L.qR[1] = *(const u32x4*)(QF + go + 8);
}
__device__ __forceinline__ void hgc_issue_hg(CLoads& L, const bf16* HGATE, const float* __restrict__ hn, int item, int tid) {
    const int h = item & 7, lane = tid & 63, w = tid >> 6, r = lane & 15, q = lane >> 4, nt = w & 3, vh = w >> 2;
    const bf16* hp = HGATE + ((size_t)(item >> 3) * 64 + 16 * nt + r) * 1024 + h * 128;
#pragma unroll
    for (int j = 0; j < 4; ++j) { L.hg[j] = *(const u32x2*)(hp + 16 * (4 * vh + j) + 4 * q); L.hnv[j] = *(const f32x4*)(hn + 16 * (4 * vh + j) + 4 * q); }
}
__device__ __forceinline__ void hgrn_c_item(LAS unsigned char* lds, CLoads& L, const bf16* __restrict__ QF, const bf16* __restrict__ LOGF, const bf16* __restrict__ VI, const bf16* __restrict__ ST,
                                            bf16* HGATE, bf16* HDST, const float* __restrict__ hn, int item, int next, int tid) {
    const int h = item & 7; const size_t tok0 = (size_t)(item >> 3) * 64;
    hgc_issue_hg(L, HGATE, hn, item, tid);
    Prep P; hg_step1(lds, L.a, tid, P, HL_VT);
    if (next >= 0) hg_issue1(L.a, LOGF, VI, next, tid);
    {
        const int k = tid & 127, seg = tid >> 7;
        LAS float* CUM = (LAS float*)(lds + HL_CUM);
#pragma unroll
        for (int i = 0; i < 16; ++i) CUM[(16 * seg + i) * 128 + k] = P.cum[i];
        if (seg == 0) ((LAS float*)(lds + HL_REF))[k] = P.ref;
#pragma unroll
        for (int j = 0; j < 4; ++j) { const int idx = tid + 512 * j, v = idx >> 4, c = idx & 15; *(LAS u32x4*)(lds + HL_ST + (v * 136 + c * 8) * 2) = L.st[j]; }
        if (next >= 0) hgc_issue_st(L, ST, next, tid);
    }
    __syncthreads();
    {
        const int t = tid >> 3, k0 = 16 * (tid & 7);
        f32x4 cm[4], rf[4];
#pragma unroll
        for (int j = 0; j < 4; ++j) { cm[j] = *(const LAS f32x4*)(lds + HL_CUM + (t * 128 + k0 + 4 * j) * 4); rf[j] = *(const LAS f32x4*)(lds + HL_REF + (k0 + 4 * j) * 4); }
        unsigned pq[8], pkk[8], po[8];
#pragma unroll
        for (int j = 0; j < 8; ++j) {
            const unsigned qw = L.qR[j >> 2][j & 3]; const float q0 = bflo(qw), q1 = bfhi(qw);
            const int e0 = 2 * j, e1 = 2 * j + 1;
            const float c0 = cm[e0 >> 2][e0 & 3], c1 = cm[e1 >> 2][e1 & 3], r0 = rf[e0 >> 2][e0 & 3], r1 = rf[e1 >> 2][e1 & 3];
            const unsigned lw = L.lfR[j >> 2][j & 3]; const float kf0 = 1.f - __builtin_amdgcn_exp2f(bflo(lw)), kf1 = 1.f - __builtin_amdgcn_exp2f(bfhi(lw));
            pq[j] = pk2(q0 * __builtin_amdgcn_exp2f(c0 - r0), q1 * __builtin_amdgcn_exp2f(c1 - r1));
            pkk[j] = pk2(kf0 * __builtin_amdgcn_exp2f(r0 - c0), kf1 * __builtin_amdgcn_exp2f(r1 - c1));
            po[j] = pk2(q0 * __builtin_amdgcn_exp2f(c0), q1 * __builtin_amdgcn_exp2f(c1));
        }
        if (next >= 0) hgc_issue_r(L, QF, LOGF, next, tid);
        const int lo = (t * 136 + k0) * 2;
        *(LAS u32x4*)(lds + HL_QT + lo) = (u32x4){pq[0], pq[1], pq[2], pq[3]}; *(LAS u32x4*)(lds + HL_QT + lo + 16) = (u32x4){pq[4], pq[5], pq[6], pq[7]};
        *(LAS u32x4*)(lds + HL_KT + lo) = (u32x4){pkk[0], pkk[1], pkk[2], pkk[3]}; *(LAS u32x4*)(lds + HL_KT + lo + 16) = (u32x4){pkk[4], pkk[5], pkk[6], pkk[7]};
        *(LAS u32x4*)(lds + HL_QO + lo) = (u32x4){po[0], po[1], po[2], po[3]}; *(LAS u32x4*)(lds + HL_QO + lo + 16) = (u32x4){po[4], po[5], po[6], po[7]};
    }
    __syncthreads();
    const int lane = tid & 63, w = tid >> 6, r = lane & 15, q = lane >> 4, nt = w & 3, vh = w >> 2;
    {
#pragma unroll
        for (int mm = 0; mm < 2; ++mm) { const int mt = vh * 2 + mm; f32x4 acc = {0.f, 0.f, 0.f, 0.f};
            if (mt <= nt) {
#pragma unroll
                for (int ks = 0; ks < 4; ++ks) { const bf16x8 a = *(const LAS bf16x8*)(lds + HL_KT + ((16 * mt + r) * 136 + 32 * ks + 8 * q) * 2), b = *(const LAS bf16x8*)(lds + HL_QT + ((16 * nt + r) * 136 + 32 * ks + 8 * q) * 2);
                    acc = MFMA16(a, b, acc); } }
            const int c = 16 * nt + r, s0 = 16 * mt + 4 * q;
            const float a0 = (mt <= nt && s0 + 0 <= c) ? acc[0] : 0.f, a1 = (mt <= nt && s0 + 1 <= c) ? acc[1] : 0.f, a2 = (mt <= nt && s0 + 2 <= c) ? acc[2] : 0.f, a3 = (mt <= nt && s0 + 3 <= c) ? acc[3] : 0.f;
            u32x2 o; o.x = pk2(a0, a1); o.y = pk2(a2, a3);
            *(LAS u32x2*)(lds + HL_ABUF + (c * 72 + s0) * 2) = o; }
    }
    __syncthreads();
    {
        bf16x8 bA[2], bQ[4];
#pragma unroll
        for (int ks = 0; ks < 2; ++ks) bA[ks] = *(const LAS bf16x8*)(lds + HL_ABUF + ((16 * nt + r) * 72 + 32 * ks + 8 * q) * 2);
#pragma unroll
        for (int ks = 0; ks < 4; ++ks) bQ[ks] = *(const LAS bf16x8*)(lds + HL_QO + ((16 * nt + r) * 136 + 32 * ks + 8 * q) * 2);
        f32x4 acc[4]; float ss = 0.f;
#pragma unroll
        for (int j = 0; j < 4; ++j) { const int vt = 4 * vh + j; acc[j] = (f32x4){0.f, 0.f, 0.f, 0.f};
#pragma unroll
            for (int ks = 0; ks < 2; ++ks) { const bf16x8 a = *(const LAS bf16x8*)(lds + HL_VT + ((16 * vt + r) * 72 + 32 * ks + 8 * q) * 2); acc[j] = MFMA16(a, bA[ks], acc[j]); }
#pragma unroll
            for (int ks = 0; ks < 4; ++ks) { const bf16x8 a = *(const LAS bf16x8*)(lds + HL_ST + ((16 * vt + r) * 136 + 32 * ks + 8 * q) * 2); acc[j] = MFMA16(a, bQ[ks], acc[j]); }
            ss += (acc[j][0] * acc[j][0] + acc[j][1] * acc[j][1]) + (acc[j][2] * acc[j][2] + acc[j][3] * acc[j][3]); }
        ss += __shfl_xor(ss, 16); ss += __shfl_xor(ss, 32);
        LAS float* SS = (LAS float*)(lds + HL_SS);
        if (q == 0) SS[vh * 64 + 16 * nt + r] = ss;
        __syncthreads();
        const float rr = rsqrtf((SS[16 * nt + r] + SS[64 + 16 * nt + r]) * (1.f / 128.f) + EPSF);
        bf16* hp = HGATE + (tok0 + 16 * nt + r) * 1024 + h * 128;
#pragma unroll
        for (int j = 0; j < 4; ++j) { const int vb = 16 * (4 * vh + j) + 4 * q; const f32x4 g = L.hnv[j]; const u32x2 hg = L.hg[j];
            u32x2 o; o.x = pk2(acc[j][0] * rr * g[0] * bflo(hg.x), acc[j][1] * rr * g[1] * bfhi(hg.x)); o.y = pk2(acc[j][2] * rr * g[2] * bflo(hg.y), acc[j][3] * rr * g[3] * bfhi(hg.y));
            *(u32x2*)(HDST + (hp - HGATE) + vb) = o; }
    }
}

constexpr int AL_K = 0, AL_VT = 208 * 144, AL_END = AL_VT + 64 * 432;
static_assert(2 * AL_END <= 131072, "attention LDS map (two parities)");
__device__ __forceinline__ void attn_item(LAS unsigned char* lds, bf16* AQ, bf16* ODST, const bf16* __restrict__ AKV, const float* __restrict__ sinks, const float* __restrict__ qn, const float* __restrict__ kn, int item, int tid, int par) {
    const int b = item >> 9, kvh = (item >> 8) & 1, qb = item & 255, t0 = qb * 64;
    const size_t tokb = (size_t)b * SEQ;
    const int ab = par * AL_END;
    const int lane = tid & 63, w = tid >> 6, r = lane & 15, quad = lane >> 4, h = kvh * 8 + w;
    bf16* qbase = AQ + (tokb + t0) * 1024 + h * 64;
    u32x4 qnx[2];
#pragma unroll
    for (int ks = 0; ks < 2; ++ks) qnx[ks] = *(const u32x4*)(qbase + (size_t)r * 1024 + 32 * ks + 8 * quad);
    {
        const f32x4 kg0 = *(const f32x4*)(kn + (tid & 7) * 8), kg1 = *(const f32x4*)(kn + (tid & 7) * 8 + 4);
        u32x4 kv[3];
#pragma unroll
        for (int j = 0; j < 3; ++j) { const int idx = tid + 512 * j, key = idx >> 3, c = idx & 7, s = t0 - 128 + key; kv[j] = (u32x4){0u, 0u, 0u, 0u};
            if (s >= 0) kv[j] = *(const u32x4*)(AKV + (tokb + s) * 256 + kvh * 64 + c * 8); }
#pragma unroll
        for (int j = 0; j < 3; ++j) { const int idx = tid + 512 * j, key = idx >> 3, c = idx & 7;
            *(LAS u32x4*)(lds + ab + AL_K + (key * 72 + c * 8) * 2) = headnorm8(kv[j], kg0, kg1, 1.f); }
    }
    {
        const int d = tid & 63, kseg = tid >> 6; unsigned vv[24];
#pragma unroll
        for (int i = 0; i < 24; ++i) { const int s = t0 - 128 + 24 * kseg + i; vv[i] = s >= 0 ? (unsigned)AKV[(tokb + s) * 256 + 128 + kvh * 64 + d] : 0u; }
#pragma unroll
        for (int j = 0; j < 3; ++j) { u32x4 w; w.x = vv[8 * j] | (vv[8 * j + 1] << 16); w.y = vv[8 * j + 2] | (vv[8 * j + 3] << 16); w.z = vv[8 * j + 4] | (vv[8 * j + 5] << 16); w.w = vv[8 * j + 6] | (vv[8 * j + 7] << 16);
            *(LAS u32x4*)(lds + ab + AL_VT + (d * 216 + 24 * kseg + 8 * j) * 2) = w; }
        if (kseg == 0) { *(LAS u32x4*)(lds + ab + AL_VT + (d * 216 + 192) * 2) = (u32x4){0u, 0u, 0u, 0u}; *(LAS u32x4*)(lds + ab + AL_VT + (d * 216 + 200) * 2) = (u32x4){0u, 0u, 0u, 0u}; }
    }
    __syncthreads();
    const float L2E = 1.44269504f, slope2 = exp2f(-0.5f * (float)(h + 1)) * L2E, sink2 = sinks[h] * L2E;
    const int m0 = r - 4 * quad;
    const float nb = -slope2 * (float)(128 + m0);
    float bias[9][4];
#pragma unroll
    for (int a = 0; a < 9; ++a)
#pragma unroll
        for (int i = 0; i < 4; ++i) bias[a][i] = fmaf(slope2, (float)(16 * a + i), nb);
#pragma unroll
    for (int i = 0; i < 4; ++i) { if (!(i > m0)) bias[0][i] = -INFINITY; if (!(i <= m0)) bias[8][i] = -INFINITY; }
    f32x4 qg[2][2];
#pragma unroll
    for (int ks = 0; ks < 2; ++ks) { qg[ks][0] = *(const f32x4*)(qn + 32 * ks + 8 * quad); qg[ks][1] = *(const f32x4*)(qn + 32 * ks + 8 * quad + 4); }
#pragma unroll 1
    for (int qt = 0; qt < 4; ++qt) {
        bf16x8 qf[2];
        {
            u32x4 qw[2]; float qv[2][8]; float ss = 0.f;
#pragma unroll
            for (int ks = 0; ks < 2; ++ks) qw[ks] = qnx[ks];
            if (qt < 3) {
#pragma unroll
                for (int ks = 0; ks < 2; ++ks) qnx[ks] = *(const u32x4*)(qbase + (size_t)(16 * (qt + 1) + r) * 1024 + 32 * ks + 8 * quad); }
#pragma unroll
            for (int ks = 0; ks < 2; ++ks) {
                qv[ks][0] = bflo(qw[ks].x); qv[ks][1] = bfhi(qw[ks].x); qv[ks][2] = bflo(qw[ks].y); qv[ks][3] = bfhi(qw[ks].y); qv[ks][4] = bflo(qw[ks].z); qv[ks][5] = bfhi(qw[ks].z); qv[ks][6] = bflo(qw[ks].w); qv[ks][7] = bfhi(qw[ks].w);
#pragma unroll
                for (int e = 0; e < 8; ++e) ss += qv[ks][e] * qv[ks][e]; }
            ss += __shfl_xor(ss, 16); ss += __shfl_xor(ss, 32);
            const float rq = rsqrtf(ss * (1.f / 64.f) + EPSF) * (0.125f * L2E);
#pragma unroll
            for (int ks = 0; ks < 2; ++ks) { const f32x4 g0 = qg[ks][0], g1 = qg[ks][1];
                const u32x4 pw = {pk2(qv[ks][0] * rq * g0[0], qv[ks][1] * rq * g0[1]), pk2(qv[ks][2] * rq * g0[2], qv[ks][3] * rq * g0[3]), pk2(qv[ks][4] * rq * g1[0], qv[ks][5] * rq * g1[1]), pk2(qv[ks][6] * rq * g1[2], qv[ks][7] * rq * g1[3])};
                qf[ks] = __builtin_bit_cast(bf16x8, pw); }
        }
        f32x4 s[9];
#pragma unroll
        for (int a = 0; a < 9; ++a) { s[a] = (f32x4){0.f, 0.f, 0.f, 0.f};
#pragma unroll
            for (int ks = 0; ks < 2; ++ks) { const bf16x8 kf = *(const LAS bf16x8*)(lds + ab + AL_K + ((16 * (qt + a) + r) * 72 + 32 * ks + 8 * quad) * 2); s[a] = MFMA16(kf, qf[ks], s[a]); } }
        const int iq = 16 * qt + r;
#pragma unroll
        for (int a = 0; a < 9; ++a)
#pragma unroll
            for (int i = 0; i < 4; ++i) s[a][i] += bias[a][i];
        if (t0 < 128) {
            const int jmin = 128 - t0;
#pragma unroll
            for (int a = 0; a < 9; ++a)
#pragma unroll
                for (int i = 0; i < 4; ++i) if (16 * (qt + a) + 4 * quad + i < jmin) s[a][i] = -INFINITY;
        }
        float mx = sink2;
#pragma unroll
        for (int a = 0; a < 9; ++a) mx = fmaxf(fmaxf(mx, fmaxf(s[a][0], s[a][1])), fmaxf(s[a][2], s[a][3]));
        mx = fmaxf(mx, __shfl_xor(mx, 16)); mx = fmaxf(mx, __shfl_xor(mx, 32));
        float sum = 0.f;
#pragma unroll
        for (int a = 0; a < 9; ++a)
#pragma unroll
            for (int i = 0; i < 4; ++i) { const float p = __builtin_amdgcn_exp2f(s[a][i] - mx); s[a][i] = p; sum += p; }
        sum += __shfl_xor(sum, 16); sum += __shfl_xor(sum, 32); sum += __builtin_amdgcn_exp2f(sink2 - mx);
        const float inv = 1.f / sum;
        f32x4 o[4];
#pragma unroll
        for (int dt = 0; dt < 4; ++dt) o[dt] = (f32x4){0.f, 0.f, 0.f, 0.f};
#pragma unroll
        for (int kp = 0; kp < 5; ++kp) {
            u32x4 pw = {pk2(s[2 * kp][0], s[2 * kp][1]), pk2(s[2 * kp][2], s[2 * kp][3]), 0u, 0u};
            if (kp < 4) { pw.z = pk2(s[(2 * kp + 1) % 9][0], s[(2 * kp + 1) % 9][1]); pw.w = pk2(s[(2 * kp + 1) % 9][2], s[(2 * kp + 1) % 9][3]); }
            const bf16x8 pb = __builtin_bit_cast(bf16x8, pw);
#pragma unroll
            for (int dt = 0; dt < 4; ++dt) {
                const u32x2 lo = *(const LAS u32x2*)(lds + ab + AL_VT + ((16 * dt + r) * 216 + 16 * (qt + 2 * kp) + 4 * quad) * 2);
                u32x4 vw = {lo.x, lo.y, 0u, 0u};
                if (kp < 4) { const u32x2 hi = *(const LAS u32x2*)(lds + ab + AL_VT + ((16 * dt + r) * 216 + 16 * (qt + 2 * kp + 1) + 4 * quad) * 2); vw.z = hi.x; vw.w = hi.y; }
                o[dt] = MFMA16(__builtin_bit_cast(bf16x8, vw), pb, o[dt]); }
        }
#pragma unroll
        for (int dt = 0; dt < 4; ++dt) { u32x2 wv; wv.x = pk2(o[dt][0] * inv, o[dt][1] * inv); wv.y = pk2(o[dt][2] * inv, o[dt][3] * inv);
            *(u32x2*)(ODST + (qbase - AQ) + (size_t)iq * 1024 + 16 * dt + 4 * quad) = wv; }
    }
}

constexpr int RSL_OFF = 132096;
template <bool FROM_PART>
__device__ __forceinline__ void fill_rs_table(LAS unsigned char* lds, const pg8::StaticOrder& S, const float* __restrict__ src, int tid) {
    int p0 = 0, p1 = 0, p2 = 0, p3 = 0;
    if (S.G == 256 && (S.nwg % (8 * pg8::WGM * S.nN)) == 0) {
        const int xcd = S.c % 8, j = S.c / 8, nig = pg8::WGM * S.nN, gid0 = (xcd * (S.nwg / 8)) / nig, b = j % pg8::WGM;
        p0 = gid0 * pg8::WGM + b; p1 = p0 + pg8::WGM; p2 = p1 + pg8::WGM; p3 = p2 + pg8::WGM;
    } else { pg8::Unit u; for (int i = 0; S.next(i, u); ++i) { if (u.slot == 0) p0 = u.pm; else if (u.slot == 1) p1 = u.pm; else if (u.slot == 2) p2 = u.pm; else p3 = u.pm; } }
    LAS float* T = (LAS float*)(lds + RSL_OFF);
    for (int e = tid; e < 1024; e += 512) { const int slot = e >> 8, t = e & 255; int pm = slot == 0 ? p0 : slot == 1 ? p1 : slot == 2 ? p2 : p3; pm = pm < MTOK / 256 ? pm : 0; const int row = pm * 256 + t;
        float v;
        if (FROM_PART) { const f32x4* p = (const f32x4*)(src + (size_t)row * 32); float s = 0.f;
#pragma unroll
            for (int jj = 0; jj < 8; ++jj) { const f32x4 w = p[jj]; s += (w[0] + w[1]) + (w[2] + w[3]); }
            v = rsqrtf(s * (1.f / DM) + EPSF); }
        else v = src[row];
        T[e] = v; }
    __syncthreads();
}

template <bool FROM_PART>
__device__ __forceinline__ void fill_rs_one(LAS unsigned char* lds, int pm, const float* __restrict__ src, int tid) {
    LAS float* T = (LAS float*)(lds + RSL_OFF);
    if (tid < 256) { const int row = pm * 256 + tid; float v;
        if (FROM_PART) { const f32x4* p = (const f32x4*)(src + (size_t)row * 32); float s = 0.f;
#pragma unroll
            for (int jj = 0; jj < 8; ++jj) { const f32x4 w = p[jj]; s += (w[0] + w[1]) + (w[2] + w[3]); }
            v = rsqrtf(s * (1.f / DM) + EPSF); }
        else v = src[row];
        T[tid] = v; }
    __syncthreads();
}
#define XB_TMO      128
#define XB_XCNT(j)  (256  + 64 * (j))
#define XB_XSUB(j)  (1280 + 64 * (j))
#define XB_XGEN(j)  (2304 + 64 * (j))
#define XB_TOP      3328
#define XB_TOPGEN   3392
#define XCD_BAR_WORDS 3456
#define XB_SPIN_CAP (1u << 18)

__device__ __forceinline__ unsigned xb_ld(unsigned* p)              { return __hip_atomic_load(p, __ATOMIC_RELAXED, __HIP_MEMORY_SCOPE_AGENT); }
__device__ __forceinline__ unsigned xb_add(unsigned* p, unsigned v) { return __hip_atomic_fetch_add(p, v, __ATOMIC_RELAXED, __HIP_MEMORY_SCOPE_AGENT); }
__device__ __forceinline__ unsigned xb_xcc_id() { return (unsigned)__builtin_amdgcn_s_getreg((3 << 11) | 20) & 0xFu; }
#define XB_SPIN(cond, bar) do { unsigned _sp = 0; while (cond) { __builtin_amdgcn_s_sleep(1); \
    if ((++_sp & 255u) == 0u) { if (xb_ld(&(bar)[XB_TMO])) break; if (_sp > XB_SPIN_CAP) { atomicAdd(&(bar)[XB_TMO], 1u); break; } } } } while (0)

struct XcdBarrier {
    unsigned* bar; unsigned x;
    volatile LAS unsigned* st;
};

__device__ __forceinline__ XcdBarrier xcd_barrier_post(unsigned* bar, volatile LAS unsigned* st) {
    XcdBarrier b; b.bar = bar; b.x = xb_xcc_id(); b.st = st;
    if (threadIdx.x == 0) (void)xb_add(&bar[XB_XCNT(b.x)], 1u);
    return b;
}
__device__ __forceinline__ void xcd_barrier_complete(unsigned* bar, unsigned x, unsigned& nloc, unsigned& nx) {
    const unsigned G = gridDim.x * gridDim.y * gridDim.z;
    unsigned sum, cnt, mine, sp = 0u;
    for (;;) {
        sum = 0u; cnt = 0u; mine = 0u;
#pragma unroll
        for (unsigned j = 0; j < 16; ++j) { const unsigned c = xb_ld(&bar[XB_XCNT(j)]); sum += c; cnt += (c > 0u) ? 1u : 0u; mine = (j == x) ? c : mine; }
        if (sum == G) break;
        __builtin_amdgcn_s_sleep(1);
        if ((++sp & 255u) == 0u) { if (xb_ld(&bar[XB_TMO])) break; if (sp > XB_SPIN_CAP) { atomicAdd(&bar[XB_TMO], 1u); break; } }
    }
    nloc = mine > 0u ? mine : 1u; nx = cnt > 0u ? cnt : 1u;
}

__device__ __forceinline__ void xcd_barrier(const XcdBarrier& b, bool leader) {
    asm volatile("s_waitcnt vmcnt(0)" ::: "memory");
    __syncthreads();
    if (leader) {
        unsigned* bar = b.bar;
        __builtin_amdgcn_s_waitcnt(0);
        unsigned nloc = b.st[0], nx = b.st[1];
        if (nloc == 0u) { xcd_barrier_complete(bar, b.x, nloc, nx); b.st[0] = nloc; b.st[1] = nx; }
        const unsigned old = xb_add(&bar[XB_XSUB(b.x)], 1u);
        const unsigned gen = old / nloc;
        if (old + 1u == (gen + 1u) * nloc) {
            __builtin_amdgcn_fence(__ATOMIC_RELEASE, "agent");
            asm volatile("s_waitcnt vmcnt(0)" ::: "memory");
            const unsigned og = xb_add(&bar[XB_TOP], 1u);
            const unsigned tg = og / nx;
            if (og + 1u == (tg + 1u) * nx) xb_add(&bar[XB_TOPGEN], 1u);
            else XB_SPIN(xb_ld(&bar[XB_TOPGEN]) == tg, bar);
            __builtin_amdgcn_fence(__ATOMIC_ACQUIRE, "agent");
            xb_add(&bar[XB_XGEN(b.x)], 1u);
            asm volatile("s_waitcnt vmcnt(0)" ::: "memory");
        } else {
            XB_SPIN(xb_ld(&bar[XB_XGEN(b.x)]) == gen, bar);
            __builtin_amdgcn_fence(__ATOMIC_ACQUIRE, "agent");
            asm volatile("s_waitcnt vmcnt(0)" ::: "memory");
        }
    }
    __syncthreads();
}

constexpr int MISC_OFF = LDS_BYTES - 256;
static_assert(MISC_OFF >= 141824 && MISC_OFF >= 131072, "LDS control words above every phase's LDS map");
typedef const Args __attribute__((address_space(4)))* KArgsP;
__device__ __forceinline__ KArgsP kargs() { KArgsP p = (KArgsP)__builtin_amdgcn_kernarg_segment_ptr(); asm volatile("" : "+s"(p)); return p; }
#define ZP(off) (ka->ws + WS_Z + (off))
#define WL(off) ((const bf16*)(ka->ws + WS_W + (size_t)l * W_LAYER + (off)))
__global__ void __launch_bounds__(512, 2) fwd_mega(Args a_unused) {
    extern __shared__ __attribute__((aligned(16))) unsigned char lds_raw[];
    LAS unsigned char* lds = (LAS unsigned char*)lds_raw;
    cg::grid_group grid = cg::this_grid();
    const int G = gridDim.x, bx = blockIdx.x;
    const int wave_s = __builtin_amdgcn_readfirstlane((int)threadIdx.x >> 6);
#define MYTID() ((wave_s << 6) | (int)__builtin_amdgcn_mbcnt_hi(~0u, __builtin_amdgcn_mbcnt_lo(~0u, 0u)))
    if (threadIdx.x < 2) ((volatile LAS unsigned*)(lds + MISC_OFF))[threadIdx.x] = 0u;
    __syncthreads();
    { KArgsP ka = kargs(); (void)xcd_barrier_post((unsigned*)(ka->ws + WS_BAR), (volatile LAS unsigned*)(lds + MISC_OFF)); }
#define GSYNC() do { KArgsP ka_ = kargs(); XcdBarrier b_; b_.bar = (unsigned*)(ka_->ws + WS_BAR); b_.x = xb_xcc_id(); b_.st = (volatile LAS unsigned*)(lds + MISC_OFF); xcd_barrier(b_, MYTID() == 0); } while (0)
#define TIDS int tid_ = MYTID(); asm volatile("" : "+v"(tid_)); const int tid = tid_, lane = tid & 63, wave = __builtin_amdgcn_readfirstlane(tid >> 6), gw = bx * 8 + wave, NGW = G * 8, gtid = bx * 512 + tid, NT = G * 512; (void)lane; (void)gw; (void)NGW; (void)gtid; (void)NT;

#if REP_P0 > 1
    int np0 = REP_P0; asm volatile("" : "+s"(np0));
#pragma unroll 1
    for (int rep0 = 0; rep0 < np0; ++rep0)
#endif
    {
        KArgsP ka = kargs(); TIDS
        unsigned char* ws = ka->ws; float* RS = (float*)(ws + WS_RS); float* LB = (float*)(ws + WS_LB); bf16* XB = (bf16*)(ws + WS_XB);
        LAS float* scr = (LAS float*)(lds + wave * 16384);
        constexpr int I_IN = (DM / 64) * (DIN / 32), I_HG = (HGW / 64) * (DM / 32), I_AT = (ATW / 64) * (DM / 32), I_OUT = (DM / 64) * (DM / 32), I_UP = (DM / 64) * (DFF / 32), I_DN = (DFF / 64) * (DM / 32);
        constexpr int I_LAYER = I_IN + I_HG + I_AT + I_OUT + I_UP + I_DN;
        for (int it = gw; it < 2 * I_LAYER; it += NGW) {
            const int l = it >= I_LAYER ? 1 : 0; int r = it - l * I_LAYER; unsigned char* wl = ws + WS_W + (size_t)l * W_LAYER;
            if (r < I_IN) { transpose_item(ka->w_in + (size_t)l * DM * DIN, ka->norm_mix + l * DM, DM, DIN, (bf16*)(wl + W_IN), scr, r, lane, true); continue; } r -= I_IN;
            if (r < I_HG) { transpose_item(ka->w_hg_out + (size_t)l * HGW * DM, nullptr, HGW, DM, (bf16*)(wl + W_HG), scr, r, lane); continue; } r -= I_HG;
            if (r < I_AT) { transpose_item(ka->w_at_out + (size_t)l * ATW * DM, nullptr, ATW, DM, (bf16*)(wl + W_AT), scr, r, lane); continue; } r -= I_AT;
            if (r < I_OUT) { transpose_item(ka->w_out + (size_t)l * DM * DM, nullptr, DM, DM, (bf16*)(wl + W_OUT), scr, r, lane); continue; } r -= I_OUT;
            if (r < I_UP) { transpose_item(ka->w_up + (size_t)l * DM * DFF, ka->norm_ffn + l * DM, DM, DFF, (bf16*)(wl + W_UP), scr, r, lane); continue; } r -= I_UP;
            transpose_item(ka->w_down + (size_t)l * DFF * DM, nullptr, DFF, DM, (bf16*)(wl + W_DN), scr, r, lane);
        }
        for (int c = gtid; c < 1024; c += NT) { LB[c] = 0.f; LB[1024 + c] = sigm(ka->lb_logits[1024 + c] - ka->lb_logits[c]); }
        const float* x = ka->x;
        for (int m = gw; m < MTOK; m += NGW) {
            const f32x4* xr = (const f32x4*)(x + (size_t)m * DM) + lane; f32x4 v[8]; float s = 0.f;
#pragma unroll
            for (int j = 0; j < 8; ++j) { v[j] = xr[64 * j]; s += (v[j][0] * v[j][0] + v[j][1] * v[j][1]) + (v[j][2] * v[j][2] + v[j][3] * v[j][3]); }
            s = wave_sum(s);
            if (lane == 0) RS[m] = rsqrtf(s * (1.f / DM) + EPSF);
            u32x2* o8 = (u32x2*)(XB + (size_t)m * DM) + lane;
#pragma unroll
            for (int j = 0; j < 8; ++j) { u32x2 w; w.x = pk2(v[j][0], v[j][1]); w.y = pk2(v[j][2], v[j][3]); o8[64 * j] = w; }
        }
    }
    { KArgsP ka = kargs(); if (ka->ws == nullptr) grid.sync(); }
    GSYNC();

    for (int l = 0; l < 2; ++l) {
        if (ON(1)) {
            KArgsP ka = kargs();
            pg8::Gemm g{(const bf16*)(ka->ws + WS_XB), WL(W_IN), MTOK, DIN, DM}; pg8::StaticOrder S; S.init(MTOK, DIN - 256, G, bx, REP_G1);
            { TIDS if (l == 0) fill_rs_table<false>(lds, S, (const float*)(ka->ws + WS_RS), tid); else fill_rs_table<true>(lds, S, (const float*)(ka->ws + WS_PART), tid); }
            pg8::EpiIn E{(const LAS float*)(lds + RSL_OFF), (const float*)(ka->ws + WS_LB) + l * 1024, ka->ws + WS_Z};
            if (SKEW_G1 > 0 && bx >= G / 2) { const unsigned long long t0 = __builtin_amdgcn_s_memrealtime(); while (__builtin_amdgcn_s_memrealtime() - t0 < (unsigned long long)SKEW_G1) __builtin_amdgcn_s_sleep(32); }
            pg8::gemm_phase<pg8::EpiIn, pg8::StaticOrder, PG_ALIGN, PG_SP2>(lds, g, S, E, MYTID());
        }
        GSYNC();
#if XSYNC > 0
        { int nx = XSYNC; asm volatile("" : "+s"(nx));
#pragma unroll 1
          for (int i = 0; i < nx; ++i) GSYNC(); }
#endif
        {
            KArgsP ka = kargs(); TIDS
#if REP_HA > 1
            int nha = REP_HA; asm volatile("" : "+s"(nha));
#pragma unroll 1
            for (int rha = 0; rha < nha; ++rha)
#endif
            if (ON(2)) { ALoads L;
                { int par = 0; for (int item = bx; item < 4096; item += G, par ^= 1) hgrn_a_item(lds, L, (const bf16*)ZP(Z_LOGF), (const bf16*)ZP(Z_VI), (bf16*)ka->out, (float*)(ka->ws + WS_D), item, item + G < 4096 ? item + G : -1, tid, par); } __syncthreads(); }
        }
        GSYNC();
        if (ON(2)) { KArgsP ka = kargs(); TIDS hgrn_scan((bf16*)ka->out, (bf16*)ka->out, (const float*)(ka->ws + WS_D), gtid, NT); }
        if (ON(5)) {
            KArgsP ka = kargs();
#define G1_LAST_PANEL(PM) do { pg8::Gemm g{(const bf16*)(ka->ws + WS_XB), WL(W_IN), MTOK, DIN, DM}; pg8::OneOrder S1{(PM), DIN / 256 - 1}; \
                if (l == 0) fill_rs_one<false>(lds, (PM), (const float*)(ka->ws + WS_RS), MYTID()); else fill_rs_one<true>(lds, (PM), (const float*)(ka->ws + WS_PART), MYTID()); \
                pg8::EpiIn E{(const LAS float*)(lds + RSL_OFF), (const float*)(ka->ws + WS_LB) + l * 1024, ka->ws + WS_Z}; \
                pg8::gemm_phase<pg8::EpiIn, pg8::OneOrder, PG_ALIGN, PG_SP2>(lds, g, S1, E, MYTID()); __syncthreads(); } while (0)
            if (G == 256) { if (bx >= 128) G1_LAST_PANEL(bx - 128); }
            else for (int pmx = bx; pmx < MTOK / 256; pmx += G) G1_LAST_PANEL(pmx);
        }
        {
            KArgsP ka = kargs(); TIDS
#define ATT(ITEM, PAR) attn_item(lds, (bf16*)ZP(Z_AQ), (bf16*)ZP(Z_AQ), (const bf16*)ZP(Z_AKV), ka->sinks + l * 16, ka->q_norm + l * 64, ka->k_norm + l * 64, (ITEM), tid, (PAR))
            if (ON(5)) {
                if (G == 256) {
                    if (bx >= 128) {
#pragma unroll 1
                        for (int k = 0; k < 2; ++k) ATT(768 + 128 * k + (bx - 128), k & 1); }
                    else {
#pragma unroll 1
                        for (int k = 0; k < 6; ++k) ATT(bx + 128 * k, k & 1); }
                } else { int par = 0; for (int item = bx; item < 1024; item += G, par ^= 1) ATT(item, par); }
            }
        }
        GSYNC();
        {
            KArgsP ka = kargs(); TIDS
            if (ON(4)) { CLoads L;
#define HGC_RUN(DST) do { { const int it0 = bx & 4095; hg_issue1(L.a, (const bf16*)ZP(Z_LOGF), (const bf16*)ZP(Z_VI), it0, tid); hgc_issue_st(L, (const bf16*)ka->out, it0, tid); hgc_issue_r(L, (const bf16*)ZP(Z_QF), (const bf16*)ZP(Z_LOGF), it0, tid); } \
                for (int item = bx; item < 4096; item += G) hgrn_c_item(lds, L, (const bf16*)ZP(Z_QF), (const bf16*)ZP(Z_LOGF), (const bf16*)ZP(Z_VI), (const bf16*)ka->out, (bf16*)ZP(Z_HGATE), (DST), ka->hg_norm + l * 128, item, item + G < 4096 ? item + G : -1, tid); } while (0)
#if REP_MIX & 4
                for (int rr_ = 0; rr_ < 4; ++rr_) if (l == 0) HGC_RUN((bf16*)ka->out + (size_t)MTOK * 2048);
#endif
                HGC_RUN((bf16*)ZP(Z_HGATE)); }
        }
        GSYNC();
        if (ON(6)) {
            KArgsP ka = kargs();
            pg8::Gemm g{(const bf16*)ZP(Z_HGATE), WL(W_HG), MTOK, DM, HGW, (const bf16*)ZP(Z_AQ), WL(W_AT)}; pg8::DualOrder S; S.b.init(MTOK, DM, G, bx, 1);
            pg8::EpiMix E{(const bf16*)ZP(Z_GH), (const bf16*)ZP(Z_GA), (bf16*)ZP(Z_MIX)};
            pg8::gemm_phase<pg8::EpiMix, pg8::DualOrder, PG_ALIGN, PG_SP2, true>(lds, g, S, E, MYTID());
        }
        GSYNC();
        if (ON(8)) {
            KArgsP ka = kargs();
            pg8::Gemm g{(const bf16*)ZP(Z_MIX), WL(W_OUT), MTOK, DM, DM}; pg8::StaticOrder S; S.init(MTOK, DM, G, bx, REP_G46);
            pg8::EpiRes E{(const bf16*)(ka->ws + WS_XB), nullptr, (bf16*)(ka->ws + WS_XB), (float*)(ka->ws + WS_PART)};
            pg8::gemm_phase<pg8::EpiRes, pg8::StaticOrder, PG_ALIGN, PG_SP2>(lds, g, S, E, MYTID());
        }
        GSYNC();
        if (ON(9)) {
            KArgsP ka = kargs();
            pg8::Gemm g{(const bf16*)(ka->ws + WS_XB), WL(W_UP), MTOK, DFF, DM}; pg8::StaticOrder S; S.init(MTOK, DFF, G, bx, REP_G5);
            { TIDS fill_rs_table<true>(lds, S, (const float*)(ka->ws + WS_PART), tid); }
            pg8::EpiUp E{(const LAS float*)(lds + RSL_OFF), (bf16*)ZP(Z_U)};
            if (SKEW_G5 > 0 && bx >= G / 2) { const unsigned long long t0 = __builtin_amdgcn_s_memrealtime(); while (__builtin_amdgcn_s_memrealtime() - t0 < (unsigned long long)SKEW_G5) __builtin_amdgcn_s_sleep(32); }
            pg8::gemm_phase<pg8::EpiUp, pg8::StaticOrder, PG_ALIGN, PG_SP2>(lds, g, S, E, MYTID());
        }
        GSYNC();
        if (ON(10)) {
            KArgsP ka = kargs();
            pg8::Gemm g{(const bf16*)ZP(Z_U), WL(W_DN), MTOK, DM, DFF}; pg8::StaticOrder S; S.init(MTOK, DM, G, bx, REP_G46);
            pg8::EpiRes E{(const bf16*)(ka->ws + WS_XB), l == 0 ? nullptr : ka->out, (bf16*)(ka->ws + WS_XB), (float*)(ka->ws + WS_PART)};
            pg8::gemm_phase<pg8::EpiRes, pg8::StaticOrder, PG_ALIGN, PG_SP2>(lds, g, S, E, MYTID());
        }
        if (l == 0) GSYNC();
    }
}

extern "C" void kernel_launch(void* const* d_in, const int* in_sizes, int n_in, void* d_out, int out_size, void* d_ws, size_t ws_size, hipStream_t stream) {
    static int grid = 0;
    if (grid == 0) {
        if (n_in != 14 || out_size != MTOK * DM || ws_size < WS_END) { fprintf(stderr, "kernel_launch: unexpected shapes (n_in %d out %d ws %zu need %zu)\n", n_in, out_size, ws_size, (size_t)WS_END); grid = -1; return; }
        int dev = 0, cus = 0, per_cu = 0;
        (void)hipGetDevice(&dev); (void)hipDeviceGetAttribute(&cus, hipDeviceAttributeMultiprocessorCount, dev);
        if (hipFuncSetAttribute((const void*)fwd_mega, hipFuncAttributeMaxDynamicSharedMemorySize, LDS_BYTES) != hipSuccess) { fprintf(stderr, "hipFuncSetAttribute failed\n"); grid = -1; return; }
        if (hipOccupancyMaxActiveBlocksPerMultiprocessor(&per_cu, (const void*)fwd_mega, 512, LDS_BYTES) != hipSuccess || per_cu < 1) { fprintf(stderr, "occupancy query: %d\n", per_cu); per_cu = 1; }
        (void)hipGetLastError();
        grid = cus * 1;
    }
    if (grid < 0) return;
    (void)hipMemsetAsync((unsigned char*)d_ws + WS_BAR, 0, 16384, stream);
    Args a{};
    a.x = (const float*)d_in[0]; a.norm_mix = (const float*)d_in[1]; a.w_in = (const float*)d_in[2]; a.lb_logits = (const float*)d_in[3]; a.hg_norm = (const float*)d_in[4];
    a.q_norm = (const float*)d_in[5]; a.k_norm = (const float*)d_in[6]; a.sinks = (const float*)d_in[7]; a.w_hg_out = (const float*)d_in[8]; a.w_at_out = (const float*)d_in[9];
    a.w_out = (const float*)d_in[10]; a.norm_ffn = (const float*)d_in[11]; a.w_up = (const float*)d_in[12]; a.w_down = (const float*)d_in[13];
    a.out = (float*)d_out; a.ws = (unsigned char*)d_ws;
    void* args[] = {&a};
    hipError_t e = hipLaunchCooperativeKernel((const void*)fwd_mega, dim3(grid), dim3(512), args, LDS_BYTES, stream);
    if (e != hipSuccess) fprintf(stderr, "cooperative launch failed: %s (grid %d)\n", hipGetErrorString(e), grid);
}
```
